# Optimizing an MI355X kernel written in HIP

```python
import math
import jax, jax.numpy as jnp
from jax import lax
import numpy as np

D_MODEL = 1024
BATCH = 16
SEQ = 4096
DEPTH = 2

POOL_WIDTH = 256
POOL_GROUPS = 4
POOL_GROUP_DIM = POOL_WIDTH // POOL_GROUPS
POOL_WINDOWS = (2, 4, 8, 16)
ATTN_HEADS = 4
ATTN_QK_DIM = 64
ATTN_V_DIM = 2 * ATTN_QK_DIM
ATTN_QK_WIDTH = ATTN_HEADS * 2 * ATTN_QK_DIM
ATTN_WIDTH = ATTN_HEADS * ATTN_V_DIM
Q_BLOCK = 128
LRU_WIDTH = 256
LRU_BLOCKS = 4
LRU_BLOCK_DIM = LRU_WIDTH // LRU_BLOCKS
LRU_CONV_WIDTH = 4
LRU_C = 8.0
LRU_DIRECTIONS = 2
N_BRANCH = 3
D_FF = 2816
NORM_EPS = 1e-6
SUBLN_EPS = 1e-5
IN_SPLITS = (POOL_WIDTH, ATTN_QK_WIDTH, ATTN_QK_WIDTH, ATTN_WIDTH, LRU_WIDTH, LRU_WIDTH, N_BRANCH * D_MODEL)
IN_WIDTH = 256 + 512 + 512 + 512 + 256 + 256 + 3 * 1024

kernel_name = "hybrid_pool_diffattn_rglru_encoder"


def rms_norm(x, g, eps=NORM_EPS):
    xf = x.astype(jnp.float32)
    y = xf * lax.rsqrt(jnp.mean(xf * xf, axis=-1, keepdims=True) + eps)
    return (y * g.astype(jnp.float32)).astype(x.dtype)


def swiglu(h, w_in, w_out):
    gate, up = jnp.split(h @ w_in, 2, axis=-1)
    return (jax.nn.silu(gate) * up) @ w_out


def alibi_slopes(n_heads):
    start = 2.0 ** (-8.0 / n_heads)
    return np.array([start ** (i + 1) for i in range(n_heads)], dtype=np.float32)


def pool_mixer(p, pool_w, pool_scale):
    b, s, _ = p.shape
    pf = p.astype(jnp.float32)
    csum = jnp.concatenate([jnp.zeros((b, 1, POOL_WIDTH), jnp.float32), jnp.cumsum(pf, axis=1)], axis=1)
    t = jnp.arange(s)
    outs = []
    for g, w in enumerate(POOL_WINDOWS):
        lo = jnp.clip(t - w // 2, 0, s)
        hi = jnp.clip(t + w - w // 2, 0, s)
        sl = slice(g * POOL_GROUP_DIM, (g + 1) * POOL_GROUP_DIM)
        cg = csum[..., sl]
        win_sum = jnp.take(cg, hi, axis=1) - jnp.take(cg, lo, axis=1)
        count = (hi - lo).astype(jnp.float32)[None, :, None]
        outs.append(win_sum / count - pf[..., sl])
    mixed = jnp.stack(outs, axis=2)
    mixed = jnp.einsum('bsgc,gcd->bsgd', mixed, pool_w.astype(jnp.float32)).reshape(b, s, POOL_WIDTH)
    return (mixed * pool_scale.astype(jnp.float32)).astype(p.dtype)


def diff_attention(q, k, v, lam_params, subln_g, lam_init):
    b, s, _ = q.shape
    f32 = jnp.float32
    qf = q.reshape(b, s, ATTN_HEADS, 2, ATTN_QK_DIM).astype(f32) * (ATTN_QK_DIM ** -0.5)
    kf = k.reshape(b, s, ATTN_HEADS, 2, ATTN_QK_DIM).astype(f32)
    vf = v.reshape(b, s, ATTN_HEADS, ATTN_V_DIM).astype(f32)
    lp = lam_params.astype(f32)
    lam = jnp.exp(jnp.sum(lp[0] * lp[1])) - jnp.exp(jnp.sum(lp[2] * lp[3])) + lam_init
    slopes = jnp.asarray(alibi_slopes(ATTN_HEADS))
    kpos = jnp.arange(s)
    nq = s // Q_BLOCK
    q_blocks = qf.reshape(b, nq, Q_BLOCK, ATTN_HEADS, 2, ATTN_QK_DIM).transpose(1, 0, 2, 3, 4, 5)

    def block(args):
        qb, start = args
        qpos = start + jnp.arange(Q_BLOCK)
        dist = jnp.abs(qpos[:, None] - kpos[None, :]).astype(f32)
        bias = -slopes[:, None, None, None] * dist
        scores = jnp.einsum('bqhmd,bkhmd->bhmqk', qb, kf) + bias
        probs = jax.nn.softmax(scores, axis=-1)
        wts = probs[:, :, 0] - lam * probs[:, :, 1]
        return jnp.einsum('bhqk,bkhe->bqhe', wts, vf)

    o = lax.map(block, (q_blocks, jnp.arange(nq) * Q_BLOCK))
    o = o.transpose(1, 0, 2, 3, 4).reshape(b, s, ATTN_HEADS, ATTN_V_DIM)
    o = o * lax.rsqrt(jnp.mean(o * o, axis=-1, keepdims=True) + SUBLN_EPS) * subln_g.astype(f32)
    o = o * (1.0 - lam_init)
    return o.reshape(b, s, ATTN_WIDTH).astype(q.dtype)


def rg_lru(xf, w_a, b_a, w_x, b_x, lam, reverse):
    b, s, _ = xf.shape
    f32 = jnp.float32
    xb = xf.reshape(b, s, LRU_BLOCKS, LRU_BLOCK_DIM)
    r = jax.nn.sigmoid(jnp.einsum('bsgc,gcd->bsgd', xb, w_a.astype(f32)).reshape(b, s, LRU_WIDTH) + b_a.astype(f32))
    i = jax.nn.sigmoid(jnp.einsum('bsgc,gcd->bsgd', xb, w_x.astype(f32)).reshape(b, s, LRU_WIDTH) + b_x.astype(f32))
    log_a = -LRU_C * r * jax.nn.softplus(-lam.astype(f32))
    a = jnp.exp(log_a)
    u = jnp.sqrt(-jnp.expm1(2.0 * log_a)) * (i * xf)

    def combine(c1, c2):
        a1, b1 = c1
        a2, b2 = c2
        return a1 * a2, a2 * b1 + b2

    _, h = lax.associative_scan(combine, (a, u), axis=1, reverse=reverse)
    return h


def rglru_branch(lx, lg, conv_w, conv_b, w_a, b_a, w_x, b_x, lam):
    conv = lax.conv_general_dilated(
        lx, conv_w[:, None, :], window_strides=(1,),
        padding=[(LRU_CONV_WIDTH // 2, LRU_CONV_WIDTH - 1 - LRU_CONV_WIDTH // 2)],
        dimension_numbers=('NWC', 'WIO', 'NWC'), feature_group_count=LRU_WIDTH)
    xf = (conv + conv_b).astype(jnp.float32)
    h = (rg_lru(xf, w_a[0], b_a[0], w_x[0], b_x[0], lam[0], reverse=False)
         + rg_lru(xf, w_a[1], b_a[1], w_x[1], b_x[1], lam[1], reverse=True))
    return (jax.nn.gelu(lg.astype(jnp.float32)) * h).astype(lx.dtype)


def token_mixer(h, w_in, pool_w, pool_scale, attn_lambda, attn_subln, lru_conv_w, lru_conv_b,
                lru_w_a, lru_b_a, lru_w_x, lru_b_x, lru_lambda, w_branch_pool, w_branch_attn,
                w_branch_lru, merge_bias, w_out, lam_init):
    b, s, _ = h.shape
    proj = h @ w_in
    offsets = []
    acc = 0
    for w in IN_SPLITS[:-1]:
        acc += w
        offsets.append(acc)
    p, q, k, v, lx, lg, gate_logits = jnp.split(proj, offsets, axis=-1)
    y_pool = pool_mixer(p, pool_w, pool_scale) @ w_branch_pool
    y_attn = diff_attention(q, k, v, attn_lambda, attn_subln, lam_init) @ w_branch_attn
    y_lru = rglru_branch(lx, lg, lru_conv_w, lru_conv_b, lru_w_a, lru_b_a, lru_w_x, lru_b_x, lru_lambda) @ w_branch_lru
    gates = jax.nn.sigmoid(gate_logits.reshape(b, s, N_BRANCH, D_MODEL).astype(jnp.float32)
                           + merge_bias.astype(jnp.float32)).astype(h.dtype)
    merged = gates[:, :, 0] * y_pool + gates[:, :, 1] * y_attn + gates[:, :, 2] * y_lru
    return merged @ w_out


def setup_inputs(seed: int = 0) -> dict:
    key = jax.random.key(seed)
    ks = jax.random.split(key, 32)
    L, D, F = DEPTH, D_MODEL, D_FF
    f32 = jnp.float32

    def dense(k, shape, fan_in):
        return jax.random.normal(k, shape, f32) * (fan_in ** -0.5)

    def gain(k, shape):
        return 1.0 + 0.02 * jax.random.normal(k, shape, f32)

    def small(k, shape, scale=0.01):
        return scale * jax.random.normal(k, shape, f32)

    u = jax.random.uniform(ks[16], (L, LRU_DIRECTIONS, LRU_WIDTH), f32, 0.9, 0.999)
    a0 = u ** (1.0 / LRU_C)
    lru_lambda = jnp.log(a0) - jnp.log1p(-a0)

    return {
        "x": jax.random.normal(ks[0], (BATCH, SEQ, D), f32),
        "ffn1_norm": gain(ks[1], (L, D)),
        "ffn1_w_in": dense(ks[2], (L, D, 2 * F), D),
        "ffn1_w_out": dense(ks[3], (L, F, D), F),
        "mix_norm": gain(ks[4], (L, D)),
        "w_in": dense(ks[5], (L, D, IN_WIDTH), D),
        "pool_w": dense(ks[6], (L, POOL_GROUPS, POOL_GROUP_DIM, POOL_GROUP_DIM), POOL_GROUP_DIM),
        "pool_scale": 1.0 + 0.1 * jax.random.normal(ks[7], (L, POOL_WIDTH), f32),
        "attn_lambda": small(ks[8], (L, 4, ATTN_QK_DIM), 0.1),
        "attn_subln": gain(ks[9], (L, ATTN_V_DIM)),
        "lru_conv_w": dense(ks[10], (L, LRU_CONV_WIDTH, LRU_WIDTH), LRU_CONV_WIDTH),
        "lru_conv_b": small(ks[11], (L, LRU_WIDTH)),
        "lru_w_a": dense(ks[12], (L, LRU_DIRECTIONS, LRU_BLOCKS, LRU_BLOCK_DIM, LRU_BLOCK_DIM), LRU_BLOCK_DIM),
        "lru_b_a": small(ks[13], (L, LRU_DIRECTIONS, LRU_WIDTH)),
        "lru_w_x": dense(ks[14], (L, LRU_DIRECTIONS, LRU_BLOCKS, LRU_BLOCK_DIM, LRU_BLOCK_DIM), LRU_BLOCK_DIM),
        "lru_b_x": small(ks[15], (L, LRU_DIRECTIONS, LRU_WIDTH)),
        "lru_lambda": lru_lambda,
        "w_branch_pool": dense(ks[17], (L, POOL_WIDTH, D), POOL_WIDTH),
        "w_branch_attn": dense(ks[18], (L, ATTN_WIDTH, D), ATTN_WIDTH),
        "w_branch_lru": dense(ks[19], (L, LRU_WIDTH, D), LRU_WIDTH),
        "merge_bias": small(ks[20], (L, N_BRANCH, D)),
        "w_out": dense(ks[21], (L, D, D), D),
        "ffn2_norm": gain(ks[22], (L, D)),
        "ffn2_w_in": dense(ks[23], (L, D, 2 * F), D),
        "ffn2_w_out": dense(ks[24], (L, F, D), F),
        "final_norm": gain(ks[25], (D,)),
    }


def reference(x, ffn1_norm, ffn1_w_in, ffn1_w_out, mix_norm, w_in, pool_w, pool_scale,
              attn_lambda, attn_subln, lru_conv_w, lru_conv_b, lru_w_a, lru_b_a, lru_w_x,
              lru_b_x, lru_lambda, w_branch_pool, w_branch_attn, w_branch_lru, merge_bias,
              w_out, ffn2_norm, ffn2_w_in, ffn2_w_out, final_norm):
    for l in range(DEPTH):
        lam_init = 0.8 - 0.6 * math.exp(-0.3 * l)
        x = x + 0.5 * swiglu(rms_norm(x, ffn1_norm[l]), ffn1_w_in[l], ffn1_w_out[l])
        x = x + token_mixer(rms_norm(x, mix_norm[l]), w_in[l], pool_w[l], pool_scale[l],
                            attn_lambda[l], attn_subln[l], lru_conv_w[l], lru_conv_b[l],
                            lru_w_a[l], lru_b_a[l], lru_w_x[l], lru_b_x[l], lru_lambda[l],
                            w_branch_pool[l], w_branch_attn[l], w_branch_lru[l],
                            merge_bias[l], w_out[l], lam_init)
        x = x + 0.5 * swiglu(rms_norm(x, ffn2_norm[l]), ffn2_w_in[l], ffn2_w_out[l])
    return rms_norm(x, final_norm)
```

```cpp
#include <hip/hip_runtime.h>
#include <hip/hip_cooperative_groups.h>
#include <cstdio>
#include <cstdint>
#include <cmath>
namespace cg = cooperative_groups;
namespace pg8 {
#define PG8_LAS __attribute__((address_space(3)))
typedef unsigned short bf16_t;
typedef short bf16x8 __attribute__((ext_vector_type(8)));
typedef float f32x4 __attribute__((ext_vector_type(4)));
typedef unsigned u32x4 __attribute__((ext_vector_type(4)));
constexpr int BM = 256, BK = 64, HALF = 128, HTB = HALF * BK * 2  , STAGE_BYTES = 8 * HTB, NXCD = 8, WGM = 8;

__host__ __device__ __forceinline__ int lds_byte(int r, int c) { const int st = (r >> 4) * 2 + (c >> 5), rr = r & 15, cc = c & 31, ob = rr * 64 + cc * 2; return st * 1024 + (ob ^ (((ob >> 9) & 1) << 5)); }
__host__ __device__ __forceinline__ void stage_rc(int b, int& R, int& C) { const int st = b / 1024, sb = b % 1024, swz = sb ^ (((sb >> 9) & 1) << 5); R = (st >> 1) * 16 + swz / 64; C = (st & 1) * 32 + (swz % 64) / 2; }
__host__ __device__ __forceinline__ int perm32(int rho) { const int n = rho >> 4, i = rho & 15; return 8 * (i >> 2) + 4 * n + (i & 3); }

struct Unit { int pm, pn; };
struct Gemm { const bf16_t* A; const bf16_t* Bt; int M, N, K, lda, ldb; };

struct StaticOrder {
    int nM, nN, nwg, G, c;
    __host__ __device__ void init(int M, int N, int G_, int c_) { nM = M / BM; nN = N / BM; nwg = nM * nN; G = G_; c = c_; }
    __host__ __device__ bool next(int i, Unit& u) const {
        const long L = (long)i * G + c; if (L >= nwg) return false;
        int wgid = (int)L; { const int q = nwg / NXCD, r = nwg % NXCD, xcd = wgid % NXCD, off = wgid / NXCD; wgid = (xcd < r ? xcd * (q + 1) : r * (q + 1) + (xcd - r) * q) + off; }
        const int nig = WGM * nN, gid = wgid / nig, fm = gid * WGM, gsz = (nM - fm) < WGM ? (nM - fm) : WGM;
        u.pm = fm + ((wgid % nig) % gsz); u.pn = (wgid % nig) / gsz; return true;
    }
    __device__ __forceinline__ void a_ready(const Unit&) const {}
    __device__ __forceinline__ void done(const Unit&) const {}
};

__device__ __forceinline__ unsigned cvt_pk_bf16(float lo, float hi) { unsigned r; asm volatile("s_nop 0\n\tv_cvt_pk_bf16_f32 %0, %1, %2" : "=v"(r) : "v"(lo), "v"(hi)); return r; }
typedef float f32x2 __attribute__((ext_vector_type(2)));
__device__ __forceinline__ float shx(float v, int m, int lane) { return __int_as_float(__builtin_amdgcn_ds_bpermute((lane ^ m) << 2, __float_as_int(v))); }
__device__ __forceinline__ int tid_opq(int wave_s) { unsigned ones = ~0u; int w = wave_s; asm volatile("" : "+s"(ones), "+s"(w)); return w * 64 + (int)__builtin_amdgcn_mbcnt_hi(ones, __builtin_amdgcn_mbcnt_lo(ones, 0u)); }
typedef unsigned u32x2 __attribute__((ext_vector_type(2)));
constexpr int MTOK = 65536, DM = 1024, DFF = 2816;
__device__ __forceinline__ float bf_lo(unsigned w) { return __uint_as_float(w << 16); }
__device__ __forceinline__ float bf_hi(unsigned w) { return __uint_as_float(w & 0xffff0000u); }
__device__ __forceinline__ float ex2(float x) { return __builtin_amdgcn_exp2f(x); }
__device__ __forceinline__ float rcpf_(float x) { return __builtin_amdgcn_rcpf(x); }
__device__ __forceinline__ float sigm(float x) { return rcpf_(1.f + ex2(-1.44269504f * x)); }
__device__ __forceinline__ float gelu_tanh(float x) { return x * sigm(1.5957691216f * (x + 0.044715f * x * x * x)); }
__device__ __forceinline__ float row_rstd(const float* ss, int row) {
    const f32x4* p = (const f32x4*)(ss + (size_t)row * 16);
    const f32x4 a = p[0], b = p[1], c = p[2], d = p[3];
    const float s = (((a[0] + a[1]) + (a[2] + a[3])) + ((b[0] + b[1]) + (b[2] + b[3]))) + (((c[0] + c[1]) + (c[2] + c[3])) + ((d[0] + d[1]) + (d[2] + d[3])));
    return __builtin_amdgcn_rsqf(s * (1.0f / 1024.0f) + 1e-6f);
}
__device__ __forceinline__ void rstd8(const float* ss, int row0, int fr, int fq, float (&rs)[2][4]) {
    f32x4 pr[2][4];
#pragma unroll
    for (int ai = 0; ai < 2; ++ai)
#pragma unroll
        for (int m = 0; m < 4; ++m) pr[ai][m] = *(const f32x4*)(ss + (size_t)(row0 + ai * HALF + m * 16) * 16 + 4 * fq);
    const int ln = fr + 16 * fq;
#pragma unroll
    for (int ai = 0; ai < 2; ++ai)
#pragma unroll
        for (int m = 0; m < 4; ++m) { float s = (pr[ai][m][0] + pr[ai][m][1]) + (pr[ai][m][2] + pr[ai][m][3]); s += shx(s, 16, ln); s += shx(s, 32, ln);
            rs[ai][m] = __builtin_amdgcn_rsqf(s * (1.0f / 1024.0f) + 1e-6f); }
}
__device__ __forceinline__ u32x4 pack8(const f32x4 v0, const f32x4 v1) { u32x4 w; w.x = cvt_pk_bf16(v0[0], v0[1]); w.y = cvt_pk_bf16(v0[2], v0[3]); w.z = cvt_pk_bf16(v1[0], v1[1]); w.w = cvt_pk_bf16(v1[2], v1[3]); return w; }

struct EpiSwiglu {
    static constexpr bool PERM = true, AFTER_DRAIN = false, HOOK = false;
    bf16_t* O; const float* ss;
    __device__ __forceinline__ void operator()(const f32x4 (&acc)[2][2][4][2], const Unit& u, int wr, int wc, int fr, int fq) const {
        const int row0 = u.pm * BM + wr * 64 + fr, col0 = u.pn * 128 + wc * 32 + 8 * fq;
        float rsa[2][4]; rstd8(ss, row0, fr, fq, rsa);
#pragma unroll
        for (int ai = 0; ai < 2; ++ai)
#pragma unroll
            for (int m = 0; m < 4; ++m) { const int row = row0 + ai * HALF + m * 16; const float rs = rsa[ai][m];
                f32x4 o[2];
#pragma unroll
                for (int n = 0; n < 2; ++n)
#pragma unroll
                    for (int e = 0; e < 4; ++e) { const float gt = acc[ai][0][m][n][e] * rs, up = acc[ai][1][m][n][e] * rs; o[n][e] = gt * sigm(gt) * up; }
                *(u32x4*)(O + (size_t)row * DFF + col0) = pack8(o[0], o[1]); }
    }
};
struct EpiResid {
    static constexpr bool PERM = true, AFTER_DRAIN = false, HOOK = false;
    bf16_t* xb; float* ss; float alpha;
    __device__ __forceinline__ void operator()(const f32x4 (&acc)[2][2][4][2], const Unit& u, int wr, int wc, int fr, int fq) const {
        const int row0 = u.pm * BM + wr * 64 + fr, col0 = u.pn * BM + wc * 32 + 8 * fq;
#pragma unroll
        for (int ai = 0; ai < 2; ++ai) { u32x4 bw[4][2];
#pragma unroll
            for (int m = 0; m < 4; ++m)
#pragma unroll
                for (int bj = 0; bj < 2; ++bj) bw[m][bj] = *(const u32x4*)(xb + (size_t)(row0 + ai * HALF + m * 16) * DM + col0 + bj * HALF);
#pragma unroll
            for (int m = 0; m < 4; ++m) { const int row = row0 + ai * HALF + m * 16; float sq = 0.f;
#pragma unroll
                for (int bj = 0; bj < 2; ++bj) { const size_t off = (size_t)row * DM + col0 + bj * HALF; const u32x4 w = bw[m][bj];
                    const f32x4 b0 = {bf_lo(w.x), bf_hi(w.x), bf_lo(w.y), bf_hi(w.y)}, b1 = {bf_lo(w.z), bf_hi(w.z), bf_lo(w.w), bf_hi(w.w)};
                    const f32x4 o0 = b0 + acc[ai][bj][m][0] * alpha, o1 = b1 + acc[ai][bj][m][1] * alpha;
                    *(u32x4*)(xb + off) = pack8(o0, o1);
                    sq += ((o0[0] * o0[0] + o0[1] * o0[1]) + (o0[2] * o0[2] + o0[3] * o0[3])) + ((o1[0] * o1[0] + o1[1] * o1[1]) + (o1[2] * o1[2] + o1[3] * o1[3])); }
                { const int ln = fr + 16 * fq; sq += shx(sq, 16, ln); sq += shx(sq, 32, ln); }
                if (fq == 0) ss[(size_t)row * 16 + u.pn * 4 + wc] = sq; }
            asm volatile("" ::: "memory"); }
    }
};
__device__ __forceinline__ unsigned gate_frag_off(int gt, int pm, int wave, int ai, int m, int bj, int lane) {
    return ((unsigned)(gt * 256 + pm) << 17) + (unsigned)((((wave * 2 + ai) * 4 + m) * 2 + bj) * 64 + lane) * 16u;
}
struct EpiProj {
    static constexpr bool PERM = true, AFTER_DRAIN = false, HOOK = false;
    bf16_t *P, *Q, *K, *LX, *LG, *GATES; const float* ss; const float* mbias;
    __device__ __forceinline__ void operator()(const f32x4 (&acc)[2][2][4][2], const Unit& u, int wr, int wc, int fr, int fq) const {
        const int pn = u.pn; bf16_t* dst; int ld, c0, kind = 0; float sc = 1.f;
        if (pn == 0) { dst = P; ld = 256; c0 = 0; }
        else if (pn < 3) { dst = Q; ld = 512; c0 = (pn - 1) * 256; sc = 0.125f * 1.44269504f; }
        else if (pn < 5) { dst = K; ld = 512; c0 = (pn - 3) * 256; }
        else if (pn == 5) { dst = LX; ld = 256; c0 = 0; }
        else if (pn == 6) { dst = LG; ld = 256; c0 = 0; kind = 1; }
        else { dst = GATES; ld = 3072; c0 = (pn - 7) * 256; kind = 2; }
        const int row0 = u.pm * BM + wr * 64 + fr, col0 = c0 + wc * 32 + 8 * fq;
        f32x4 bv[2][2];
#pragma unroll
        for (int bj = 0; bj < 2; ++bj)
#pragma unroll
            for (int n = 0; n < 2; ++n) bv[bj][n] = (kind == 2) ? *(const f32x4*)(mbias + col0 + bj * HALF + 4 * n) : (f32x4){0.f, 0.f, 0.f, 0.f};
        float rsa[2][4]; rstd8(ss, row0, fr, fq, rsa);
#pragma unroll
        for (int ai = 0; ai < 2; ++ai)
#pragma unroll
            for (int m = 0; m < 4; ++m) { const int row = row0 + ai * HALF + m * 16; const float rs = rsa[ai][m] * sc;
#pragma unroll
                for (int bj = 0; bj < 2; ++bj) { f32x4 v[2];
#pragma unroll
                    for (int n = 0; n < 2; ++n) { v[n] = acc[ai][bj][m][n] * rs;
                        if (kind == 1) {
#pragma unroll
                            for (int e = 0; e < 4; ++e) v[n][e] = gelu_tanh(v[n][e]); }
                        else if (kind == 2) {
#pragma unroll
                            for (int e = 0; e < 4; ++e) v[n][e] = sigm(v[n][e] + bv[bj][n][e]); } }
                    if (kind == 2) *(u32x4*)((char*)GATES + gate_frag_off(pn - 7, u.pm, wr * 4 + wc, ai, m, bj, fr + 16 * fq)) = pack8(v[0], v[1]);
                    else *(u32x4*)(dst + (size_t)row * ld + col0 + bj * HALF) = pack8(v[0], v[1]); } }
    }
};
struct EpiVt {
    static constexpr bool PERM = false, AFTER_DRAIN = false, HOOK = false;
    bf16_t* Vt; const float* ss;
    __device__ __forceinline__ void operator()(const f32x4 (&acc)[2][2][4][2], const Unit& u, int wr, int wc, int fr, int fq) const {
        const int ch0 = u.pm * BM + wr * 64 + fr;
        const int tokj = u.pn * BM + (fr >> 3) * HALF + wc * 32 + ((fr >> 2) & 1) * 16 + 4 * fq + (fr & 3);
        const float rsj = row_rstd(ss, tokj);
#pragma unroll
        for (int bj = 0; bj < 2; ++bj)
#pragma unroll
            for (int n = 0; n < 2; ++n) { const int tok = u.pn * BM + bj * HALF + wc * 32 + n * 16 + 4 * fq;
                f32x4 rs;
#pragma unroll
                for (int e2 = 0; e2 < 4; ++e2) rs[e2] = __int_as_float(__builtin_amdgcn_ds_bpermute(((bj * 8 + n * 4 + e2) + 16 * fq) << 2, __float_as_int(rsj)));
                const int b = tok >> 12, s = tok & 4095, sp = (s & ~15) + 8 * (fq & 1) + 4 * (fq >> 1);
#pragma unroll
                for (int ai = 0; ai < 2; ++ai)
#pragma unroll
                    for (int m = 0; m < 4; ++m) { const int ch = ch0 + ai * HALF + m * 16; const f32x4 v = acc[ai][bj][m][n] * rs;
                        u32x2 w; w.x = cvt_pk_bf16(v[0], v[1]); w.y = cvt_pk_bf16(v[2], v[3]);
                        *(u32x2*)(Vt + ((size_t)(b * 512 + ch)) * 4096 + sp) = w; } }
    }
};
typedef _Float16 h2_t __attribute__((ext_vector_type(2)));
struct EpiGates {
    static constexpr bool PERM = true, AFTER_DRAIN = false, HOOK = false;
    unsigned* AU; const bf16_t* XF  ; const float* b_a; const float* b_x; const float* c8;
    __device__ __forceinline__ void operator()(const f32x4 (&acc)[2][2][4][2], const Unit& u, int wr, int wc, int fr, int fq) const {
        const int dir = u.pn >> 1, half = u.pn & 1; const int row0 = u.pm * BM + wr * 64 + fr, ch0 = half * 128 + wc * 32 + 8 * fq;
#pragma unroll
        for (int n = 0; n < 2; ++n) { const int ch = ch0 + 4 * n;
            const f32x4 ba = *(const f32x4*)(b_a + dir * 256 + ch), bx = *(const f32x4*)(b_x + dir * 256 + ch), cc = *(const f32x4*)(c8 + dir * 256 + ch);
            u32x2 xwa[2][4];
#pragma unroll
            for (int ai = 0; ai < 2; ++ai)
#pragma unroll
                for (int m = 0; m < 4; ++m) xwa[ai][m] = *(const u32x2*)((const char*)XF + ((unsigned)(row0 + ai * HALF + m * 16) * 1024u + (unsigned)ch) * 2u);
#pragma unroll
            for (int ai = 0; ai < 2; ++ai)
#pragma unroll
                for (int m = 0; m < 4; ++m) { const int row = row0 + ai * HALF + m * 16;
                    const u32x2 xw = xwa[ai][m];
                    const float xf[4] = {bf_lo(xw.x), bf_hi(xw.x), bf_lo(xw.y), bf_hi(xw.y)};
                    u32x4 o;
#pragma unroll
                    for (int e = 0; e < 4; ++e) { const float r = sigm(acc[ai][0][m][n][e] + ba[e]), ig = sigm(acc[ai][1][m][n][e] + bx[e]);
                        const float l2a = cc[e] * r; const float a2 = ex2(2.f * l2a); const float uu = __builtin_sqrtf(fmaxf(1.f - a2, 0.f)) * ig * xf[e];
                        h2_t hv; hv[0] = (_Float16)l2a; hv[1] = (_Float16)uu; o[e] = __builtin_bit_cast(unsigned, hv); }
                    *(u32x4*)((char*)AU + (((unsigned)dir * (unsigned)MTOK + (unsigned)row) * 256u + (unsigned)ch) * 4u) = o; }
            asm volatile("" ::: "memory"); }
    }
};
struct EpiMerged {
    static constexpr bool PERM = true, AFTER_DRAIN = false, HOOK = true;
    bf16_t* O; const bf16_t* G  ;
    __device__ __forceinline__ void hook(f32x4 (&acc)[2][2][4][2], const Unit& u, int t, int wr, int wc, int fr, int fq) const {
        const int which = (t == 4) ? 0 : 1;
#pragma unroll
        for (int ai = 0; ai < 2; ++ai) { u32x4 ga[4][2], gb[4][2];
#pragma unroll
            for (int m = 0; m < 4; ++m)
#pragma unroll
                for (int bj = 0; bj < 2; ++bj) { const unsigned go = gate_frag_off(which * 4 + u.pn, u.pm, wr * 4 + wc, ai, m, bj, fr + 16 * fq);
                    ga[m][bj] = *(const u32x4*)((const char*)G + go); gb[m][bj] = *(const u32x4*)((const char*)G + go + ((4u * 256u) << 17)); }
#pragma unroll
            for (int m = 0; m < 4; ++m)
#pragma unroll
                for (int bj = 0; bj < 2; ++bj) { const u32x4 a = ga[m][bj], b = gb[m][bj];
                    acc[ai][bj][m][0][0] *= bf_lo(a.x) * rcpf_(bf_lo(b.x)); acc[ai][bj][m][0][1] *= bf_hi(a.x) * rcpf_(bf_hi(b.x));
                    acc[ai][bj][m][0][2] *= bf_lo(a.y) * rcpf_(bf_lo(b.y)); acc[ai][bj][m][0][3] *= bf_hi(a.y) * rcpf_(bf_hi(b.y));
                    acc[ai][bj][m][1][0] *= bf_lo(a.z) * rcpf_(bf_lo(b.z)); acc[ai][bj][m][1][1] *= bf_hi(a.z) * rcpf_(bf_hi(b.z));
                    acc[ai][bj][m][1][2] *= bf_lo(a.w) * rcpf_(bf_lo(b.w)); acc[ai][bj][m][1][3] *= bf_hi(a.w) * rcpf_(bf_hi(b.w)); }
            asm volatile("" ::: "memory"); }
    }
    __device__ __forceinline__ void operator()(const f32x4 (&acc)[2][2][4][2], const Unit& u, int wr, int wc, int fr, int fq) const {
        const int row0 = u.pm * BM + wr * 64 + fr, col0 = u.pn * BM + wc * 32 + 8 * fq;
#pragma unroll
        for (int ai = 0; ai < 2; ++ai) { u32x4 g2[4][2];
#pragma unroll
            for (int m = 0; m < 4; ++m)
#pragma unroll
                for (int bj = 0; bj < 2; ++bj) g2[m][bj] = *(const u32x4*)((const char*)G + gate_frag_off(8 + u.pn, u.pm, wr * 4 + wc, ai, m, bj, fr + 16 * fq));
#pragma unroll
            for (int m = 0; m < 4; ++m) { const int row = row0 + ai * HALF + m * 16;
#pragma unroll
                for (int bj = 0; bj < 2; ++bj) { const u32x4 g = g2[m][bj];
                    f32x4 v0 = acc[ai][bj][m][0], v1 = acc[ai][bj][m][1];
                    v0[0] *= bf_lo(g.x); v0[1] *= bf_hi(g.x); v0[2] *= bf_lo(g.y); v0[3] *= bf_hi(g.y);
                    v1[0] *= bf_lo(g.z); v1[1] *= bf_hi(g.z); v1[2] *= bf_lo(g.w); v1[3] *= bf_hi(g.w);
                    *(u32x4*)(O + (size_t)row * DM + col0 + bj * HALF) = pack8(v0, v1); } }
            asm volatile("" ::: "memory"); }
    }
};
struct RowOrder {
    int c, G;
    __device__ __forceinline__ void init(int G_, int c_) { G = G_; c = c_; }
    __device__ __forceinline__ bool next(int i, Unit& u) const { const int pm = c + (i >> 2) * G; if (pm >= MTOK / BM) return false; u.pm = pm; u.pn = i & 3; return true; }
    __device__ __forceinline__ void a_ready(const Unit&) const {}
    __device__ __forceinline__ void done(const Unit&) const {}
};
template <class Epi, class Sched, bool ALIGN_EPI = false, bool SP2 = false>
__device__ __forceinline__ void gemm_phase(PG8_LAS unsigned char* lds, const Gemm g, const Sched& S, const Epi& E, int wave_s) {
    const int tid_ = tid_opq(wave_s);
    const int tid = tid_, wid = __builtin_amdgcn_readfirstlane(tid >> 6), lane = tid & 63, wr = wid >> 2, wc = wid & 3, fr = lane & 15, fq = lane >> 4;
    const int K = g.K, nt = K / BK;
    unsigned voffA[2], voffB[2];
#pragma unroll
    for (int i = 0; i < 2; ++i) { int R, C; stage_rc(tid * 16 + i * 8192, R, C); const int Rb = Epi::PERM ? ((R & ~31) + perm32(R & 31)) : R;
        voffA[i] = (unsigned)(R * g.lda + C) * 2u; voffB[i] = (unsigned)(Rb * g.ldb + C) * 2u; }
    const size_t kstep = (size_t)(BK * 2);
    const size_t hstepA = (size_t)HALF * g.lda * 2, hstepB = (size_t)HALF * g.ldb * 2;
    const size_t tstepA = 2 * hstepA, tstepB = 2 * hstepB;
    const unsigned ldsw = (unsigned)wid * 1024u;
    const int aoff = lds_byte(wr * 64 + fr, fq * 8), boff = lds_byte(wc * 32 + fr, fq * 8);
#define PG8_SA(b, h) (((b) * 2 + (h)) * HTB)
#define PG8_SB(b, h) ((4 + (b) * 2 + (h)) * HTB)
#define PG8_STAGE(bufoff, gbase, voff) do { _Pragma("unroll") for (int _i = 0; _i < 2; ++_i) \
        __builtin_amdgcn_global_load_lds((const unsigned*)((const char*)(gbase) + (voff)[_i]), (PG8_LAS unsigned*)(lds + (bufoff) + ldsw + _i * 8192), 16, 0, 0); } while (0)
#define PG8_LDA(dst, b, h) do { _Pragma("unroll") for (int m = 0; m < 4; ++m) _Pragma("unroll") for (int k = 0; k < 2; ++k) dst[m][k] = *(const PG8_LAS bf16x8*)(lds + PG8_SA(b, h) + aoff + m * 2048 + k * 1024); } while (0)
#define PG8_LDB(dst, b, h) do { _Pragma("unroll") for (int n = 0; n < 2; ++n) _Pragma("unroll") for (int k = 0; k < 2; ++k) dst[n][k] = *(const PG8_LAS bf16x8*)(lds + PG8_SB(b, h) + boff + n * 2048 + k * 1024); } while (0)
#define PG8_MMA(ai, bj, At, Bt) do { __builtin_amdgcn_s_setprio(1); _Pragma("unroll") for (int m = 0; m < 4; ++m) _Pragma("unroll") for (int n = 0; n < 2; ++n) _Pragma("unroll") for (int k = 0; k < 2; ++k) \
        acc[ai][bj][m][n] = __builtin_amdgcn_mfma_f32_16x16x32_bf16(Bt[n][k], At[m][k], acc[ai][bj][m][n], 0, 0, 0); __builtin_amdgcn_s_setprio(0); } while (0)
#define PG8_WAIT_V(n) asm volatile("s_waitcnt vmcnt(" #n ")" ::: "memory")
#define PG8_WAIT_L(n) asm volatile("s_waitcnt lgkmcnt(" #n ")" ::: "memory")
#define PG8_BAR __builtin_amdgcn_s_barrier()
#define PG8_SCHED __builtin_amdgcn_sched_barrier(0)
    Unit cur, nxt; int ui = 0;
    if (!S.next(0, cur)) return;
    f32x4 acc[2][2][4][2];
#pragma unroll
    for (int a = 0; a < 2; ++a)
#pragma unroll
        for (int b = 0; b < 2; ++b)
#pragma unroll
            for (int m = 0; m < 4; ++m)
#pragma unroll
                for (int n = 0; n < 2; ++n) acc[a][b][m][n] = (f32x4){0.f, 0.f, 0.f, 0.f};
    bf16x8 At[4][2], B0[2][2], B1[2][2];
    const char* cA = (const char*)g.A + (size_t)cur.pm * tstepA; const char* cB = (const char*)g.Bt + (size_t)cur.pn * tstepB;
    S.a_ready(cur);
    if constexpr (SP2) {
        PG8_STAGE(PG8_SB(0, 0), cB, voffB); PG8_STAGE(PG8_SB(0, 1), cB + hstepB, voffB); PG8_STAGE(PG8_SA(0, 0), cA, voffA); PG8_STAGE(PG8_SA(0, 1), cA + hstepA, voffA);
        if (wr == 1) PG8_BAR;
        PG8_WAIT_V(2); PG8_BAR;
        PG8_STAGE(PG8_SB(1, 0), cB + kstep, voffB); PG8_STAGE(PG8_SA(1, 0), cA + kstep, voffA); PG8_STAGE(PG8_SB(1, 1), cB + hstepB + kstep, voffB);
        PG8_WAIT_V(6); PG8_BAR;
    } else {
        PG8_STAGE(PG8_SB(0, 0), cB, voffB); PG8_STAGE(PG8_SA(0, 0), cA, voffA); PG8_STAGE(PG8_SB(0, 1), cB + hstepB, voffB); PG8_STAGE(PG8_SA(0, 1), cA + hstepA, voffA);
        if (wr == 1) PG8_BAR;
        PG8_WAIT_V(4); PG8_BAR;
        PG8_STAGE(PG8_SB(1, 0), cB + kstep, voffB); PG8_STAGE(PG8_SA(1, 0), cA + kstep, voffA); PG8_STAGE(PG8_SB(1, 1), cB + hstepB + kstep, voffB);
        PG8_WAIT_V(6); PG8_BAR;
    }
    for (;;) {
        const bool has_next = S.next(ui + 1, nxt);
        const char* nA = has_next ? (const char*)g.A + (size_t)nxt.pm * tstepA : cA; const char* nB = has_next ? (const char*)g.Bt + (size_t)nxt.pn * tstepB : cB;
        for (int t = 0; t < nt; t += 2) {
            const bool last = (t == nt - 2);
            if constexpr (Epi::HOOK) { if (t == 4 || t == 12) { PG8_SCHED; E.hook(acc, cur, t, wr, wc, fr, fq); PG8_SCHED; } }
            const char* a1 = cA + (size_t)(t + 1) * kstep;
            const char* a2 = last ? nA : cA + (size_t)(t + 2) * kstep; const char* b2 = last ? nB : cB + (size_t)(t + 2) * kstep;
            const char* a3 = a2 + kstep; const char* b3 = b2 + kstep;
            if (last && has_next) S.a_ready(nxt);
            if constexpr (SP2) {
            PG8_LDB(B0, 0, 0); PG8_LDB(B1, 0, 1); PG8_SCHED; PG8_LDA(At, 0, 0); PG8_STAGE(PG8_SA(1, 1), a1 + hstepA, voffA);
            PG8_WAIT_V(8); PG8_WAIT_L(0); PG8_BAR; PG8_MMA(0, 0, At, B0); PG8_MMA(0, 1, At, B1); PG8_BAR; PG8_SCHED;
            PG8_LDA(At, 0, 1); PG8_STAGE(PG8_SB(0, 0), b2, voffB); PG8_STAGE(PG8_SB(0, 1), b2 + hstepB, voffB); PG8_STAGE(PG8_SA(0, 0), a2, voffA);
            PG8_WAIT_V(8); PG8_WAIT_L(0); PG8_BAR; PG8_MMA(1, 0, At, B0); PG8_MMA(1, 1, At, B1); PG8_BAR; PG8_SCHED;
            PG8_LDB(B0, 1, 0); PG8_LDB(B1, 1, 1); PG8_SCHED; PG8_LDA(At, 1, 0); PG8_STAGE(PG8_SA(0, 1), a2 + hstepA, voffA);
            PG8_WAIT_V(8); PG8_WAIT_L(0); PG8_BAR; PG8_MMA(0, 0, At, B0); PG8_MMA(0, 1, At, B1); PG8_BAR; PG8_SCHED;
            PG8_LDA(At, 1, 1); PG8_STAGE(PG8_SB(1, 0), b3, voffB); PG8_STAGE(PG8_SB(1, 1), b3 + hstepB, voffB); PG8_STAGE(PG8_SA(1, 0), a3, voffA);
            PG8_WAIT_V(8); PG8_WAIT_L(0); PG8_BAR; PG8_MMA(1, 0, At, B0); PG8_MMA(1, 1, At, B1); PG8_BAR; PG8_SCHED;
            } else {
            PG8_LDB(B0, 0, 0); PG8_SCHED; PG8_LDA(At, 0, 0); PG8_STAGE(PG8_SA(1, 1), a1 + hstepA, voffA);
            PG8_WAIT_L(8); PG8_BAR; PG8_WAIT_L(0); PG8_MMA(0, 0, At, B0); PG8_BAR; PG8_SCHED;
            PG8_LDB(B1, 0, 1); PG8_STAGE(PG8_SB(0, 0), b2, voffB);
            PG8_BAR; PG8_WAIT_L(0); PG8_MMA(0, 1, At, B1); PG8_BAR;
            PG8_LDA(At, 0, 1); PG8_STAGE(PG8_SA(0, 0), a2, voffA);
            PG8_BAR; PG8_WAIT_L(0); PG8_MMA(1, 0, At, B0); PG8_BAR; PG8_SCHED;
            PG8_STAGE(PG8_SB(0, 1), b2 + hstepB, voffB);
            PG8_WAIT_V(6); PG8_BAR; PG8_MMA(1, 1, At, B1); PG8_BAR;
            PG8_LDB(B0, 1, 0); PG8_SCHED; PG8_LDA(At, 1, 0); PG8_STAGE(PG8_SA(0, 1), a2 + hstepA, voffA);
            PG8_WAIT_L(8); PG8_BAR; PG8_WAIT_L(0); PG8_MMA(0, 0, At, B0); PG8_BAR; PG8_SCHED;
            PG8_LDB(B1, 1, 1); PG8_STAGE(PG8_SB(1, 0), b3, voffB);
            PG8_BAR; PG8_WAIT_L(0); PG8_MMA(0, 1, At, B1); PG8_BAR;
            PG8_LDA(At, 1, 1); PG8_STAGE(PG8_SA(1, 0), a3, voffA);
            PG8_BAR; PG8_WAIT_L(0); PG8_MMA(1, 0, At, B0); PG8_BAR; PG8_SCHED;
            PG8_STAGE(PG8_SB(1, 1), b3 + hstepB, voffB);
            PG8_WAIT_V(6); PG8_BAR; PG8_MMA(1, 1, At, B1); PG8_BAR;
            }
        }
        if constexpr (ALIGN_EPI) { if (wr == 0) PG8_BAR; }
        if constexpr (!Epi::AFTER_DRAIN) { E(acc, cur, wr, wc, fr, fq); S.done(cur); }
        if (!has_next) break;
#pragma unroll
        for (int a = 0; a < 2; ++a)
#pragma unroll
            for (int b = 0; b < 2; ++b)
#pragma unroll
                for (int m = 0; m < 4; ++m)
#pragma unroll
                    for (int n = 0; n < 2; ++n) acc[a][b][m][n] = (f32x4){0.f, 0.f, 0.f, 0.f};
        cur = nxt; cA = nA; cB = nB; ++ui;
        if constexpr (ALIGN_EPI) { if (wr == 1) PG8_BAR; }
    }
    PG8_WAIT_V(0);
    if constexpr (!ALIGN_EPI) { if (wr == 0) PG8_BAR; }
    PG8_BAR;
    if constexpr (Epi::AFTER_DRAIN) { E.fused(acc, cur, wr, wc, fr, fq, lds, wid, lane); S.done(cur); }
#undef PG8_SA
#undef PG8_SB
#undef PG8_STAGE
#undef PG8_LDA
#undef PG8_LDB
#undef PG8_MMA
#undef PG8_WAIT_V
#undef PG8_WAIT_L
#undef PG8_BAR
#undef PG8_SCHED
}
}
using namespace pg8;
#define LAS __attribute__((address_space(3)))
typedef float f32x16 __attribute__((ext_vector_type(16)));
constexpr int NWAVES = 8, NTHR = 512;
constexpr int SEQ = 4096, NBATCH = 16;
constexpr int LDS_BYTES = 147456;
constexpr int LDS_SCR = 131072;
constexpr size_t MiB = 1u << 20;
constexpr size_t WS_KMAX = 32768;
constexpr size_t WS_SS = 1 * MiB, WS_W = 5 * MiB, WS_TAB = 53 * MiB, WS_XB = 54 * MiB, WS_MIX = 182 * MiB;
constexpr size_t WS_P = WS_MIX, WS_LX = WS_MIX + 32 * MiB, WS_Q = WS_MIX + 64 * MiB, WS_K = WS_MIX + 128 * MiB, WS_LG = WS_MIX + 192 * MiB,
                 WS_VT = WS_MIX + 224 * MiB, WS_BR = WS_MIX + 288 * MiB, WS_GATES = WS_MIX + 416 * MiB, WS_END = WS_MIX + 800 * MiB;
constexpr size_t WS_MERGED = WS_Q, WS_ACT = WS_MIX;
constexpr size_t WO_W1A = 0, WO_W2A = WO_W1A + 5632 * 1024, WO_WP = WO_W2A + 1024 * 2816, WO_WV = WO_WP + 4864 * 1024, WO_WG = WO_WV + 512 * 1024,
                 WO_WBR = WO_WG + 1024 * 256, WO_WO = WO_WBR + 1024 * 1024, WO_W1B = WO_WO + 1024 * 1024, WO_W2B = WO_W1B + 5632 * 1024, WO_END = WO_W2B + 1024 * 2816;
static_assert(WO_END * 2 <= 48 * MiB, "weights region");

struct Params { const float* in[26]; float* out; unsigned char* ws; };

__device__ __forceinline__ unsigned f2bf(float f) { unsigned u = __builtin_bit_cast(unsigned, f); return (u + 0x7fffu + ((u >> 16) & 1u)) >> 16; }
__device__ __forceinline__ unsigned pk2(float lo, float hi) { return f2bf(lo) | (f2bf(hi) << 16); }
__device__ __forceinline__ float wave_sum(float v, int lane) {
#pragma unroll
    for (int o = 1; o < 64; o <<= 1) v += shx(v, o, lane);
    return v;
}
__device__ __forceinline__ void transpose_block(const float* W, int ldsrc, int sc0, int k0, bf16_t* WT, int ldd, int dr0, int koff, const float* kscale, LAS float* scr, int lane) {
#pragma unroll 16
    for (int i = 0; i < 32; ++i) { const int kk = 2 * i + (lane >> 5); float v = W[(size_t)(k0 + kk) * ldsrc + sc0 + (lane & 31)]; if (kscale) v *= kscale[k0 + kk]; scr[kk * 33 + (lane & 31)] = v; }
    asm volatile("s_waitcnt lgkmcnt(0)" ::: "memory");
    const int c = lane & 7;
#pragma unroll
    for (int j = 0; j < 4; ++j) { const int n = (lane >> 3) + 8 * j; const LAS float* s = scr + (8 * c) * 33 + n;
        u32x4 o; o.x = pk2(s[0 * 33], s[1 * 33]); o.y = pk2(s[2 * 33], s[3 * 33]); o.z = pk2(s[4 * 33], s[5 * 33]); o.w = pk2(s[6 * 33], s[7 * 33]);
        *(u32x4*)(WT + (size_t)(dr0 + n) * ldd + koff + k0 + 8 * c) = o; }
    asm volatile("s_waitcnt lgkmcnt(0)" ::: "memory");
}
typedef const __attribute__((address_space(4))) Params* KPc;
__device__ __forceinline__ void convert_layer(KPc pp, int l, LAS unsigned char* lds, int G, int wave_s) {
    const int tid = tid_opq(wave_s), lane = tid & 63, wave = tid >> 6;
    LAS float* scr = (LAS float*)(lds + wave * 16384);
    bf16_t* Wb = (bf16_t*)(pp->ws + WS_W);
    const int gw = blockIdx.x * NWAVES + wave, NGW = G * NWAVES;
    constexpr int I_W1 = 16 * 176, I_W2 = 44 * 32, I_WP = 16 * 152, I_WV = 16 * 16, I_BA = 8 * 32, I_BL = 4 * 32, I_WO = 16 * 32;
    constexpr int NIT = 2 * I_W1 + 2 * I_W2 + I_WP + I_WV + I_BA + I_BL + I_WO;
    for (int it = gw; it < NIT; it += NGW) {
        int r = it;
        if (r < 2 * I_W1) { const int f = r / I_W1; r -= f * I_W1; const int kb = r / 176, nb = r % 176; const int dr0 = nb * 32, tile = dr0 >> 8, within = dr0 & 255, bj = within >> 7, j = within & 127;
            const float* src = pp->in[f ? 23 : 2] + (size_t)l * 1024 * 5632; const float* gn = pp->in[f ? 22 : 1] + l * 1024;
            transpose_block(src, 5632, bj * 2816 + tile * 128 + j, kb * 64, Wb + (f ? WO_W1B : WO_W1A), 1024, dr0, 0, gn, scr, lane); continue; }
        r -= 2 * I_W1;
        if (r < 2 * I_W2) { const int f = r / I_W2; r -= f * I_W2; const int kb = r / 32, nb = r % 32;
            const float* src = pp->in[f ? 24 : 3] + (size_t)l * 2816 * 1024;
            transpose_block(src, 1024, nb * 32, kb * 64, Wb + (f ? WO_W2B : WO_W2A), 2816, nb * 32, 0, nullptr, scr, lane); continue; }
        r -= 2 * I_W2;
        if (r < I_WP) { const int kb = r / 152, nb = r % 152; const int dr0 = nb * 32; const int sc0 = dr0 < 1280 ? dr0 : dr0 + 512;
            transpose_block(pp->in[5] + (size_t)l * 1024 * 5376, 5376, sc0, kb * 64, Wb + WO_WP, 1024, dr0, 0, pp->in[4] + l * 1024, scr, lane); continue; }
        r -= I_WP;
        if (r < I_WV) { const int kb = r / 16, nb = r % 16;
            transpose_block(pp->in[5] + (size_t)l * 1024 * 5376, 5376, 1280 + nb * 32, kb * 64, Wb + WO_WV, 1024, nb * 32, 0, pp->in[4] + l * 1024, scr, lane); continue; }
        r -= I_WV;
        if (r < I_BA) { const int kb = r / 32, nb = r % 32;
            transpose_block(pp->in[18] + (size_t)l * 512 * 1024, 1024, nb * 32, kb * 64, Wb + WO_WBR, 1024, nb * 32, 256, nullptr, scr, lane); continue; }
        r -= I_BA;
        if (r < I_BL) { const int kb = r / 32, nb = r % 32;
            transpose_block(pp->in[19] + (size_t)l * 256 * 1024, 1024, nb * 32, kb * 64, Wb + WO_WBR, 1024, nb * 32, 768, nullptr, scr, lane); continue; }
        r -= I_BL;
        { const int kb = r / 32, nb = r % 32;
            transpose_block(pp->in[21] + (size_t)l * 1024 * 1024, 1024, nb * 32, kb * 64, Wb + WO_WO, 1024, nb * 32, 0, nullptr, scr, lane); }
    }
    const int gt = blockIdx.x * NTHR + tid, NGT = G * NTHR;
    { const float* pw = pp->in[6] + (size_t)l * 4 * 64 * 64; const float* ps = pp->in[7] + l * 256; const float* wbp = pp->in[17] + (size_t)l * 256 * 1024;
      for (int i = gt; i < 256 * 1024; i += NGT) { const int n = i & 1023, k = i >> 10, g = k >> 6; const float* pr = pw + (size_t)k * 64; float s = 0.f;
#pragma unroll 16
          for (int d = 0; d < 64; ++d) s += pr[d] * ps[64 * g + d] * wbp[(size_t)(64 * g + d) * 1024 + n];
          Wb[WO_WBR + (size_t)n * 1024 + k] = (bf16_t)f2bf(s); } }
    { for (int i = gt; i < 1024 * 256; i += NGT) { const int k = i & 255, n = i >> 8, tile = n >> 8, bj = (n >> 7) & 1, j = n & 127, dir = tile >> 1, half = tile & 1, ch = half * 128 + j, gq = ch >> 6, d = ch & 63;
          const float* w = pp->in[bj ? 14 : 12] + ((size_t)(l * 2 + dir) * 4 + gq) * 64 * 64; const float v = ((k >> 6) == gq) ? w[(k & 63) * 64 + d] : 0.f;
          Wb[WO_WG + (size_t)n * 256 + k] = (bf16_t)f2bf(v); } }
    { float* tab = (float*)(pp->ws + WS_TAB); const float* lam = pp->in[16] + l * 512;
      for (int i = gt; i < 512; i += NGT) tab[i] = -8.0f * __builtin_amdgcn_logf(1.0f + ex2(-1.44269504f * lam[i])); }
}
__device__ __forceinline__ void x_to_bf16(const float* x, bf16_t* xb, float* ss, int G, int wave_s) {
    const int tid = tid_opq(wave_s), lane = tid & 63, wave = tid >> 6; const int gw = blockIdx.x * NWAVES + wave, NGW = G * NWAVES;
    for (int m0 = gw * 4; m0 < MTOK; m0 += NGW * 4) { f32x4 v[4][4];
#pragma unroll
        for (int r = 0; r < 4; ++r)
#pragma unroll
            for (int j = 0; j < 4; ++j) v[r][j] = ((const f32x4*)(x + (size_t)(m0 + r) * DM) + lane)[64 * j];
#pragma unroll
        for (int r = 0; r < 4; ++r) { u32x2* o = (u32x2*)(xb + (size_t)(m0 + r) * DM) + lane; float s = 0.f;
#pragma unroll
            for (int j = 0; j < 4; ++j) { const f32x4 q = v[r][j]; s += (q[0] * q[0] + q[1] * q[1]) + (q[2] * q[2] + q[3] * q[3]); u32x2 w; w.x = cvt_pk_bf16(q[0], q[1]); w.y = cvt_pk_bf16(q[2], q[3]); o[64 * j] = w; }
            s = wave_sum(s, lane); if (lane < 16) ss[(size_t)(m0 + r) * 16 + lane] = (lane == 0) ? s : 0.f; } }
}
__device__ __forceinline__ void final_norm(const bf16_t* xb, float* out, const float* ss, const float* g, int G, int wave_s) {
    const int tid = tid_opq(wave_s), lane = tid & 63, wave = tid >> 6; const int gw = blockIdx.x * NWAVES + wave, NGW = G * NWAVES;
    f32x4 gv[4];
#pragma unroll
    for (int j = 0; j < 4; ++j) gv[j] = ((const f32x4*)g)[lane + 64 * j];
    for (int m0 = gw * 4; m0 < MTOK; m0 += NGW * 4) { u32x2 w[4][4]; float rs[4];
#pragma unroll
        for (int r = 0; r < 4; ++r) { rs[r] = row_rstd(ss, m0 + r);
#pragma unroll
            for (int j = 0; j < 4; ++j) w[r][j] = ((const u32x2*)(xb + (size_t)(m0 + r) * DM) + lane)[64 * j]; }
#pragma unroll
        for (int r = 0; r < 4; ++r) { f32x4* o = (f32x4*)(out + (size_t)(m0 + r) * DM) + lane;
#pragma unroll
            for (int j = 0; j < 4; ++j) { const u32x2 q = w[r][j]; const f32x4 v = {bf_lo(q.x), bf_hi(q.x), bf_lo(q.y), bf_hi(q.y)}; o[64 * j] = v * rs[r] * gv[j]; } } }
}
__device__ __forceinline__ void unpack8(const u32x4 w, float* f) { f[0] = bf_lo(w.x); f[1] = bf_hi(w.x); f[2] = bf_lo(w.y); f[3] = bf_hi(w.y); f[4] = bf_lo(w.z); f[5] = bf_hi(w.z); f[6] = bf_lo(w.w); f[7] = bf_hi(w.w); }
__device__ __forceinline__ u32x4 pack8f(const float* f) { u32x4 w; w.x = cvt_pk_bf16(f[0], f[1]); w.y = cvt_pk_bf16(f[2], f[3]); w.z = cvt_pk_bf16(f[4], f[5]); w.w = cvt_pk_bf16(f[6], f[7]); return w; }
__device__ __forceinline__ void prep_phase(const bf16_t* __restrict__ P, const bf16_t* __restrict__ LX, bf16_t* __restrict__ BR, const float* __restrict__ cw, const float* __restrict__ cb, const bf16_t* __restrict__ Kb, unsigned* __restrict__ kmax2, int G, int wave_s) {
    const int tid = tid_opq(wave_s), sub = tid >> 5, c8 = (tid & 31) * 8;
#pragma unroll 2
    for (int rb = blockIdx.x; rb < MTOK / 16; rb += G) { const int row = rb * 16 + sub, t = row & (SEQ - 1), b0 = row - t;
        { const int g = c8 >> 6, hw = 1 << g; const int lo = max(t - hw, 0), hi = min(t + hw, SEQ); float sum[8] = {0, 0, 0, 0, 0, 0, 0, 0}, f[8];
#pragma unroll
          for (int o = 0; o < 16; ++o) { const int tt = t - hw + o; if (o < 2 * hw && tt >= 0 && tt < SEQ) { unpack8(*(const u32x4*)(P + (size_t)(b0 + tt) * 256 + c8), f);
#pragma unroll
              for (int e = 0; e < 8; ++e) sum[e] += f[e]; } }
          unpack8(*(const u32x4*)(P + (size_t)row * 256 + c8), f); const float inv = 1.0f / (float)(hi - lo);
#pragma unroll
          for (int e = 0; e < 8; ++e) sum[e] = sum[e] * inv - f[e];
          *(u32x4*)(BR + (size_t)row * 1024 + c8) = pack8f(sum); }
        { float a[8], f[8];
#pragma unroll
          for (int e = 0; e < 8; ++e) a[e] = cb[c8 + e];
#pragma unroll
          for (int j = 0; j < 4; ++j) { const int tt = t - 2 + j; if (tt >= 0 && tt < SEQ) { unpack8(*(const u32x4*)(LX + (size_t)(b0 + tt) * 256 + c8), f);
#pragma unroll
                  for (int e = 0; e < 8; ++e) a[e] += cw[j * 256 + c8 + e] * f[e]; } }
          *(u32x4*)(BR + (size_t)row * 1024 + 768 + c8) = pack8f(a); }
        { float f[8], g8[8]; unpack8(*(const u32x4*)(Kb + (size_t)row * 512 + 2 * c8), f); unpack8(*(const u32x4*)(Kb + (size_t)row * 512 + 2 * c8 + 8), g8); float s = 0.f;
#pragma unroll
          for (int e = 0; e < 8; ++e) s += f[e] * f[e] + g8[e] * g8[e];
          s += shx(s, 1, tid & 63); s += shx(s, 2, tid & 63);
          if ((tid & 3) == 0) { unsigned* dst = kmax2 + (row >> 12) * 8 + ((tid & 31) >> 2); const unsigned sv = __float_as_uint(s);
              if (sv > __hip_atomic_load(dst, __ATOMIC_RELAXED, __HIP_MEMORY_SCOPE_AGENT)) atomicMax(dst, sv); } }
    }
}
__device__ __forceinline__ void lau4(const u32x4 w, f32x4& a, f32x4& u) {
    const unsigned w0 = w.x, w1 = w.y, w2 = w.z, w3 = w.w;
    const h2_t h0 = __builtin_bit_cast(h2_t, w0), h1 = __builtin_bit_cast(h2_t, w1), h2 = __builtin_bit_cast(h2_t, w2), h3 = __builtin_bit_cast(h2_t, w3);
    a = (f32x4){ex2((float)h0[0]), ex2((float)h1[0]), ex2((float)h2[0]), ex2((float)h3[0])}; u = (f32x4){(float)h0[1], (float)h1[1], (float)h2[1], (float)h3[1]};
}
__device__ __forceinline__ void scan_unit(LAS unsigned char* lds, const unsigned* __restrict__ AU, const bf16_t* __restrict__ GL, bf16_t* __restrict__ BR, int b, int cg8, int wave_s) {
    const int tid = tid_opq(wave_s), cq = tid & 1, j = tid >> 1, ch = cg8 * 8 + cq * 4, t0 = j * 16;
    LAS float* sPf = (LAS float*)lds; LAS float* sHf = sPf + 2048; LAS float* sPb = sPf + 4096; LAS float* sHb = sPf + 6144; LAS float* sCf = sPf + 8192; LAS float* sCb = sPf + 10240;
    const unsigned* auf = AU + ((size_t)b * SEQ + t0) * 256 + ch; const unsigned* aub = auf + (size_t)MTOK * 256;
    u32x4 wf[16], wb[16];
#pragma unroll
    for (int s = 0; s < 16; ++s) { wf[s] = *(const u32x4*)(auf + (size_t)s * 256); wb[s] = *(const u32x4*)(aub + (size_t)s * 256); }
    { f32x4 Pp = {1.f, 1.f, 1.f, 1.f}, H = {0.f, 0.f, 0.f, 0.f};
#pragma unroll
      for (int s = 0; s < 16; ++s) { f32x4 a, u; lau4(wf[s], a, u); Pp = Pp * a; H = a * H + u; }
      *(LAS f32x4*)(sPf + j * 8 + cq * 4) = Pp; *(LAS f32x4*)(sHf + j * 8 + cq * 4) = H; }
    { f32x4 Pp = {1.f, 1.f, 1.f, 1.f}, H = {0.f, 0.f, 0.f, 0.f};
#pragma unroll
      for (int s = 15; s >= 0; --s) { f32x4 a, u; lau4(wb[s], a, u); Pp = Pp * a; H = a * H + u; }
      *(LAS f32x4*)(sPb + j * 8 + cq * 4) = Pp; *(LAS f32x4*)(sHb + j * 8 + cq * 4) = H; }
#pragma unroll
    for (int s = 0; s < 16; ++s) { asm volatile("" : "+v"(wf[s]), "+v"(wb[s])); }
    __syncthreads();
    if (tid < 16) { const int c = tid & 7; float h = 0.f;
        if (tid < 8) {
#pragma unroll 8
            for (int jj = 0; jj < 256; ++jj) { sCf[jj * 8 + c] = h; h = sPf[jj * 8 + c] * h + sHf[jj * 8 + c]; } }
        else {
#pragma unroll 8
            for (int jj = 255; jj >= 0; --jj) { sCb[jj * 8 + c] = h; h = sPb[jj * 8 + c] * h + sHb[jj * 8 + c]; } } }
    __syncthreads();
    { f32x4 h = *(const LAS f32x4*)(sCb + j * 8 + cq * 4);
#pragma unroll
      for (int s = 15; s >= 0; --s) { f32x4 a, u; lau4(wb[s], a, u); h = a * h + u; wb[s] = __builtin_bit_cast(u32x4, h); } }
    { f32x4 h = *(const LAS f32x4*)(sCf + j * 8 + cq * 4);
      for (int sb = 0; sb < 16; sb += 8) { u32x2 gw[8];
#pragma unroll
        for (int i = 0; i < 8; ++i) gw[i] = *(const u32x2*)(GL + ((size_t)b * SEQ + t0 + sb + i) * 256 + ch);
#pragma unroll
        for (int i = 0; i < 8; ++i) { const int s = sb + i; const size_t row = (size_t)b * SEQ + t0 + s; f32x4 a, u; lau4(wf[s], a, u); h = a * h + u; const f32x4 hb = __builtin_bit_cast(f32x4, wb[s]);
            const f32x4 o = {(h[0] + hb[0]) * bf_lo(gw[i].x), (h[1] + hb[1]) * bf_hi(gw[i].x), (h[2] + hb[2]) * bf_lo(gw[i].y), (h[3] + hb[3]) * bf_hi(gw[i].y)};
            u32x2 ow; ow.x = cvt_pk_bf16(o[0], o[1]); ow.y = cvt_pk_bf16(o[2], o[3]); *(u32x2*)(BR + row * 1024 + 768 + ch) = ow; } } }
    __syncthreads();
}
__device__ __forceinline__ int crow(int r, int hi) { return (r & 3) + 8 * (r >> 2) + 4 * hi; }
__device__ __forceinline__ bf16x8 pack_p(const f32x16& s, int o) {
    u32x4 w; w.x = cvt_pk_bf16(s[o + 0], s[o + 1]); w.y = cvt_pk_bf16(s[o + 2], s[o + 3]); w.z = cvt_pk_bf16(s[o + 4], s[o + 5]); w.w = cvt_pk_bf16(s[o + 6], s[o + 7]);
    return __builtin_bit_cast(bf16x8, w);
}
__device__ __forceinline__ void attn_unit(LAS unsigned char* lds, const bf16_t* Q, const bf16_t* Kb, const bf16_t* Vt, bf16_t* BR, int b, int h, int qblk, float lam, float slope2, const float* subln, float lam_init, const unsigned* kmax2, int wave_s) {
    const int tid = tid_opq(wave_s), lane = tid & 63, wid = wave_s  , r32 = lane & 31, hi = lane >> 5, mp = wid >> 2, wq = wid & 3;
    const int q0 = qblk * 128; const size_t rowbase = (size_t)b * SEQ;
    bf16x8 qf[4];
    { const bf16_t* qp = Q + (rowbase + q0 + wq * 32 + r32) * 512 + h * 128 + mp * 64 + hi * 8;
#pragma unroll
      for (int d0 = 0; d0 < 4; ++d0) qf[d0] = *(const bf16x8*)(qp + d0 * 16); }
    const int srow = tid >> 3, sc = (tid & 7) ^ ((srow >> 1) & 7);
    const bf16_t* kg = Kb + (rowbase + srow) * 512 + h * 128 + sc * 8;
    const bf16_t* vg = Vt + ((size_t)(b * 512 + h * 128 + srow)) * 4096 + sc * 8;
    const int wofs = wid * 1024;
    const int sw = (r32 >> 1) & 7;
    const int kfo = mp * 8192 + r32 * 128, vfo = 65536 + r32 * 128;
#define ATT_DMA(gp, off) __builtin_amdgcn_global_load_lds((const unsigned*)(gp), (LAS unsigned*)(lds + (off)), 16, 0, 0)
    LAS float* scr = (LAS float*)(lds + LDS_SCR + wid * 128);
    const int td = q0 >> 6;
    { const size_t k0_ = (size_t)td * 64, k1_ = k0_ + 64;
      ATT_DMA(kg + k0_ * 512, wofs); ATT_DMA(kg + k0_ * 512 + 64, 8192 + wofs); ATT_DMA(kg + k1_ * 512, 16384 + wofs); ATT_DMA(kg + k1_ * 512 + 64, 16384 + 8192 + wofs);
      ATT_DMA(vg + k0_, 65536 + wofs); ATT_DMA(vg + k0_ + (size_t)64 * 4096, 65536 + 8192 + wofs); }
    int tlo, thi;
    { float q2 = 0.f;
#pragma unroll
      for (int d0 = 0; d0 < 4; ++d0) { const u32x4 w = __builtin_bit_cast(u32x4, qf[d0]); float f[8]; unpack8(w, f);
#pragma unroll
          for (int e = 0; e < 8; ++e) q2 += f[e] * f[e]; }
      q2 += shx(q2, 32, lane);
#pragma unroll
      for (int o = 1; o < 32; o <<= 1) q2 = fmaxf(q2, shx(q2, o, lane));
      LAS float* qx = (LAS float*)(lds + LDS_SCR + 1040);
      if (lane == 0) qx[wid] = q2;
      __syncthreads();
      float qm = qx[0];
#pragma unroll
      for (int w = 1; w < 8; ++w) qm = fmaxf(qm, qx[w]);
      const float k2 = fmaxf(__uint_as_float(kmax2[b * 8 + 2 * h]), __uint_as_float(kmax2[b * 8 + 2 * h + 1]));
      const float bound = 160.0f + 2.02f * __builtin_sqrtf(qm * k2);
      const float Df = fminf(bound / slope2, 16384.0f);
      const int hi_ = (int)floorf((Df + (float)(q0 + 127)) * (1.0f / 64.0f)), lo_ = (int)ceilf(((float)(q0 - 63) - Df) * (1.0f / 64.0f));
      thi = __builtin_amdgcn_readfirstlane(hi_ > 63 ? 63 : hi_); tlo = __builtin_amdgcn_readfirstlane(lo_ < 0 ? 0 : lo_);
      if (thi < td + 1) thi = td + 1; if (tlo > td) tlo = td; }
    const int ntile = thi - tlo + 1, nr = thi - td + 1;
#define ATT_TILE(i) (((i) < nr) ? (td + (i)) : (td - 1 + nr - (i)))
#define SBAR() __builtin_amdgcn_sched_barrier(0)
#define MFMA32(a, b, c) __builtin_amdgcn_mfma_f32_32x32x16_bf16(a, b, c, 0, 0, 0)
    { const u32x4 z = (u32x4){0u, 0u, 0u, 0u}; *(LAS u32x4*)(lds + 65536 + 3 * 16384 + tid * 32) = z; *(LAS u32x4*)(lds + 65536 + 3 * 16384 + tid * 32 + 16) = z;
      const size_t k2_ = (size_t)ATT_TILE(ntile > 2 ? 2 : ntile - 1) * 64;
      ATT_DMA(kg + k2_ * 512, 32768 + wofs); ATT_DMA(kg + k2_ * 512 + 64, 32768 + 8192 + wofs); }
    asm volatile("s_waitcnt vmcnt(0) lgkmcnt(0)\n\ts_barrier" ::: "memory");
    f32x16 SA0, SA1, SB0, SB1;
#pragma unroll
    for (int r = 0; r < 16; ++r) { SA0[r] = 0.f; SA1[r] = 0.f; }
#pragma unroll
    for (int d0 = 0; d0 < 4; ++d0) { const int co = ((2 * d0 + hi) ^ sw) << 4;
        SA0 = MFMA32(*(const LAS bf16x8*)(lds + kfo + co), qf[d0], SA0); SA1 = MFMA32(*(const LAS bf16x8*)(lds + kfo + 4096 + co), qf[d0], SA1); }
    float mrun = -1e30f, lsum = 0.f; f32x16 O[4];
#pragma unroll
    for (int d = 0; d < 4; ++d)
#pragma unroll
        for (int r = 0; r < 16; ++r) O[d][r] = 0.f;
    const float qposf = (float)(q0 + wq * 32 + r32 - 4 * hi);
#define KFRAG(d0, blk) (*(const LAS bf16x8*)(kb_ + (blk) * 4096 + (((2 * (d0) + hi) ^ sw) << 4)))
#define VFRAG(g) (*(const LAS bf16x8*)(vb_ + ((g) & 3) * 4096 + (((2 * ((g) >> 2) + hi) ^ sw) << 4)))
#define ATT_BIAS(SC0, SC1, d0) do { _Pragma("unroll") for (int r = 4 * (d0); r < 4 * (d0) + 4; ++r) { const float cr_ = (float)((r & 3) + 8 * (r >> 2)); \
        if (FAST_) { SC0[r] = __builtin_fmaf(ssg_, cr_, SC0[r]); SC1[r] = __builtin_fmaf(ssg_, cr_ + 32.f, SC1[r]); mx0_ = fmaxf(mx0_, fmaxf(SC0[r], SC1[r])); } \
        else { SC0[r] = SC0[r] - slope2 * __builtin_fabsf(dq_ - cr_); SC1[r] = SC1[r] - slope2 * __builtin_fabsf(dq_ - 32.f - cr_); mx0_ = fmaxf(mx0_, fmaxf(SC0[r], SC1[r])); } } } while (0)
#define ATT_STEP(t, SC0, SC1, SN0, SN1, FAST) do { \
        constexpr bool FAST_ = (FAST) != 0; \
        const int t_ = (t); const int tile_ = ATT_TILE(t_); \
        { const int tn_ = (t_ + 3 < ntile) ? t_ + 3 : ntile - 1, tv_ = (t_ + 1 < ntile) ? t_ + 1 : ntile - 1; const int tk_ = ATT_TILE(tn_), tvt_ = ATT_TILE(tv_); const size_t kv0_ = (size_t)tk_ * 64, vv0_ = (size_t)tvt_ * 64; \
          const int kd_ = ((t_ + 3) & 3) * 16384 + wofs, vd_ = 65536 + ((t_ + 1) & 3) * 16384 + wofs; \
          ATT_DMA(kg + kv0_ * 512, kd_); ATT_DMA(kg + kv0_ * 512 + 64, kd_ + 8192); ATT_DMA(vg + vv0_, vd_); ATT_DMA(vg + vv0_ + (size_t)64 * 4096, vd_ + 8192); } \
        const LAS unsigned char* kb_ = lds + ((t_ + 1) & 3) * 16384 + kfo; const LAS unsigned char* vb_ = lds + ((t_ + 3) & 3) * 16384 + vfo; \
        const float dq_ = qposf - (float)(tile_ * 64); float mx0_ = -1e30f; \
        const float ssg_ = (t_ < nr) ? -slope2 : slope2; const float c1_ = -ssg_ * dq_; \
        bf16x8 k00_ = KFRAG(0, 0), k01_ = KFRAG(0, 1), k10_ = KFRAG(1, 0), k11_ = KFRAG(1, 1); \
        ATT_BIAS(SC0, SC1, 0); SBAR(); \
        { f32x16 z_; _Pragma("unroll") for (int r = 0; r < 16; ++r) z_[r] = 0.f; SN0 = MFMA32(k00_, qf[0], z_); SN1 = MFMA32(k01_, qf[0], z_); } \
        k00_ = KFRAG(2, 0); k01_ = KFRAG(2, 1); ATT_BIAS(SC0, SC1, 1); SBAR(); \
        SN0 = MFMA32(k10_, qf[1], SN0); SN1 = MFMA32(k11_, qf[1], SN1); \
        k10_ = KFRAG(3, 0); k11_ = KFRAG(3, 1); ATT_BIAS(SC0, SC1, 2); SBAR(); \
        SN0 = MFMA32(k00_, qf[2], SN0); SN1 = MFMA32(k01_, qf[2], SN1); \
        bf16x8 v0_ = VFRAG(0), v1_ = VFRAG(1); ATT_BIAS(SC0, SC1, 3); SBAR(); \
        SN0 = MFMA32(k10_, qf[3], SN0); SN1 = MFMA32(k11_, qf[3], SN1); \
        float mt_ = FAST_ ? (mx0_ + c1_) : mx0_; \
        mt_ = fmaxf(mt_, shx(mt_, 32, lane)); \
        const bool resc_ = __any(mt_ > mrun); \
        { const float mn_ = fmaxf(mrun, mt_), al_ = ex2(mrun - mn_); lsum *= al_; mrun = mn_; if (hi == 0) scr[r32] = al_; } \
        const float mo0_ = FAST_ ? (mrun - c1_) : mrun; \
        SBAR(); \
        _Pragma("unroll") for (int g = 0; g < 16; ++g) { const int c_ = g >> 2, d_ = g & 3; \
            bf16x8 v2_ = v0_; if (g < 14) v2_ = VFRAG(g + 2); \
            O[d_] = MFMA32(PK[c_], v0_, O[d_]); \
            if (g < 8) { SC0[2 * g] = ex2(SC0[2 * g] - mo0_); SC0[2 * g + 1] = ex2(SC0[2 * g + 1] - mo0_); lsum += SC0[2 * g] + SC0[2 * g + 1]; } \
            else { SC1[2 * g - 16] = ex2(SC1[2 * g - 16] - mo0_); SC1[2 * g - 15] = ex2(SC1[2 * g - 15] - mo0_); lsum += SC1[2 * g - 16] + SC1[2 * g - 15]; } \
            if (g == 3) PK[0] = pack_p(SC0, 0); if (g == 7) PK[1] = pack_p(SC0, 8); if (g == 11) PK[2] = pack_p(SC1, 0); if (g == 15) PK[3] = pack_p(SC1, 8); \
            v0_ = v1_; v1_ = v2_; SBAR(); } \
        if (resc_) { f32x4 al4_[4]; \
            _Pragma("unroll") for (int jq = 0; jq < 4; ++jq) al4_[jq] = *(const LAS f32x4*)(scr + 8 * jq + 4 * hi); \
            _Pragma("unroll") for (int d = 0; d < 4; ++d) _Pragma("unroll") for (int r = 0; r < 16; ++r) O[d][r] *= al4_[r >> 2][r & 3]; } \
        asm volatile("s_waitcnt vmcnt(4) lgkmcnt(0)\n\ts_barrier" ::: "memory");     \
    } while (0)
    bf16x8 PK[4];
#pragma unroll
    for (int c = 0; c < 4; ++c) PK[c] = (bf16x8){0, 0, 0, 0, 0, 0, 0, 0};
    ATT_STEP(0, SA0, SA1, SB0, SB1, 0);
    ATT_STEP(1, SB0, SB1, SA0, SA1, 0);
    for (int t = 2; t < ntile; t += 2) {
        ATT_STEP(t, SA0, SA1, SB0, SB1, 1);
        if (t + 1 >= ntile) break;
        ATT_STEP(t + 1, SB0, SB1, SA0, SA1, 1);
    }
    { const LAS unsigned char* vb_ = lds + ((ntile - 1) & 3) * 16384 + vfo;
#pragma unroll
      for (int c = 0; c < 4; ++c)
#pragma unroll
          for (int d = 0; d < 4; ++d) { const bf16x8 vf = *(const LAS bf16x8*)(vb_ + d * 4096 + (((2 * c + hi) ^ sw) << 4)); O[d] = MFMA32(PK[c], vf, O[d]); } }
    lsum += shx(lsum, 32, lane);
    if (hi == 0) scr[r32] = rcpf_(lsum);
    __builtin_amdgcn_wave_barrier();
    { f32x4 al[4];
#pragma unroll
      for (int jq = 0; jq < 4; ++jq) al[jq] = *(const LAS f32x4*)(scr + 8 * jq + 4 * hi);
#pragma unroll
      for (int d = 0; d < 4; ++d)
#pragma unroll
          for (int r = 0; r < 16; ++r) O[d][r] *= al[r >> 2][r & 3]; }
    asm volatile("s_waitcnt vmcnt(0)" ::: "memory");
    __syncthreads();
    LAS float* C = (LAS float*)lds;
    if (mp == 1) {
#pragma unroll
        for (int d = 0; d < 4; ++d)
#pragma unroll
            for (int r = 0; r < 16; ++r) C[(wq * 32 + crow(r, hi)) * 132 + d * 32 + r32] = O[d][r]; }
    __syncthreads();
    if (mp == 0) {
#pragma unroll
        for (int d = 0; d < 4; ++d)
#pragma unroll
            for (int r = 0; r < 16; ++r) { const int ix = (wq * 32 + crow(r, hi)) * 132 + d * 32 + r32; C[ix] = O[d][r] - lam * C[ix]; } }
    __syncthreads();
    { float li_ = lam_init; asm volatile("" : "+s"(li_)); const float outscale = 1.0f - li_;
      const int tid2 = tid_opq(wave_s); const int row = tid2 >> 2, part = tid2 & 3; const LAS float* cp = C + row * 132 + part * 32; float v[32]; float sq = 0.f;
#pragma unroll
      for (int jq = 0; jq < 8; ++jq) { const f32x4 x = *(const LAS f32x4*)(cp + 4 * jq); v[4 * jq] = x[0]; v[4 * jq + 1] = x[1]; v[4 * jq + 2] = x[2]; v[4 * jq + 3] = x[3]; sq += (x[0] * x[0] + x[1] * x[1]) + (x[2] * x[2] + x[3] * x[3]); }
      sq += shx(sq, 1, tid2 & 63); sq += shx(sq, 2, tid2 & 63);
      const float rs = __builtin_amdgcn_rsqf(sq * (1.0f / 128.0f) + 1e-5f) * outscale;
      bf16_t* op = BR + (rowbase + q0 + row) * 1024 + 256 + h * 128 + part * 32;
#pragma unroll
      for (int jq = 0; jq < 4; ++jq) { float f[8];
#pragma unroll
          for (int e = 0; e < 8; ++e) f[e] = v[8 * jq + e] * rs * subln[part * 32 + 8 * jq + e];
          *(u32x4*)(op + 8 * jq) = pack8f(f); } }
    __syncthreads();
#undef ATT_TILE
#undef ATT_DMA
#undef ATT_STEP
#undef ATT_BIAS
#undef KFRAG
#undef VFRAG
#undef SBAR
#undef MFMA32
}

typedef const __attribute__((address_space(4))) Params* KP;
__device__ __forceinline__ KP kparams() { auto k = __builtin_amdgcn_kernarg_segment_ptr(); asm volatile("" : "+s"(k)); return (KP)k; }
#define WSP(T, off) ((T*)(kp->ws + (off)))
#define RLX_AGENT __ATOMIC_RELAXED, __HIP_MEMORY_SCOPE_AGENT
#define XB_TMO      128
#define XB_XCNT(j)  (256  + 64 * (j))
#define XB_XSUB(j)  (1280 + 64 * (j))
#define XB_XGEN(j)  (2304 + 64 * (j))
#define XB_TOP      3328
#define XB_TOPGEN   3392
#define XCD_BAR_WORDS 3456
#define XB_SPIN_CAP (1u << 18)

__device__ __forceinline__ unsigned xb_ld(unsigned* p)              { return __hip_atomic_load(p, __ATOMIC_RELAXED, __HIP_MEMORY_SCOPE_AGENT); }
__device__ __forceinline__ unsigned xb_add(unsigned* p, unsigned v) { return __hip_atomic_fetch_add(p, v, __ATOMIC_RELAXED, __HIP_MEMORY_SCOPE_AGENT); }
__device__ __forceinline__ unsigned xb_xcc_id() { return (unsigned)__builtin_amdgcn_s_getreg((3 << 11) | 20) & 0xFu; }
#define XB_SPIN(cond, bar) do { unsigned _sp = 0; while (cond) { __builtin_amdgcn_s_sleep(1); \
    if ((++_sp & 255u) == 0u) { if (xb_ld(&(bar)[XB_TMO])) break; if (_sp > XB_SPIN_CAP) { atomicAdd(&(bar)[XB_TMO], 1u); break; } } } } while (0)

struct XcdBarrier {
    unsigned* bar; unsigned x;
    volatile LAS unsigned* st;
};

__device__ __forceinline__ XcdBarrier xcd_barrier_post(unsigned* bar, volatile LAS unsigned* st, int tid) {
    XcdBarrier b; b.bar = bar; b.x = xb_xcc_id(); b.st = st;
    if (tid == 0) (void)xb_add(&bar[XB_XCNT(b.x)], 1u);
    return b;
}
__device__ __forceinline__ void xcd_barrier_complete(unsigned* bar, unsigned x, unsigned& nloc, unsigned& nx) {
    const unsigned G = gridDim.x * gridDim.y * gridDim.z;
    unsigned sum, cnt, mine, sp = 0u;
    for (;;) {
        sum = 0u; cnt = 0u; mine = 0u;
#pragma unroll
        for (unsigned j = 0; j < 16; ++j) { const unsigned c = xb_ld(&bar[XB_XCNT(j)]); sum += c; cnt += (c > 0u) ? 1u : 0u; mine = (j == x) ? c : mine; }
        if (sum == G) break;
        __builtin_amdgcn_s_sleep(1);
        if ((++sp & 255u) == 0u) { if (xb_ld(&bar[XB_TMO])) break; if (sp > XB_SPIN_CAP) { atomicAdd(&bar[XB_TMO], 1u); break; } }
    }
    nloc = mine > 0u ? mine : 1u; nx = cnt > 0u ? cnt : 1u;
}

__device__ __forceinline__ void xcd_barrier(const XcdBarrier& b, int tid) {
    asm volatile("s_waitcnt vmcnt(0)" ::: "memory");
    __syncthreads();
    if (tid == 0) {
        unsigned* bar = b.bar;
        __builtin_amdgcn_s_waitcnt(0);
        unsigned nloc = b.st[0], nx = b.st[1];
        if (nloc == 0u) { xcd_barrier_complete(bar, b.x, nloc, nx); b.st[0] = nloc; b.st[1] = nx; }
        const unsigned old = xb_add(&bar[XB_XSUB(b.x)], 1u);
        const unsigned gen = old / nloc;
        if (old + 1u == (gen + 1u) * nloc) {
            __builtin_amdgcn_fence(__ATOMIC_RELEASE, "agent");
            asm volatile("s_waitcnt vmcnt(0)" ::: "memory");
            const unsigned og = xb_add(&bar[XB_TOP], 1u);
            const unsigned tg = og / nx;
            if (og + 1u == (tg + 1u) * nx) xb_add(&bar[XB_TOPGEN], 1u);
            else XB_SPIN(xb_ld(&bar[XB_TOPGEN]) == tg, bar);
            __builtin_amdgcn_fence(__ATOMIC_ACQUIRE, "agent");
            xb_add(&bar[XB_XGEN(b.x)], 1u);
            asm volatile("s_waitcnt vmcnt(0)" ::: "memory");
        } else {
            XB_SPIN(xb_ld(&bar[XB_XGEN(b.x)]) == gen, bar);
            __builtin_amdgcn_fence(__ATOMIC_ACQUIRE, "agent");
            asm volatile("s_waitcnt vmcnt(0)" ::: "memory");
        }
    }
    __syncthreads();
}
constexpr int LDS_BARST = LDS_SCR + 1024;
__device__ __forceinline__ void xsync(LAS unsigned char* lds, int wave_s) {
    KP kp = kparams(); XcdBarrier b; b.bar = (unsigned*)kp->ws; b.x = xb_xcc_id(); b.st = (volatile LAS unsigned*)(lds + LDS_BARST);
    xcd_barrier(b, tid_opq(wave_s));
}
#ifdef DUP_SYNC
#define GSYNC() do { xsync(lds, wave_s); xsync(lds, wave_s); } while (0)
#else
#define GSYNC() xsync(lds, wave_s)
#endif
#ifndef REP_SMALL
#define REP_SMALL 1
#endif
#ifndef REP_PROJ
#define REP_PROJ 1
#endif
#ifndef REP_MERGED
#define REP_MERGED 1
#endif
#ifndef REP_OUT
#define REP_OUT 1
#endif
#ifndef REP_XF
#define REP_XF 1
#endif
#ifndef REP_FFN2
#define REP_FFN2 1
#endif
#ifdef DUP_ATTN
#define ATT_REPS 2
#else
#define ATT_REPS 1
#endif
#ifdef DUP_FFN1
#define FFN1_REPS 2
#else
#define FFN1_REPS 1
#endif
__global__ void __launch_bounds__(NTHR, 2) fwd_megakernel(Params p_unused) {
    extern __shared__ __attribute__((aligned(16))) unsigned char lds_raw[];
    LAS unsigned char* lds = (LAS unsigned char*)lds_raw;
    cg::grid_group grid = cg::this_grid();
    const int wave_s = __builtin_amdgcn_readfirstlane((int)(threadIdx.x >> 6));
    { const int t0 = tid_opq(wave_s); if (t0 < 2) ((LAS unsigned*)(lds + LDS_BARST))[t0] = 0u; __syncthreads();
      KP kp = kparams(); (void)xcd_barrier_post((unsigned*)kp->ws, (volatile LAS unsigned*)(lds + LDS_BARST), t0); }
    for (int l = 0; l < 2; ++l) {
        { KP kp = kparams(); const int G = gridDim.x;
#ifndef SKIP_CONV
for (int rep_ = 0; rep_ < (REP_SMALL); ++rep_)
          convert_layer(kp, l, lds, G, wave_s);
#endif
          for (int rep_ = 0; rep_ < (REP_XF); ++rep_)
          if (l == 0) x_to_bf16(kp->in[0], WSP(bf16_t, WS_XB), WSP(float, WS_SS), G, wave_s); }
        if (l == 0) grid.sync(); else GSYNC();
        for (int f = 0; f < 2; ++f) {
            if (f == 1) {
#ifndef SKIP_PROJ
for (int rep_ = 0; rep_ < (REP_PROJ); ++rep_)
                { KP kp = kparams(); const int G = gridDim.x, bid = blockIdx.x; bf16_t* Wb = WSP(bf16_t, WS_W);
                  Gemm g{WSP(bf16_t, WS_XB), Wb + WO_WP, MTOK, 4864, 1024, 1024, 1024}; StaticOrder S; S.init(MTOK, 4864, G, bid);
                  EpiProj E{WSP(bf16_t, WS_P), WSP(bf16_t, WS_Q), WSP(bf16_t, WS_K), WSP(bf16_t, WS_LX), WSP(bf16_t, WS_LG), WSP(bf16_t, WS_GATES), WSP(float, WS_SS), kp->in[20] + l * 3072};
                  gemm_phase<EpiProj, StaticOrder, true, true>(lds, g, S, E, wave_s); }
#endif
#ifndef SKIP_VT
for (int rep_ = 0; rep_ < (REP_PROJ); ++rep_)
                { KP kp = kparams(); const int G = gridDim.x, bid = blockIdx.x; bf16_t* Wb = WSP(bf16_t, WS_W);
                  Gemm g{Wb + WO_WV, WSP(bf16_t, WS_XB), 512, MTOK, 1024, 1024, 1024}; StaticOrder S; S.init(512, MTOK, G, bid);
                  EpiVt E{WSP(bf16_t, WS_VT), WSP(float, WS_SS)};
                  gemm_phase<EpiVt, StaticOrder, true, true>(lds, g, S, E, wave_s); }
#endif
                GSYNC();
#ifndef SKIP_PREP
for (int rep_ = 0; rep_ < (REP_SMALL); ++rep_)
                { KP kp = kparams(); prep_phase(WSP(bf16_t, WS_P), WSP(bf16_t, WS_LX), WSP(bf16_t, WS_BR), kp->in[10] + l * 1024, kp->in[11] + l * 256, WSP(bf16_t, WS_K), WSP(unsigned, WS_KMAX) + l * 128, gridDim.x, wave_s); }
#endif
                GSYNC();
#ifndef SKIP_GATES
for (int rep_ = 0; rep_ < (REP_SMALL); ++rep_)
                { KP kp = kparams(); const int G = gridDim.x, bid = blockIdx.x; bf16_t* Wb = WSP(bf16_t, WS_W); bf16_t* BR = WSP(bf16_t, WS_BR);
                  int Kg = 256; asm volatile("" : "+s"(Kg));
                  Gemm g{BR + 768, Wb + WO_WG, MTOK, 1024, Kg, 1024, 256}; StaticOrder S; S.init(MTOK, 1024, G, bid);
                  EpiGates E{((unsigned*)kp->out)  , BR + 768, kp->in[13] + l * 512, kp->in[15] + l * 512, WSP(float, WS_TAB)};
                  gemm_phase<EpiGates, StaticOrder, true, true>(lds, g, S, E, wave_s); }
#endif
                GSYNC();
#ifndef SKIP_SCAN
for (int rep_ = 0; rep_ < (REP_SMALL); ++rep_)
                { KP kp = kparams(); const int G = gridDim.x, bid = blockIdx.x;
                  for (int u = bid; u < 512; u += G) { const int v = u & 255, k = u >> 8; scan_unit(lds, ((unsigned*)kp->out), WSP(bf16_t, WS_LG), WSP(bf16_t, WS_BR), (v & 7) + 8 * k, v >> 3, wave_s); } }
#endif
#ifndef SKIP_ATTN
                { KP kp = kparams(); const int G = gridDim.x, bid = blockIdx.x;
                  int ll = l; asm volatile("" : "+s"(ll)); const int lane = tid_opq(wave_s) & 63;
                  const float* lp = kp->in[8] + ll * 256;
                  const float s1 = wave_sum(lp[lane] * lp[64 + lane], lane), s2 = wave_sum(lp[128 + lane] * lp[192 + lane], lane);
                  int lib_ = (ll == 0) ? 0x3e4ccccd   : 0x3eb60549  ; asm volatile("" : "+s"(lib_)); const float lam_init = __int_as_float(lib_);     const float lam = __uint_as_float(__builtin_amdgcn_readfirstlane(__float_as_uint(ex2(1.44269504f * s1) - ex2(1.44269504f * s2) + lam_init)));
                  for (int rep = 0; rep < ATT_REPS; ++rep)
                  for (int u = bid; u < 2048; u += G) { const int x = u & 7, k = u >> 8, slot = (((u >> 3) & 31) + 16 * (k >> 2)) & 31, pair = 8 * k + ((x + k) & 7), b = pair >> 2, h = pair & 3;
                      const float slope2 = __uint_as_float(__builtin_amdgcn_readfirstlane(__float_as_uint(ex2(-2.0f * (float)(h + 1)) * 1.44269504f)));
                      attn_unit(lds, WSP(bf16_t, WS_Q), WSP(bf16_t, WS_K), WSP(bf16_t, WS_VT), WSP(bf16_t, WS_BR), b, h, slot, lam, slope2, kp->in[9] + ll * 128, lam_init, WSP(unsigned, WS_KMAX) + ll * 128, wave_s); } }
#endif
                GSYNC();
#ifndef SKIP_MERGED
for (int rep_ = 0; rep_ < (REP_MERGED); ++rep_)
                { KP kp = kparams(); const int G = gridDim.x, bid = blockIdx.x; bf16_t* Wb = WSP(bf16_t, WS_W);
                  Gemm g{WSP(bf16_t, WS_BR), Wb + WO_WBR, MTOK, 1024, 1024, 1024, 1024}; RowOrder S; S.init(G, bid);
                  EpiMerged E{WSP(bf16_t, WS_MERGED), WSP(bf16_t, WS_GATES)};
                  gemm_phase<EpiMerged, RowOrder, true, true>(lds, g, S, E, wave_s); }
#endif
                { asm volatile("s_waitcnt vmcnt(0)" ::: "memory"); __syncthreads(); __builtin_amdgcn_fence(__ATOMIC_ACQUIRE, "agent"); asm volatile("s_waitcnt vmcnt(0)" ::: "memory"); __syncthreads(); }
#ifndef SKIP_OUT
                for (int rep_ = 0; rep_ < (REP_OUT); ++rep_)
                { KP kp = kparams(); const int G = gridDim.x, bid = blockIdx.x; bf16_t* Wb = WSP(bf16_t, WS_W);
                  Gemm g{WSP(bf16_t, WS_MERGED), Wb + WO_WO, MTOK, 1024, 1024, 1024, 1024}; RowOrder S; S.init(G, bid);
                  EpiResid E{WSP(bf16_t, WS_XB), WSP(float, WS_SS), (rep_ + 1 < (REP_OUT)) ? 0.0f : 1.0f};
                  gemm_phase<EpiResid, RowOrder, true, true>(lds, g, S, E, wave_s); }
#endif
                GSYNC();
            }
#ifndef SKIP_FFN1
            for (int rep = 0; rep < FFN1_REPS; ++rep)
            { KP kp = kparams(); const int G = gridDim.x, bid = blockIdx.x; bf16_t* Wb = WSP(bf16_t, WS_W);
              Gemm g{WSP(bf16_t, WS_XB), Wb + (f ? WO_W1B : WO_W1A), MTOK, 5632, 1024, 1024, 1024}; StaticOrder S; S.init(MTOK, 5632, G, bid);
              EpiSwiglu E{WSP(bf16_t, WS_ACT), WSP(float, WS_SS)};
              gemm_phase<EpiSwiglu, StaticOrder, true, true>(lds, g, S, E, wave_s); }
#endif
            GSYNC();
#ifndef SKIP_FFN2
            for (int rep_ = 0; rep_ < (REP_FFN2); ++rep_)
            { KP kp = kparams(); const int G = gridDim.x, bid = blockIdx.x; bf16_t* Wb = WSP(bf16_t, WS_W);
              Gemm g{WSP(bf16_t, WS_ACT), Wb + (f ? WO_W2B : WO_W2A), MTOK, 1024, 2816, 2816, 2816}; StaticOrder S; S.init(MTOK, 1024, G, bid);
              EpiResid E{WSP(bf16_t, WS_XB), WSP(float, WS_SS), 0.5f};
              gemm_phase<EpiResid, StaticOrder, true, true>(lds, g, S, E, wave_s); }
#endif
            GSYNC();
        }
    }
    for (int rep_ = 0; rep_ < (REP_XF); ++rep_)
    { KP kp = kparams(); final_norm(WSP(bf16_t, WS_XB), kp->out, WSP(float, WS_SS), kp->in[25], gridDim.x, wave_s); }
}

extern "C" void kernel_launch(void* const* d_in, const int* in_sizes, int n_in, void* d_out, int out_size, void* d_ws, size_t ws_size, hipStream_t stream) {
    static int grid = 0;
    if (grid == 0) {
        if (n_in != 26 || out_size != MTOK * DM || ws_size < WS_END) { fprintf(stderr, "kernel_launch: unexpected shapes (n_in %d, out %d, ws %zu)\n", n_in, out_size, ws_size); grid = -1; return; }
        int dev = 0, cus = 0, per_cu = 0;
        hipGetDevice(&dev); hipDeviceGetAttribute(&cus, hipDeviceAttributeMultiprocessorCount, dev);
        hipFuncSetAttribute((const void*)fwd_megakernel, hipFuncAttributeMaxDynamicSharedMemorySize, LDS_BYTES);
        hipOccupancyMaxActiveBlocksPerMultiprocessor(&per_cu, (const void*)fwd_megakernel, NTHR, LDS_BYTES);
        if (per_cu < 1) per_cu = 1;
        grid = cus * per_cu;
    }
    if (grid < 0) return;
    if (hipMemsetAsync(d_ws, 0, 65536, stream) != hipSuccess) { fprintf(stderr, "kernel_launch: memset of the barrier words failed\n"); return; }
    Params p{};
    for (int i = 0; i < 26; ++i) p.in[i] = (const float*)d_in[i];
    p.out = (float*)d_out; p.ws = (unsigned char*)d_ws;
    void* args[] = {&p};
    hipError_t e = hipLaunchCooperativeKernel((const void*)fwd_megakernel, dim3(grid), dim3(NTHR), args, LDS_BYTES, stream);
    if (e != hipSuccess) fprintf(stderr, "cooperative launch failed: %s (grid %d)\n", hipGetErrorString(e), grid);
}
```

```cpp
#include <hip/hip_runtime.h>
#include <hip/hip_cooperative_groups.h>
#include <cstdio>
#include <cstdint>
#include <cmath>
namespace cg = cooperative_groups;
namespace pg8 {
#define PG8_LAS __attribute__((address_space(3)))
typedef unsigned short bf16_t;
typedef short bf16x8 __attribute__((ext_vector_type(8)));
typedef float f32x4 __attribute__((ext_vector_type(4)));
typedef unsigned u32x4 __attribute__((ext_vector_type(4)));
constexpr int BM = 256, BK = 64, HALF = 128, HTB = HALF * BK * 2  , STAGE_BYTES = 8 * HTB, NXCD = 8, WGM = 8;

__host__ __device__ __forceinline__ int lds_byte(int r, int c) { const int st = (r >> 4) * 2 + (c >> 5), rr = r & 15, cc = c & 31, ob = rr * 64 + cc * 2; return st * 1024 + (ob ^ (((ob >> 9) & 1) << 5)); }
__host__ __device__ __forceinline__ void stage_rc(int b, int& R, int& C) { const int st = b / 1024, sb = b % 1024, swz = sb ^ (((sb >> 9) & 1) << 5); R = (st >> 1) * 16 + swz / 64; C = (st & 1) * 32 + (swz % 64) / 2; }
__host__ __device__ __forceinline__ int perm32(int rho) { const int n = rho >> 4, i = rho & 15; return 8 * (i >> 2) + 4 * n + (i & 3); }

struct Unit { int pm, pn; };
struct Gemm { const bf16_t* A; const bf16_t* Bt; int M, N, K, lda, ldb; };

struct StaticOrder {
    int nM, nN, nwg, G, c;
    __host__ __device__ void init(int M, int N, int G_, int c_) { nM = M / BM; nN = N / BM; nwg = nM * nN; G = G_; c = c_; }
    __host__ __device__ bool next(int i, Unit& u) const {
        const long L = (long)i * G + c; if (L >= nwg) return false;
        int wgid = (int)L; { const int q = nwg / NXCD, r = nwg % NXCD, xcd = wgid % NXCD, off = wgid / NXCD; wgid = (xcd < r ? xcd * (q + 1) : r * (q + 1) + (xcd - r) * q) + off; }
        const int nig = WGM * nN, gid = wgid / nig, fm = gid * WGM, gsz = (nM - fm) < WGM ? (nM - fm) : WGM;
        u.pm = fm + ((wgid % nig) % gsz); u.pn = (wgid % nig) / gsz; return true;
    }
    __device__ __forceinline__ void a_ready(const Unit&) const {}
    __device__ __forceinline__ void done(const Unit&) const {}
};

__device__ __forceinline__ unsigned cvt_pk_bf16(float lo, float hi) { unsigned r; asm volatile("s_nop 0\n\tv_cvt_pk_bf16_f32 %0, %1, %2" : "=v"(r) : "v"(lo), "v"(hi)); return r; }
typedef float f32x2 __attribute__((ext_vector_type(2)));
__device__ __forceinline__ float shx(float v, int m, int lane) { return __int_as_float(__builtin_amdgcn_ds_bpermute((lane ^ m) << 2, __float_as_int(v))); }
__device__ __forceinline__ int tid_opq(int wave_s) { unsigned ones = ~0u; int w = wave_s; asm volatile("" : "+s"(ones), "+s"(w)); return w * 64 + (int)__builtin_amdgcn_mbcnt_hi(ones, __builtin_amdgcn_mbcnt_lo(ones, 0u)); }
typedef unsigned u32x2 __attribute__((ext_vector_type(2)));
constexpr int MTOK = 65536, DM = 1024, DFF = 2816;
__device__ __forceinline__ float bf_lo(unsigned w) { return __uint_as_float(w << 16); }
__device__ __forceinline__ float bf_hi(unsigned w) { return __uint_as_float(w & 0xffff0000u); }
__device__ __forceinline__ float ex2(float x) { return __builtin_amdgcn_exp2f(x); }
__device__ __forceinline__ float rcpf_(float x) { return __builtin_amdgcn_rcpf(x); }
__device__ __forceinline__ float sigm(float x) { return rcpf_(1.f + ex2(-1.44269504f * x)); }
__device__ __forceinline__ float gelu_tanh(float x) { return x * sigm(1.5957691216f * (x + 0.044715f * x * x * x)); }
__device__ __forceinline__ float row_rstd(const float* ss, int row) {
    const f32x4* p = (const f32x4*)(ss + (size_t)row * 16);
    const f32x4 a = p[0], b = p[1], c = p[2], d = p[3];
    const float s = (((a[0] + a[1]) + (a[2] + a[3])) + ((b[0] + b[1]) + (b[2] + b[3]))) + (((c[0] + c[1]) + (c[2] + c[3])) + ((d[0] + d[1]) + (d[2] + d[3])));
    return __builtin_amdgcn_rsqf(s * (1.0f / 1024.0f) + 1e-6f);
}
__device__ __forceinline__ void rstd8(const float* ss, int row0, int fr, int fq, float (&rs)[2][4]) {
    f32x4 pr[2][4];
#pragma unroll
    for (int ai = 0; ai < 2; ++ai)
#pragma unroll
        for (int m = 0; m < 4; ++m) pr[ai][m] = *(const f32x4*)(ss + (size_t)(row0 + ai * HALF + m * 16) * 16 + 4 * fq);
    const int ln = fr + 16 * fq;
#pragma unroll
    for (int ai = 0; ai < 2; ++ai)
#pragma unroll
        for (int m = 0; m < 4; ++m) { float s = (pr[ai][m][0] + pr[ai][m][1]) + (pr[ai][m][2] + pr[ai][m][3]); s += shx(s, 16, ln); s += shx(s, 32, ln);
            rs[ai][m] = __builtin_amdgcn_rsqf(s * (1.0f / 1024.0f) + 1e-6f); }
}
__device__ __forceinline__ u32x4 pack8(const f32x4 v0, const f32x4 v1) { u32x4 w; w.x = cvt_pk_bf16(v0[0], v0[1]); w.y = cvt_pk_bf16(v0[2], v0[3]); w.z = cvt_pk_bf16(v1[0], v1[1]); w.w = cvt_pk_bf16(v1[2], v1[3]); return w; }

struct EpiSwiglu {
    static constexpr bool PERM = true, AFTER_DRAIN = false, HOOK = false;
    bf16_t* O; const float* ss;
    __device__ __forceinline__ void operator()(const f32x4 (&acc)[2][2][4][2], const Unit& u, int wr, int wc, int fr, int fq) const {
        const int row0 = u.pm * BM + wr * 64 + fr, col0 = u.pn * 128 + wc * 32 + 8 * fq;
        float rsa[2][4]; rstd8(ss, row0, fr, fq, rsa);
#pragma unroll
        for (int ai = 0; ai < 2; ++ai)
#pragma unroll
            for (int m = 0; m < 4; ++m) { const int row = row0 + ai * HALF + m * 16; const float rs = rsa[ai][m];
                f32x4 o[2];
#pragma unroll
                for (int n = 0; n < 2; ++n)
#pragma unroll
                    for (int e = 0; e < 4; ++e) { const float gt = acc[ai][0][m][n][e] * rs, up = acc[ai][1][m][n][e] * rs; o[n][e] = gt * sigm(gt) * up; }
                *(u32x4*)(O + (size_t)row * DFF + col0) = pack8(o[0], o[1]); }
    }
};
struct EpiResid {
    static constexpr bool PERM = true, AFTER_DRAIN = false, HOOK = false;
    bf16_t* xb; float* ss; float alpha;
    __device__ __forceinline__ void operator()(const f32x4 (&acc)[2][2][4][2], const Unit& u, int wr, int wc, int fr, int fq) const {
        const int row0 = u.pm * BM + wr * 64 + fr, col0 = u.pn * BM + wc * 32 + 8 * fq;
#pragma unroll
        for (int ai = 0; ai < 2; ++ai) { u32x4 bw[4][2];
#pragma unroll
            for (int m = 0; m < 4; ++m)
#pragma unroll
                for (int bj = 0; bj < 2; ++bj) bw[m][bj] = *(const u32x4*)(xb + (size_t)(row0 + ai * HALF + m * 16) * DM + col0 + bj * HALF);
#pragma unroll
            for (int m = 0; m < 4; ++m) { const int row = row0 + ai * HALF + m * 16; float sq = 0.f;
#pragma unroll
                for (int bj = 0; bj < 2; ++bj) { const size_t off = (size_t)row * DM + col0 + bj * HALF; const u32x4 w = bw[m][bj];
                    const f32x4 b0 = {bf_lo(w.x), bf_hi(w.x), bf_lo(w.y), bf_hi(w.y)}, b1 = {bf_lo(w.z), bf_hi(w.z), bf_lo(w.w), bf_hi(w.w)};
                    const f32x4 o0 = b0 + acc[ai][bj][m][0] * alpha, o1 = b1 + acc[ai][bj][m][1] * alpha;
                    *(u32x4*)(xb + off) = pack8(o0, o1);
                    sq += ((o0[0] * o0[0] + o0[1] * o0[1]) + (o0[2] * o0[2] + o0[3] * o0[3])) + ((o1[0] * o1[0] + o1[1] * o1[1]) + (o1[2] * o1[2] + o1[3] * o1[3])); }
                { const int ln = fr + 16 * fq; sq += shx(sq, 16, ln); sq += shx(sq, 32, ln); }
                if (fq == 0) ss[(size_t)row * 16 + u.pn * 4 + wc] = sq; }
            asm volatile("" ::: "memory"); }
    }
};
__device__ __forceinline__ unsigned gate_frag_off(int gt, int pm, int wave, int ai, int m, int bj, int lane) {
    return ((unsigned)(gt * 256 + pm) << 17) + (unsigned)((((wave * 2 + ai) * 4 + m) * 2 + bj) * 64 + lane) * 16u;
}
struct EpiProj {
    static constexpr bool PERM = true, AFTER_DRAIN = false, HOOK = false;
    bf16_t *P, *Q, *K, *LX, *LG, *GATES; const float* ss; const float* mbias;
    __device__ __forceinline__ void operator()(const f32x4 (&acc)[2][2][4][2], const Unit& u, int wr, int wc, int fr, int fq) const {
        const int pn = u.pn; bf16_t* dst; int ld, c0, kind = 0; float sc = 1.f;
        if (pn == 0) { dst = P; ld = 256; c0 = 0; }
        else if (pn < 3) { dst = Q; ld = 512; c0 = (pn - 1) * 256; sc = 0.125f * 1.44269504f; }
        else if (pn < 5) { dst = K; ld = 512; c0 = (pn - 3) * 256; }
        else if (pn == 5) { dst = LX; ld = 256; c0 = 0; }
        else if (pn == 6) { dst = LG; ld = 256; c0 = 0; kind = 1; }
        else { dst = GATES; ld = 3072; c0 = (pn - 7) * 256; kind = 2; }
        const int row0 = u.pm * BM + wr * 64 + fr, col0 = c0 + wc * 32 + 8 * fq;
        f32x4 bv[2][2];
#pragma unroll
        for (int bj = 0; bj < 2; ++bj)
#pragma unroll
            for (int n = 0; n < 2; ++n) bv[bj][n] = (kind == 2) ? *(const f32x4*)(mbias + col0 + bj * HALF + 4 * n) : (f32x4){0.f, 0.f, 0.f, 0.f};
        float rsa[2][4]; rstd8(ss, row0, fr, fq, rsa);
#pragma unroll
        for (int ai = 0; ai < 2; ++ai)
#pragma unroll
            for (int m = 0; m < 4; ++m) { const int row = row0 + ai * HALF + m * 16; const float rs = rsa[ai][m] * sc;
#pragma unroll
                for (int bj = 0; bj < 2; ++bj) { f32x4 v[2];
#pragma unroll
                    for (int n = 0; n < 2; ++n) { v[n] = acc[ai][bj][m][n] * rs;
                        if (kind == 1) {
#pragma unroll
                            for (int e = 0; e < 4; ++e) v[n][e] = gelu_tanh(v[n][e]); }
                        else if (kind == 2) {
#pragma unroll
                            for (int e = 0; e < 4; ++e) v[n][e] = sigm(v[n][e] + bv[bj][n][e]); } }
                    if (kind == 2) *(u32x4*)((char*)GATES + gate_frag_off(pn - 7, u.pm, wr * 4 + wc, ai, m, bj, fr + 16 * fq)) = pack8(v[0], v[1]);
                    else *(u32x4*)(dst + (size_t)row * ld + col0 + bj * HALF) = pack8(v[0], v[1]); } }
    }
};
struct EpiVt {
    static constexpr bool PERM = false, AFTER_DRAIN = false, HOOK = false;
    bf16_t* Vt; const float* ss;
    __device__ __forceinline__ void operator()(const f32x4 (&acc)[2][2][4][2], const Unit& u, int wr, int wc, int fr, int fq) const {
        const int ch0 = u.pm * BM + wr * 64 + fr;
        const int tokj = u.pn * BM + (fr >> 3) * HALF + wc * 32 + ((fr >> 2) & 1) * 16 + 4 * fq + (fr & 3);
        const float rsj = row_rstd(ss, tokj);
#pragma unroll
        for (int bj = 0; bj < 2; ++bj)
#pragma unroll
            for (int n = 0; n < 2; ++n) { const int tok = u.pn * BM + bj * HALF + wc * 32 + n * 16 + 4 * fq;
                f32x4 rs;
#pragma unroll
                for (int e2 = 0; e2 < 4; ++e2) rs[e2] = __int_as_float(__builtin_amdgcn_ds_bpermute(((bj * 8 + n * 4 + e2) + 16 * fq) << 2, __float_as_int(rsj)));
                const int b = tok >> 12, s = tok & 4095, sp = (s & ~15) + 8 * (fq & 1) + 4 * (fq >> 1);
#pragma unroll
                for (int ai = 0; ai < 2; ++ai)
#pragma unroll
                    for (int m = 0; m < 4; ++m) { const int ch = ch0 + ai * HALF + m * 16; const f32x4 v = acc[ai][bj][m][n] * rs;
                        u32x2 w; w.x = cvt_pk_bf16(v[0], v[1]); w.y = cvt_pk_bf16(v[2], v[3]);
                        *(u32x2*)(Vt + ((size_t)(b * 512 + ch)) * 4096 + sp) = w; } }
    }
};
typedef _Float16 h2_t __attribute__((ext_vector_type(2)));
struct EpiGates {
    static constexpr bool PERM = true, AFTER_DRAIN = false, HOOK = false;
    unsigned* AU; const bf16_t* XF  ; const float* b_a; const float* b_x; const float* c8;
    __device__ __forceinline__ void operator()(const f32x4 (&acc)[2][2][4][2], const Unit& u, int wr, int wc, int fr, int fq) const {
        const int dir = u.pn >> 1, half = u.pn & 1; const int row0 = u.pm * BM + wr * 64 + fr, ch0 = half * 128 + wc * 32 + 8 * fq;
#pragma unroll
        for (int n = 0; n < 2; ++n) { const int ch = ch0 + 4 * n;
            const f32x4 ba = *(const f32x4*)(b_a + dir * 256 + ch), bx = *(const f32x4*)(b_x + dir * 256 + ch), cc = *(const f32x4*)(c8 + dir * 256 + ch);
            u32x2 xwa[2][4];
#pragma unroll
            for (int ai = 0; ai < 2; ++ai)
#pragma unroll
                for (int m = 0; m < 4; ++m) xwa[ai][m] = *(const u32x2*)((const char*)XF + ((unsigned)(row0 + ai * HALF + m * 16) * 1024u + (unsigned)ch) * 2u);
#pragma unroll
            for (int ai = 0; ai < 2; ++ai)
#pragma unroll
                for (int m = 0; m < 4; ++m) { const int row = row0 + ai * HALF + m * 16;
                    const u32x2 xw = xwa[ai][m];
                    const float xf[4] = {bf_lo(xw.x), bf_hi(xw.x), bf_lo(xw.y), bf_hi(xw.y)};
                    u32x4 o;
#pragma unroll
                    for (int e = 0; e < 4; ++e) { const float r = sigm(acc[ai][0][m][n][e] + ba[e]), ig = sigm(acc[ai][1][m][n][e] + bx[e]);
                        const float l2a = cc[e] * r; const float a2 = ex2(2.f * l2a); const float uu = __builtin_sqrtf(fmaxf(1.f - a2, 0.f)) * ig * xf[e];
                        h2_t hv; hv[0] = (_Float16)l2a; hv[1] = (_Float16)uu; o[e] = __builtin_bit_cast(unsigned, hv); }
                    *(u32x4*)((char*)AU + (((unsigned)dir * (unsigned)MTOK + (unsigned)row) * 256u + (unsigned)ch) * 4u) = o; }
            asm volatile("" ::: "memory"); }
    }
};
struct EpiMerged {
    static constexpr bool PERM = true, AFTER_DRAIN = false, HOOK = true;
    bf16_t* O; const bf16_t* G  ;
    __device__ __forceinline__ void hook(f32x4 (&acc)[2][2][4][2], const Unit& u, int t, int wr, int wc, int fr, int fq) const {
        const int which = (t == 4) ? 0 : 1;
#pragma unroll
        for (int ai = 0; ai < 2; ++ai) { u32x4 ga[4][2], gb[4][2];
#pragma unroll
            for (int m = 0; m < 4; ++m)
#pragma unroll
                for (int bj = 0; bj < 2; ++bj) { const unsigned go = gate_frag_off(which * 4 + u.pn, u.pm, wr * 4 + wc, ai, m, bj, fr + 16 * fq);
                    ga[m][bj] = *(const u32x4*)((const char*)G + go); gb[m][bj] = *(const u32x4*)((const char*)G + go + ((4u * 256u) << 17)); }
#pragma unroll
            for (int m = 0; m < 4; ++m)
#pragma unroll
                for (int bj = 0; bj < 2; ++bj) { const u32x4 a = ga[m][bj], b = gb[m][bj];
                    acc[ai][bj][m][0][0] *= bf_lo(a.x) * rcpf_(bf_lo(b.x)); acc[ai][bj][m][0][1] *= bf_hi(a.x) * rcpf_(bf_hi(b.x));
                    acc[ai][bj][m][0][2] *= bf_lo(a.y) * rcpf_(bf_lo(b.y)); acc[ai][bj][m][0][3] *= bf_hi(a.y) * rcpf_(bf_hi(b.y));
                    acc[ai][bj][m][1][0] *= bf_lo(a.z) * rcpf_(bf_lo(b.z)); acc[ai][bj][m][1][1] *= bf_hi(a.z) * rcpf_(bf_hi(b.z));
                    acc[ai][bj][m][1][2] *= bf_lo(a.w) * rcpf_(bf_lo(b.w)); acc[ai][bj][m][1][3] *= bf_hi(a.w) * rcpf_(bf_hi(b.w)); }
            asm volatile("" ::: "memory"); }
    }
    __device__ __forceinline__ void operator()(const f32x4 (&acc)[2][2][4][2], const Unit& u, int wr, int wc, int fr, int fq) const {
        const int row0 = u.pm * BM + wr * 64 + fr, col0 = u.pn * BM + wc * 32 + 8 * fq;
#pragma unroll
        for (int ai = 0; ai < 2; ++ai) { u32x4 g2[4][2];
#pragma unroll
            for (int m = 0; m < 4; ++m)
#pragma unroll
                for (int bj = 0; bj < 2; ++bj) g2[m][bj] = *(const u32x4*)((const char*)G + gate_frag_off(8 + u.pn, u.pm, wr * 4 + wc, ai, m, bj, fr + 16 * fq));
#pragma unroll
            for (int m = 0; m < 4; ++m) { const int row = row0 + ai * HALF + m * 16;
#pragma unroll
                for (int bj = 0; bj < 2; ++bj) { const u32x4 g = g2[m][bj];
                    f32x4 v0 = acc[ai][bj][m][0], v1 = acc[ai][bj][m][1];
                    v0[0] *= bf_lo(g.x); v0[1] *= bf_hi(g.x); v0[2] *= bf_lo(g.y); v0[3] *= bf_hi(g.y);
                    v1[0] *= bf_lo(g.z); v1[1] *= bf_hi(g.z); v1[2] *= bf_lo(g.w); v1[3] *= bf_hi(g.w);
                    *(u32x4*)(O + (size_t)row * DM + col0 + bj * HALF) = pack8(v0, v1); } }
            asm volatile("" ::: "memory"); }
    }
};
template <class Epi, class Sched, bool ALIGN_EPI = false, bool SP2 = false>
__device__ __forceinline__ void gemm_phase(PG8_LAS unsigned char* lds, const Gemm g, const Sched& S, const Epi& E, int wave_s) {
    const int tid_ = tid_opq(wave_s);
    const int tid = tid_, wid = __builtin_amdgcn_readfirstlane(tid >> 6), lane = tid & 63, wr = wid >> 2, wc = wid & 3, fr = lane & 15, fq = lane >> 4;
    const int K = g.K, nt = K / BK;
    unsigned voffA[2], voffB[2];
#pragma unroll
    for (int i = 0; i < 2; ++i) { int R, C; stage_rc(tid * 16 + i * 8192, R, C); const int Rb = Epi::PERM ? ((R & ~31) + perm32(R & 31)) : R;
        voffA[i] = (unsigned)(R * g.lda + C) * 2u; voffB[i] = (unsigned)(Rb * g.ldb + C) * 2u; }
    const size_t kstep = (size_t)(BK * 2);
    const size_t hstepA = (size_t)HALF * g.lda * 2, hstepB = (size_t)HALF * g.ldb * 2;
    const size_t tstepA = 2 * hstepA, tstepB = 2 * hstepB;
    const unsigned ldsw = (unsigned)wid * 1024u;
    const int aoff = lds_byte(wr * 64 + fr, fq * 8), boff = lds_byte(wc * 32 + fr, fq * 8);
#define PG8_SA(b, h) (((b) * 2 + (h)) * HTB)
#define PG8_SB(b, h) ((4 + (b) * 2 + (h)) * HTB)
#define PG8_STAGE(bufoff, gbase, voff) do { _Pragma("unroll") for (int _i = 0; _i < 2; ++_i) \
        __builtin_amdgcn_global_load_lds((const unsigned*)((const char*)(gbase) + (voff)[_i]), (PG8_LAS unsigned*)(lds + (bufoff) + ldsw + _i * 8192), 16, 0, 0); } while (0)
#define PG8_LDA(dst, b, h) do { _Pragma("unroll") for (int m = 0; m < 4; ++m) _Pragma("unroll") for (int k = 0; k < 2; ++k) dst[m][k] = *(const PG8_LAS bf16x8*)(lds + PG8_SA(b, h) + aoff + m * 2048 + k * 1024); } while (0)
#define PG8_LDB(dst, b, h) do { _Pragma("unroll") for (int n = 0; n < 2; ++n) _Pragma("unroll") for (int k = 0; k < 2; ++k) dst[n][k] = *(const PG8_LAS bf16x8*)(lds + PG8_SB(b, h) + boff + n * 2048 + k * 1024); } while (0)
#define PG8_MMA(ai, bj, At, Bt) do { __builtin_amdgcn_s_setprio(1); _Pragma("unroll") for (int m = 0; m < 4; ++m) _Pragma("unroll") for (int n = 0; n < 2; ++n) _Pragma("unroll") for (int k = 0; k < 2; ++k) \
        acc[ai][bj][m][n] = __builtin_amdgcn_mfma_f32_16x16x32_bf16(Bt[n][k], At[m][k], acc[ai][bj][m][n], 0, 0, 0); __builtin_amdgcn_s_setprio(0); } while (0)
#define PG8_WAIT_V(n) asm volatile("s_waitcnt vmcnt(" #n ")" ::: "memory")
#define PG8_WAIT_L(n) asm volatile("s_waitcnt lgkmcnt(" #n ")" ::: "memory")
#define PG8_BAR __builtin_amdgcn_s_barrier()
#define PG8_SCHED __builtin_amdgcn_sched_barrier(0)
    Unit cur, nxt; int ui = 0;
    if (!S.next(0, cur)) return;
    f32x4 acc[2][2][4][2];
#pragma unroll
    for (int a = 0; a < 2; ++a)
#pragma unroll
        for (int b = 0; b < 2; ++b)
#pragma unroll
            for (int m = 0; m < 4; ++m)
#pragma unroll
                for (int n = 0; n < 2; ++n) acc[a][b][m][n] = (f32x4){0.f, 0.f, 0.f, 0.f};
    bf16x8 At[4][2], B0[2][2], B1[2][2];
    const char* cA = (const char*)g.A + (size_t)cur.pm * tstepA; const char* cB = (const char*)g.Bt + (size_t)cur.pn * tstepB;
    S.a_ready(cur);
    if constexpr (SP2) {
        PG8_STAGE(PG8_SB(0, 0), cB, voffB); PG8_STAGE(PG8_SB(0, 1), cB + hstepB, voffB); PG8_STAGE(PG8_SA(0, 0), cA, voffA); PG8_STAGE(PG8_SA(0, 1), cA + hstepA, voffA);
        if (wr == 1) PG8_BAR;
        PG8_WAIT_V(2); PG8_BAR;
        PG8_STAGE(PG8_SB(1, 0), cB + kstep, voffB); PG8_STAGE(PG8_SA(1, 0), cA + kstep, voffA); PG8_STAGE(PG8_SB(1, 1), cB + hstepB + kstep, voffB);
        PG8_WAIT_V(6); PG8_BAR;
    } else {
        PG8_STAGE(PG8_SB(0, 0), cB, voffB); PG8_STAGE(PG8_SA(0, 0), cA, voffA); PG8_STAGE(PG8_SB(0, 1), cB + hstepB, voffB); PG8_STAGE(PG8_SA(0, 1), cA + hstepA, voffA);
        if (wr == 1) PG8_BAR;
        PG8_WAIT_V(4); PG8_BAR;
        PG8_STAGE(PG8_SB(1, 0), cB + kstep, voffB); PG8_STAGE(PG8_SA(1, 0), cA + kstep, voffA); PG8_STAGE(PG8_SB(1, 1), cB + hstepB + kstep, voffB);
        PG8_WAIT_V(6); PG8_BAR;
    }
    for (;;) {
        const bool has_next = S.next(ui + 1, nxt);
        const char* nA = has_next ? (const char*)g.A + (size_t)nxt.pm * tstepA : cA; const char* nB = has_next ? (const char*)g.Bt + (size_t)nxt.pn * tstepB : cB;
        for (int t = 0; t < nt; t += 2) {
            const bool last = (t == nt - 2);
            if constexpr (Epi::HOOK) { if (t == 4 || t == 12) { PG8_SCHED; E.hook(acc, cur, t, wr, wc, fr, fq); PG8_SCHED; } }
            const char* a1 = cA + (size_t)(t + 1) * kstep;
            const char* a2 = last ? nA : cA + (size_t)(t + 2) * kstep; const char* b2 = last ? nB : cB + (size_t)(t + 2) * kstep;
            const char* a3 = a2 + kstep; const char* b3 = b2 + kstep;
            if (last && has_next) S.a_ready(nxt);
            if constexpr (SP2) {
            PG8_LDB(B0, 0, 0); PG8_LDB(B1, 0, 1); PG8_SCHED; PG8_LDA(At, 0, 0); PG8_STAGE(PG8_SA(1, 1), a1 + hstepA, voffA);
            PG8_WAIT_V(8); PG8_WAIT_L(0); PG8_BAR; PG8_MMA(0, 0, At, B0); PG8_MMA(0, 1, At, B1); PG8_BAR; PG8_SCHED;
            PG8_LDA(At, 0, 1); PG8_STAGE(PG8_SB(0, 0), b2, voffB); PG8_STAGE(PG8_SB(0, 1), b2 + hstepB, voffB); PG8_STAGE(PG8_SA(0, 0), a2, voffA);
            PG8_WAIT_V(8); PG8_WAIT_L(0); PG8_BAR; PG8_MMA(1, 0, At, B0); PG8_MMA(1, 1, At, B1); PG8_BAR; PG8_SCHED;
            PG8_LDB(B0, 1, 0); PG8_LDB(B1, 1, 1); PG8_SCHED; PG8_LDA(At, 1, 0); PG8_STAGE(PG8_SA(0, 1), a2 + hstepA, voffA);
            PG8_WAIT_V(8); PG8_WAIT_L(0); PG8_BAR; PG8_MMA(0, 0, At, B0); PG8_MMA(0, 1, At, B1); PG8_BAR; PG8_SCHED;
            PG8_LDA(At, 1, 1); PG8_STAGE(PG8_SB(1, 0), b3, voffB); PG8_STAGE(PG8_SB(1, 1), b3 + hstepB, voffB); PG8_STAGE(PG8_SA(1, 0), a3, voffA);
            PG8_WAIT_V(8); PG8_WAIT_L(0); PG8_BAR; PG8_MMA(1, 0, At, B0); PG8_MMA(1, 1, At, B1); PG8_BAR; PG8_SCHED;
            } else {
            PG8_LDB(B0, 0, 0); PG8_SCHED; PG8_LDA(At, 0, 0); PG8_STAGE(PG8_SA(1, 1), a1 + hstepA, voffA);
            PG8_WAIT_L(8); PG8_BAR; PG8_WAIT_L(0); PG8_MMA(0, 0, At, B0); PG8_BAR; PG8_SCHED;
            PG8_LDB(B1, 0, 1); PG8_STAGE(PG8_SB(0, 0), b2, voffB);
            PG8_BAR; PG8_WAIT_L(0); PG8_MMA(0, 1, At, B1); PG8_BAR;
            PG8_LDA(At, 0, 1); PG8_STAGE(PG8_SA(0, 0), a2, voffA);
            PG8_BAR; PG8_WAIT_L(0); PG8_MMA(1, 0, At, B0); PG8_BAR; PG8_SCHED;
            PG8_STAGE(PG8_SB(0, 1), b2 + hstepB, voffB);
            PG8_WAIT_V(6); PG8_BAR; PG8_MMA(1, 1, At, B1); PG8_BAR;
            PG8_LDB(B0, 1, 0); PG8_SCHED; PG8_LDA(At, 1, 0); PG8_STAGE(PG8_SA(0, 1), a2 + hstepA, voffA);
            PG8_WAIT_L(8); PG8_BAR; PG8_WAIT_L(0); PG8_MMA(0, 0, At, B0); PG8_BAR; PG8_SCHED;
            PG8_LDB(B1, 1, 1); PG8_STAGE(PG8_SB(1, 0), b3, voffB);
            PG8_BAR; PG8_WAIT_L(0); PG8_MMA(0, 1, At, B1); PG8_BAR;
            PG8_LDA(At, 1, 1); PG8_STAGE(PG8_SA(1, 0), a3, voffA);
            PG8_BAR; PG8_WAIT_L(0); PG8_MMA(1, 0, At, B0); PG8_BAR; PG8_SCHED;
            PG8_STAGE(PG8_SB(1, 1), b3 + hstepB, voffB);
            PG8_WAIT_V(6); PG8_BAR; PG8_MMA(1, 1, At, B1); PG8_BAR;
            }
        }
        if constexpr (ALIGN_EPI) { if (wr == 0) PG8_BAR; }
        if constexpr (!Epi::AFTER_DRAIN) { E(acc, cur, wr, wc, fr, fq); S.done(cur); }
        if (!has_next) break;
#pragma unroll
        for (int a = 0; a < 2; ++a)
#pragma unroll
            for (int b = 0; b < 2; ++b)
#pragma unroll
                for (int m = 0; m < 4; ++m)
#pragma unroll
                    for (int n = 0; n < 2; ++n) acc[a][b][m][n] = (f32x4){0.f, 0.f, 0.f, 0.f};
        cur = nxt; cA = nA; cB = nB; ++ui;
        if constexpr (ALIGN_EPI) { if (wr == 1) PG8_BAR; }
    }
    PG8_WAIT_V(0);
    if constexpr (!ALIGN_EPI) { if (wr == 0) PG8_BAR; }
    PG8_BAR;
    if constexpr (Epi::AFTER_DRAIN) { E.fused(acc, cur, wr, wc, fr, fq, lds, wid, lane); S.done(cur); }
#undef PG8_SA
#undef PG8_SB
#undef PG8_STAGE
#undef PG8_LDA
#undef PG8_LDB
#undef PG8_MMA
#undef PG8_WAIT_V
#undef PG8_WAIT_L
#undef PG8_BAR
#undef PG8_SCHED
}
}
using namespace pg8;
#define LAS __attribute__((address_space(3)))
typedef float f32x16 __attribute__((ext_vector_type(16)));
constexpr int NWAVES = 8, NTHR = 512;
constexpr int SEQ = 4096, NBATCH = 16;
constexpr int LDS_BYTES = 147456;
constexpr int LDS_SCR = 131072;
constexpr size_t MiB = 1u << 20;
constexpr size_t WS_KMAX = 32768;
constexpr size_t WS_SS = 1 * MiB, WS_W = 5 * MiB, WS_TAB = 53 * MiB, WS_XB = 54 * MiB, WS_MIX = 182 * MiB;
constexpr size_t WS_P = WS_MIX, WS_LX = WS_MIX + 32 * MiB, WS_Q = WS_MIX + 64 * MiB, WS_K = WS_MIX + 128 * MiB, WS_LG = WS_MIX + 192 * MiB,
                 WS_VT = WS_MIX + 224 * MiB, WS_BR = WS_MIX + 288 * MiB, WS_GATES = WS_MIX + 416 * MiB, WS_END = WS_MIX + 800 * MiB;
constexpr size_t WS_MERGED = WS_Q, WS_ACT = WS_MIX;
constexpr size_t WO_W1A = 0, WO_W2A = WO_W1A + 5632 * 1024, WO_WP = WO_W2A + 1024 * 2816, WO_WV = WO_WP + 4864 * 1024, WO_WG = WO_WV + 512 * 1024,
                 WO_WBR = WO_WG + 1024 * 256, WO_WO = WO_WBR + 1024 * 1024, WO_W1B = WO_WO + 1024 * 1024, WO_W2B = WO_W1B + 5632 * 1024, WO_END = WO_W2B + 1024 * 2816;
static_assert(WO_END * 2 <= 48 * MiB, "weights region");

struct Params { const float* in[26]; float* out; unsigned char* ws; };

__device__ __forceinline__ unsigned f2bf(float f) { unsigned u = __builtin_bit_cast(unsigned, f); return (u + 0x7fffu + ((u >> 16) & 1u)) >> 16; }
__device__ __forceinline__ unsigned pk2(float lo, float hi) { return f2bf(lo) | (f2bf(hi) << 16); }
__device__ __forceinline__ float wave_sum(float v, int lane) {
#pragma unroll
    for (int o = 1; o < 64; o <<= 1) v += shx(v, o, lane);
    return v;
}
__device__ __forceinline__ void transpose_block(const float* W, int ldsrc, int sc0, int k0, bf16_t* WT, int ldd, int dr0, int koff, const float* kscale, LAS float* scr, int lane) {
#pragma unroll 16
    for (int i = 0; i < 32; ++i) { const int kk = 2 * i + (lane >> 5); float v = W[(size_t)(k0 + kk) * ldsrc + sc0 + (lane & 31)]; if (kscale) v *= kscale[k0 + kk]; scr[kk * 33 + (lane & 31)] = v; }
    asm volatile("s_waitcnt lgkmcnt(0)" ::: "memory");
    const int c = lane & 7;
#pragma unroll
    for (int j = 0; j < 4; ++j) { const int n = (lane >> 3) + 8 * j; const LAS float* s = scr + (8 * c) * 33 + n;
        u32x4 o; o.x = pk2(s[0 * 33], s[1 * 33]); o.y = pk2(s[2 * 33], s[3 * 33]); o.z = pk2(s[4 * 33], s[5 * 33]); o.w = pk2(s[6 * 33], s[7 * 33]);
        *(u32x4*)(WT + (size_t)(dr0 + n) * ldd + koff + k0 + 8 * c) = o; }
    asm volatile("s_waitcnt lgkmcnt(0)" ::: "memory");
}
typedef const __attribute__((address_space(4))) Params* KPc;
__device__ __forceinline__ void convert_layer(KPc pp, int l, LAS unsigned char* lds, int G, int wave_s) {
    const int tid = tid_opq(wave_s), lane = tid & 63, wave = tid >> 6;
    LAS float* scr = (LAS float*)(lds + wave * 16384);
    bf16_t* Wb = (bf16_t*)(pp->ws + WS_W);
    const int gw = blockIdx.x * NWAVES + wave, NGW = G * NWAVES;
    constexpr int I_W1 = 16 * 176, I_W2 = 44 * 32, I_WP = 16 * 152, I_WV = 16 * 16, I_BA = 8 * 32, I_BL = 4 * 32, I_WO = 16 * 32;
    constexpr int NIT = 2 * I_W1 + 2 * I_W2 + I_WP + I_WV + I_BA + I_BL + I_WO;
    for (int it = gw; it < NIT; it += NGW) {
        int r = it;
        if (r < 2 * I_W1) { const int f = r / I_W1; r -= f * I_W1; const int kb = r / 176, nb = r % 176; const int dr0 = nb * 32, tile = dr0 >> 8, within = dr0 & 255, bj = within >> 7, j = within & 127;
            const float* src = pp->in[f ? 23 : 2] + (size_t)l * 1024 * 5632; const float* gn = pp->in[f ? 22 : 1] + l * 1024;
            transpose_block(src, 5632, bj * 2816 + tile * 128 + j, kb * 64, Wb + (f ? WO_W1B : WO_W1A), 1024, dr0, 0, gn, scr, lane); continue; }
        r -= 2 * I_W1;
        if (r < 2 * I_W2) { const int f = r / I_W2; r -= f * I_W2; const int kb = r / 32, nb = r % 32;
            const float* src = pp->in[f ? 24 : 3] + (size_t)l * 2816 * 1024;
            transpose_block(src, 1024, nb * 32, kb * 64, Wb + (f ? WO_W2B : WO_W2A), 2816, nb * 32, 0, nullptr, scr, lane); continue; }
        r -= 2 * I_W2;
        if (r < I_WP) { const int kb = r / 152, nb = r % 152; const int dr0 = nb * 32; const int sc0 = dr0 < 1280 ? dr0 : dr0 + 512;
            transpose_block(pp->in[5] + (size_t)l * 1024 * 5376, 5376, sc0, kb * 64, Wb + WO_WP, 1024, dr0, 0, pp->in[4] + l * 1024, scr, lane); continue; }
        r -= I_WP;
        if (r < I_WV) { const int kb = r / 16, nb = r % 16;
            transpose_block(pp->in[5] + (size_t)l * 1024 * 5376, 5376, 1280 + nb * 32, kb * 64, Wb + WO_WV, 1024, nb * 32, 0, pp->in[4] + l * 1024, scr, lane); continue; }
        r -= I_WV;
        if (r < I_BA) { const int kb = r / 32, nb = r % 32;
            transpose_block(pp->in[18] + (size_t)l * 512 * 1024, 1024, nb * 32, kb * 64, Wb + WO_WBR, 1024, nb * 32, 256, nullptr, scr, lane); continue; }
        r -= I_BA;
        if (r < I_BL) { const int kb = r / 32, nb = r % 32;
            transpose_block(pp->in[19] + (size_t)l * 256 * 1024, 1024, nb * 32, kb * 64, Wb + WO_WBR, 1024, nb * 32, 768, nullptr, scr, lane); continue; }
        r -= I_BL;
        { const int kb = r / 32, nb = r % 32;
            transpose_block(pp->in[21] + (size_t)l * 1024 * 1024, 1024, nb * 32, kb * 64, Wb + WO_WO, 1024, nb * 32, 0, nullptr, scr, lane); }
    }
    const int gt = blockIdx.x * NTHR + tid, NGT = G * NTHR;
    { const float* pw = pp->in[6] + (size_t)l * 4 * 64 * 64; const float* ps = pp->in[7] + l * 256; const float* wbp = pp->in[17] + (size_t)l * 256 * 1024;
      for (int i = gt; i < 256 * 1024; i += NGT) { const int n = i & 1023, k = i >> 10, g = k >> 6; const float* pr = pw + (size_t)k * 64; float s = 0.f;
#pragma unroll 16
          for (int d = 0; d < 64; ++d) s += pr[d] * ps[64 * g + d] * wbp[(size_t)(64 * g + d) * 1024 + n];
          Wb[WO_WBR + (size_t)n * 1024 + k] = (bf16_t)f2bf(s); } }
    { for (int i = gt; i < 1024 * 256; i += NGT) { const int k = i & 255, n = i >> 8, tile = n >> 8, bj = (n >> 7) & 1, j = n & 127, dir = tile >> 1, half = tile & 1, ch = half * 128 + j, gq = ch >> 6, d = ch & 63;
          const float* w = pp->in[bj ? 14 : 12] + ((size_t)(l * 2 + dir) * 4 + gq) * 64 * 64; const float v = ((k >> 6) == gq) ? w[(k & 63) * 64 + d] : 0.f;
          Wb[WO_WG + (size_t)n * 256 + k] = (bf16_t)f2bf(v); } }
    { float* tab = (float*)(pp->ws + WS_TAB); const float* lam = pp->in[16] + l * 512;
      for (int i = gt; i < 512; i += NGT) tab[i] = -8.0f * __builtin_amdgcn_logf(1.0f + ex2(-1.44269504f * lam[i])); }
}
__device__ __forceinline__ void x_to_bf16(const float* x, bf16_t* xb, float* ss, int G, int wave_s) {
    const int tid = tid_opq(wave_s), lane = tid & 63, wave = tid >> 6; const int gw = blockIdx.x * NWAVES + wave, NGW = G * NWAVES;
    for (int m0 = gw * 4; m0 < MTOK; m0 += NGW * 4) { f32x4 v[4][4];
#pragma unroll
        for (int r = 0; r < 4; ++r)
#pragma unroll
            for (int j = 0; j < 4; ++j) v[r][j] = __builtin_nontemporal_load(((const f32x4*)(x + (size_t)(m0 + r) * DM) + lane) + 64 * j);
#pragma unroll
        for (int r = 0; r < 4; ++r) { u32x2* o = (u32x2*)(xb + (size_t)(m0 + r) * DM) + lane; float s = 0.f;
#pragma unroll
            for (int j = 0; j < 4; ++j) { const f32x4 q = v[r][j]; s += (q[0] * q[0] + q[1] * q[1]) + (q[2] * q[2] + q[3] * q[3]); u32x2 w; w.x = cvt_pk_bf16(q[0], q[1]); w.y = cvt_pk_bf16(q[2], q[3]); o[64 * j] = w; }
            s = wave_sum(s, lane); if (lane < 16) ss[(size_t)(m0 + r) * 16 + lane] = (lane == 0) ? s : 0.f; } }
}
__device__ __forceinline__ void final_norm(const bf16_t* xb, float* out, const float* ss, const float* g, int G, int wave_s) {
    const int tid = tid_opq(wave_s), lane = tid & 63, wave = tid >> 6; const int gw = blockIdx.x * NWAVES + wave, NGW = G * NWAVES;
    f32x4 gv[4];
#pragma unroll
    for (int j = 0; j < 4; ++j) gv[j] = ((const f32x4*)g)[lane + 64 * j];
    for (int m0 = gw * 4; m0 < MTOK; m0 += NGW * 4) { u32x2 w[4][4]; float rs[4];
#pragma unroll
        for (int r = 0; r < 4; ++r) { rs[r] = row_rstd(ss, m0 + r);
#pragma unroll
            for (int j = 0; j < 4; ++j) w[r][j] = ((const u32x2*)(xb + (size_t)(m0 + r) * DM) + lane)[64 * j]; }
#pragma unroll
        for (int r = 0; r < 4; ++r) { f32x4* o = (f32x4*)(out + (size_t)(m0 + r) * DM) + lane;
#pragma unroll
            for (int j = 0; j < 4; ++j) { const u32x2 q = w[r][j]; const f32x4 v = {bf_lo(q.x), bf_hi(q.x), bf_lo(q.y), bf_hi(q.y)}; __builtin_nontemporal_store(v * rs[r] * gv[j], o + 64 * j); } } }
}
__device__ __forceinline__ void unpack8(const u32x4 w, float* f) { f[0] = bf_lo(w.x); f[1] = bf_hi(w.x); f[2] = bf_lo(w.y); f[3] = bf_hi(w.y); f[4] = bf_lo(w.z); f[5] = bf_hi(w.z); f[6] = bf_lo(w.w); f[7] = bf_hi(w.w); }
__device__ __forceinline__ u32x4 pack8f(const float* f) { u32x4 w; w.x = cvt_pk_bf16(f[0], f[1]); w.y = cvt_pk_bf16(f[2], f[3]); w.z = cvt_pk_bf16(f[4], f[5]); w.w = cvt_pk_bf16(f[6], f[7]); return w; }
__device__ __forceinline__ void prep_phase(const bf16_t* __restrict__ P, const bf16_t* __restrict__ LX, bf16_t* __restrict__ BR, const float* __restrict__ cw, const float* __restrict__ cb, const bf16_t* __restrict__ Kb, unsigned* __restrict__ kmax2, int G, int wave_s) {
    const int tid = tid_opq(wave_s), sub = tid >> 5, c8 = (tid & 31) * 8;
#pragma unroll 2
    for (int rb = blockIdx.x; rb < MTOK / 16; rb += G) { const int row = rb * 16 + sub, t = row & (SEQ - 1), b0 = row - t;
        { const int g = c8 >> 6, hw = 1 << g; const int lo = max(t - hw, 0), hi = min(t + hw, SEQ); float sum[8] = {0, 0, 0, 0, 0, 0, 0, 0}, f[8];
#pragma unroll
          for (int o = 0; o < 16; ++o) { const int tt = t - hw + o; if (o < 2 * hw && tt >= 0 && tt < SEQ) { unpack8(*(const u32x4*)(P + (size_t)(b0 + tt) * 256 + c8), f);
#pragma unroll
              for (int e = 0; e < 8; ++e) sum[e] += f[e]; } }
          unpack8(*(const u32x4*)(P + (size_t)row * 256 + c8), f); const float inv = 1.0f / (float)(hi - lo);
#pragma unroll
          for (int e = 0; e < 8; ++e) sum[e] = sum[e] * inv - f[e];
          *(u32x4*)(BR + (size_t)row * 1024 + c8) = pack8f(sum); }
        { float a[8], f[8];
#pragma unroll
          for (int e = 0; e < 8; ++e) a[e] = cb[c8 + e];
#pragma unroll
          for (int j = 0; j < 4; ++j) { const int tt = t - 2 + j; if (tt >= 0 && tt < SEQ) { unpack8(*(const u32x4*)(LX + (size_t)(b0 + tt) * 256 + c8), f);
#pragma unroll
                  for (int e = 0; e < 8; ++e) a[e] += cw[j * 256 + c8 + e] * f[e]; } }
          *(u32x4*)(BR + (size_t)row * 1024 + 768 + c8) = pack8f(a); }
        { float f[8], g8[8]; unpack8(*(const u32x4*)(Kb + (size_t)row * 512 + 2 * c8), f); unpack8(*(const u32x4*)(Kb + (size_t)row * 512 + 2 * c8 + 8), g8); float s = 0.f;
#pragma unroll
          for (int e = 0; e < 8; ++e) s += f[e] * f[e] + g8[e] * g8[e];
          s += shx(s, 1, tid & 63); s += shx(s, 2, tid & 63);
          if ((tid & 3) == 0) { unsigned* dst = kmax2 + (row >> 12) * 8 + ((tid & 31) >> 2); const unsigned sv = __float_as_uint(s);
              if (sv > __hip_atomic_load(dst, __ATOMIC_RELAXED, __HIP_MEMORY_SCOPE_AGENT)) atomicMax(dst, sv); } }
    }
}
__device__ __forceinline__ void lau4(const u32x4 w, f32x4& a, f32x4& u) {
    const unsigned w0 = w.x, w1 = w.y, w2 = w.z, w3 = w.w;
    const h2_t h0 = __builtin_bit_cast(h2_t, w0), h1 = __builtin_bit_cast(h2_t, w1), h2 = __builtin_bit_cast(h2_t, w2), h3 = __builtin_bit_cast(h2_t, w3);
    a = (f32x4){ex2((float)h0[0]), ex2((float)h1[0]), ex2((float)h2[0]), ex2((float)h3[0])}; u = (f32x4){(float)h0[1], (float)h1[1], (float)h2[1], (float)h3[1]};
}
__device__ __forceinline__ void scan_unit(LAS unsigned char* lds, const unsigned* __restrict__ AU, const bf16_t* __restrict__ GL, bf16_t* __restrict__ BR, int b, int cg8, int wave_s) {
    const int tid = tid_opq(wave_s), cq = tid & 1, j = tid >> 1, ch = cg8 * 8 + cq * 4, t0 = j * 16;
    LAS float* sPf = (LAS float*)lds; LAS float* sHf = sPf + 2048; LAS float* sPb = sPf + 4096; LAS float* sHb = sPf + 6144; LAS float* sCf = sPf + 8192; LAS float* sCb = sPf + 10240;
    const unsigned* auf = AU + ((size_t)b * SEQ + t0) * 256 + ch; const unsigned* aub = auf + (size_t)MTOK * 256;
    u32x4 wf[16], wb[16];
#pragma unroll
    for (int s = 0; s < 16; ++s) { wf[s] = *(const u32x4*)(auf + (size_t)s * 256); wb[s] = *(const u32x4*)(aub + (size_t)s * 256); }
    { f32x4 Pp = {1.f, 1.f, 1.f, 1.f}, H = {0.f, 0.f, 0.f, 0.f};
#pragma unroll
      for (int s = 0; s < 16; ++s) { f32x4 a, u; lau4(wf[s], a, u); Pp = Pp * a; H = a * H + u; }
      *(LAS f32x4*)(sPf + j * 8 + cq * 4) = Pp; *(LAS f32x4*)(sHf + j * 8 + cq * 4) = H; }
    { f32x4 Pp = {1.f, 1.f, 1.f, 1.f}, H = {0.f, 0.f, 0.f, 0.f};
#pragma unroll
      for (int s = 15; s >= 0; --s) { f32x4 a, u; lau4(wb[s], a, u); Pp = Pp * a; H = a * H + u; }
      *(LAS f32x4*)(sPb + j * 8 + cq * 4) = Pp; *(LAS f32x4*)(sHb + j * 8 + cq * 4) = H; }
#pragma unroll
    for (int s = 0; s < 16; ++s) { asm volatile("" : "+v"(wf[s]), "+v"(wb[s])); }
    __syncthreads();
    if (tid < 16) { const int c = tid & 7; float h = 0.f;
        if (tid < 8) {
#pragma unroll 8
            for (int jj = 0; jj < 256; ++jj) { sCf[jj * 8 + c] = h; h = sPf[jj * 8 + c] * h + sHf[jj * 8 + c]; } }
        else {
#pragma unroll 8
            for (int jj = 255; jj >= 0; --jj) { sCb[jj * 8 + c] = h; h = sPb[jj * 8 + c] * h + sHb[jj * 8 + c]; } } }
    __syncthreads();
    { f32x4 h = *(const LAS f32x4*)(sCb + j * 8 + cq * 4);
#pragma unroll
      for (int s = 15; s >= 0; --s) { f32x4 a, u; lau4(wb[s], a, u); h = a * h + u; wb[s] = __builtin_bit_cast(u32x4, h); } }
    { f32x4 h = *(const LAS f32x4*)(sCf + j * 8 + cq * 4);
      for (int sb = 0; sb < 16; sb += 8) { u32x2 gw[8];
#pragma unroll
        for (int i = 0; i < 8; ++i) gw[i] = *(const u32x2*)(GL + ((size_t)b * SEQ + t0 + sb + i) * 256 + ch);
#pragma unroll
        for (int i = 0; i < 8; ++i) { const int s = sb + i; const size_t row = (size_t)b * SEQ + t0 + s; f32x4 a, u; lau4(wf[s], a, u); h = a * h + u; const f32x4 hb = __builtin_bit_cast(f32x4, wb[s]);
            const f32x4 o = {(h[0] + hb[0]) * bf_lo(gw[i].x), (h[1] + hb[1]) * bf_hi(gw[i].x), (h[2] + hb[2]) * bf_lo(gw[i].y), (h[3] + hb[3]) * bf_hi(gw[i].y)};
            u32x2 ow; ow.x = cvt_pk_bf16(o[0], o[1]); ow.y = cvt_pk_bf16(o[2], o[3]); *(u32x2*)(BR + row * 1024 + 768 + ch) = ow; } } }
    __syncthreads();
}
__device__ __forceinline__ int crow(int r, int hi) { return (r & 3) + 8 * (r >> 2) + 4 * hi; }
__device__ __forceinline__ bf16x8 pack_p(const f32x16& s, int o) {
    u32x4 w; w.x = cvt_pk_bf16(s[o + 0], s[o + 1]); w.y = cvt_pk_bf16(s[o + 2], s[o + 3]); w.z = cvt_pk_bf16(s[o + 4], s[o + 5]); w.w = cvt_pk_bf16(s[o + 6], s[o + 7]);
    return __builtin_bit_cast(bf16x8, w);
}
__device__ __forceinline__ void attn_unit(LAS unsigned char* lds, const bf16_t* Q, const bf16_t* Kb, const bf16_t* Vt, bf16_t* BR, int b, int h, int qblk, float lam, float slope2, const float* subln, float lam_init, const unsigned* kmax2, int wave_s) {
    const int tid = tid_opq(wave_s), lane = tid & 63, wid = wave_s  , r32 = lane & 31, hi = lane >> 5, mp = wid >> 2, wq = wid & 3;
    const int q0 = qblk * 128; const size_t rowbase = (size_t)b * SEQ;
    bf16x8 qf[4];
    { const bf16_t* qp = Q + (rowbase + q0 + wq * 32 + r32) * 512 + h * 128 + mp * 64 + hi * 8;
#pragma unroll
      for (int d0 = 0; d0 < 4; ++d0) qf[d0] = *(const bf16x8*)(qp + d0 * 16); }
    const int srow = tid >> 3, sc = (tid & 7) ^ ((srow >> 1) & 7);
    const bf16_t* kg = Kb + (rowbase + srow) * 512 + h * 128 + sc * 8;
    const bf16_t* vg = Vt + ((size_t)(b * 512 + h * 128 + srow)) * 4096 + sc * 8;
    const int wofs = wid * 1024;
    const int sw = (r32 >> 1) & 7;
    const int kfo = mp * 8192 + r32 * 128, vfo = 65536 + r32 * 128;
#define ATT_DMA(gp, off) __builtin_amdgcn_global_load_lds((const unsigned*)(gp), (LAS unsigned*)(lds + (off)), 16, 0, 0)
    LAS float* scr = (LAS float*)(lds + LDS_SCR + wid * 128);
    const int td = q0 >> 6;
    { const size_t k0_ = (size_t)td * 64, k1_ = k0_ + 64;
      ATT_DMA(kg + k0_ * 512, wofs); ATT_DMA(kg + k0_ * 512 + 64, 8192 + wofs); ATT_DMA(kg + k1_ * 512, 16384 + wofs); ATT_DMA(kg + k1_ * 512 + 64, 16384 + 8192 + wofs);
      ATT_DMA(vg + k0_, 65536 + wofs); ATT_DMA(vg + k0_ + (size_t)64 * 4096, 65536 + 8192 + wofs); }
    int tlo, thi;
    { float q2 = 0.f;
#pragma unroll
      for (int d0 = 0; d0 < 4; ++d0) { const u32x4 w = __builtin_bit_cast(u32x4, qf[d0]); float f[8]; unpack8(w, f);
#pragma unroll
          for (int e = 0; e < 8; ++e) q2 += f[e] * f[e]; }
      q2 += shx(q2, 32, lane);
#pragma unroll
      for (int o = 1; o < 32; o <<= 1) q2 = fmaxf(q2, shx(q2, o, lane));
      LAS float* qx = (LAS float*)(lds + LDS_SCR + 1040);
      if (lane == 0) qx[wid] = q2;
      __syncthreads();
      float qm = qx[0];
#pragma unroll
      for (int w = 1; w < 8; ++w) qm = fmaxf(qm, qx[w]);
      const float k2 = fmaxf(__uint_as_float(kmax2[b * 8 + 2 * h]), __uint_as_float(kmax2[b * 8 + 2 * h + 1]));
      const float bound = 160.0f + 2.02f * __builtin_sqrtf(qm * k2);
      const float Df = fminf(bound / slope2, 16384.0f);
      const int hi_ = (int)floorf((Df + (float)(q0 + 127)) * (1.0f / 64.0f)), lo_ = (int)ceilf(((float)(q0 - 63) - Df) * (1.0f / 64.0f));
      thi = __builtin_amdgcn_readfirstlane(hi_ > 63 ? 63 : hi_); tlo = __builtin_amdgcn_readfirstlane(lo_ < 0 ? 0 : lo_);
      if (thi < td + 1) thi = td + 1; if (tlo > td) tlo = td; }
    const int ntile = thi - tlo + 1, nr = thi - td + 1;
#define ATT_TILE(i) (((i) < nr) ? (td + (i)) : (td - 1 + nr - (i)))
#define SBAR() __builtin_amdgcn_sched_barrier(0)
#define MFMA32(a, b, c) __builtin_amdgcn_mfma_f32_32x32x16_bf16(a, b, c, 0, 0, 0)
    { const u32x4 z = (u32x4){0u, 0u, 0u, 0u}; *(LAS u32x4*)(lds + 65536 + 3 * 16384 + tid * 32) = z; *(LAS u32x4*)(lds + 65536 + 3 * 16384 + tid * 32 + 16) = z;
      const size_t k2_ = (size_t)ATT_TILE(ntile > 2 ? 2 : ntile - 1) * 64;
      ATT_DMA(kg + k2_ * 512, 32768 + wofs); ATT_DMA(kg + k2_ * 512 + 64, 32768 + 8192 + wofs); }
    asm volatile("s_waitcnt vmcnt(0) lgkmcnt(0)\n\ts_barrier" ::: "memory");
    f32x16 SA0, SA1, SB0, SB1;
#pragma unroll
    for (int r = 0; r < 16; ++r) { SA0[r] = 0.f; SA1[r] = 0.f; }
#pragma unroll
    for (int d0 = 0; d0 < 4; ++d0) { const int co = ((2 * d0 + hi) ^ sw) << 4;
        SA0 = MFMA32(*(const LAS bf16x8*)(lds + kfo + co), qf[d0], SA0); SA1 = MFMA32(*(const LAS bf16x8*)(lds + kfo + 4096 + co), qf[d0], SA1); }
    float mrun = -1e30f, lsum = 0.f; f32x16 O[4];
#pragma unroll
    for (int d = 0; d < 4; ++d)
#pragma unroll
        for (int r = 0; r < 16; ++r) O[d][r] = 0.f;
    const float qposf = (float)(q0 + wq * 32 + r32 - 4 * hi);
#define KFRAG(d0, blk) (*(const LAS bf16x8*)(kb_ + (blk) * 4096 + (((2 * (d0) + hi) ^ sw) << 4)))
#define VFRAG(g) (*(const LAS bf16x8*)(vb_ + ((g) & 3) * 4096 + (((2 * ((g) >> 2) + hi) ^ sw) << 4)))
#define ATT_BIAS(SC0, SC1, d0) do { _Pragma("unroll") for (int r = 4 * (d0); r < 4 * (d0) + 4; ++r) { const float cr_ = (float)((r & 3) + 8 * (r >> 2)); \
        if (FAST_) { SC0[r] = __builtin_fmaf(ssg_, cr_, SC0[r]); SC1[r] = __builtin_fmaf(ssg_, cr_ + 32.f, SC1[r]); mx0_ = fmaxf(mx0_, fmaxf(SC0[r], SC1[r])); } \
        else { SC0[r] = SC0[r] - slope2 * __builtin_fabsf(dq_ - cr_); SC1[r] = SC1[r] - slope2 * __builtin_fabsf(dq_ - 32.f - cr_); mx0_ = fmaxf(mx0_, fmaxf(SC0[r], SC1[r])); } } } while (0)
#define ATT_STEP(t, SC0, SC1, SN0, SN1, FAST) do { \
        constexpr bool FAST_ = (FAST) != 0; \
        const int t_ = (t); const int tile_ = ATT_TILE(t_); \
        { const int tn_ = (t_ + 3 < ntile) ? t_ + 3 : ntile - 1, tv_ = (t_ + 1 < ntile) ? t_ + 1 : ntile - 1; const int tk_ = ATT_TILE(tn_), tvt_ = ATT_TILE(tv_); const size_t kv0_ = (size_t)tk_ * 64, vv0_ = (size_t)tvt_ * 64; \
          const int kd_ = ((t_ + 3) & 3) * 16384 + wofs, vd_ = 65536 + ((t_ + 1) & 3) * 16384 + wofs; \
          ATT_DMA(kg + kv0_ * 512, kd_); ATT_DMA(kg + kv0_ * 512 + 64, kd_ + 8192); ATT_DMA(vg + vv0_, vd_); ATT_DMA(vg + vv0_ + (size_t)64 * 4096, vd_ + 8192); } \
        const LAS unsigned char* kb_ = lds + ((t_ + 1) & 3) * 16384 + kfo; const LAS unsigned char* vb_ = lds + ((t_ + 3) & 3) * 16384 + vfo; \
        const float dq_ = qposf - (float)(tile_ * 64); float mx0_ = -1e30f; \
        const float ssg_ = (t_ < nr) ? -slope2 : slope2; const float c1_ = -ssg_ * dq_; \
        bf16x8 k00_ = KFRAG(0, 0), k01_ = KFRAG(0, 1), k10_ = KFRAG(1, 0), k11_ = KFRAG(1, 1); \
        ATT_BIAS(SC0, SC1, 0); SBAR(); \
        { f32x16 z_; _Pragma("unroll") for (int r = 0; r < 16; ++r) z_[r] = 0.f; SN0 = MFMA32(k00_, qf[0], z_); SN1 = MFMA32(k01_, qf[0], z_); } \
        k00_ = KFRAG(2, 0); k01_ = KFRAG(2, 1); ATT_BIAS(SC0, SC1, 1); SBAR(); \
        SN0 = MFMA32(k10_, qf[1], SN0); SN1 = MFMA32(k11_, qf[1], SN1); \
        k10_ = KFRAG(3, 0); k11_ = KFRAG(3, 1); ATT_BIAS(SC0, SC1, 2); SBAR(); \
        SN0 = MFMA32(k00_, qf[2], SN0); SN1 = MFMA32(k01_, qf[2], SN1); \
        bf16x8 v0_ = VFRAG(0), v1_ = VFRAG(1); ATT_BIAS(SC0, SC1, 3); SBAR(); \
        SN0 = MFMA32(k10_, qf[3], SN0); SN1 = MFMA32(k11_, qf[3], SN1); \
        float mt_ = FAST_ ? (mx0_ + c1_) : mx0_; \
        mt_ = fmaxf(mt_, shx(mt_, 32, lane)); \
        const bool resc_ = __any(mt_ > mrun); \
        { const float mn_ = fmaxf(mrun, mt_), al_ = ex2(mrun - mn_); lsum *= al_; mrun = mn_; if (hi == 0) scr[r32] = al_; } \
        const float mo0_ = FAST_ ? (mrun - c1_) : mrun; \
        SBAR(); \
        _Pragma("unroll") for (int g = 0; g < 16; ++g) { const int c_ = g >> 2, d_ = g & 3; \
            bf16x8 v2_ = v0_; if (g < 14) v2_ = VFRAG(g + 2); \
            O[d_] = MFMA32(PK[c_], v0_, O[d_]); \
            if (g < 8) { SC0[2 * g] = ex2(SC0[2 * g] - mo0_); SC0[2 * g + 1] = ex2(SC0[2 * g + 1] - mo0_); lsum += SC0[2 * g] + SC0[2 * g + 1]; } \
            else { SC1[2 * g - 16] = ex2(SC1[2 * g - 16] - mo0_); SC1[2 * g - 15] = ex2(SC1[2 * g - 15] - mo0_); lsum += SC1[2 * g - 16] + SC1[2 * g - 15]; } \
            if (g == 3) PK[0] = pack_p(SC0, 0); if (g == 7) PK[1] = pack_p(SC0, 8); if (g == 11) PK[2] = pack_p(SC1, 0); if (g == 15) PK[3] = pack_p(SC1, 8); \
            v0_ = v1_; v1_ = v2_; SBAR(); } \
        if (resc_) { f32x4 al4_[4]; \
            _Pragma("unroll") for (int jq = 0; jq < 4; ++jq) al4_[jq] = *(const LAS f32x4*)(scr + 8 * jq + 4 * hi); \
            _Pragma("unroll") for (int d = 0; d < 4; ++d) _Pragma("unroll") for (int r = 0; r < 16; ++r) O[d][r] *= al4_[r >> 2][r & 3]; } \
        asm volatile("s_waitcnt vmcnt(4) lgkmcnt(0)\n\ts_barrier" ::: "memory");     \
    } while (0)
    bf16x8 PK[4];
#pragma unroll
    for (int c = 0; c < 4; ++c) PK[c] = (bf16x8){0, 0, 0, 0, 0, 0, 0, 0};
    ATT_STEP(0, SA0, SA1, SB0, SB1, 0);
    ATT_STEP(1, SB0, SB1, SA0, SA1, 0);
    for (int t = 2; t < ntile; t += 2) {
        ATT_STEP(t, SA0, SA1, SB0, SB1, 1);
        if (t + 1 >= ntile) break;
        ATT_STEP(t + 1, SB0, SB1, SA0, SA1, 1);
    }
    { const LAS unsigned char* vb_ = lds + ((ntile - 1) & 3) * 16384 + vfo;
#pragma unroll
      for (int c = 0; c < 4; ++c)
#pragma unroll
          for (int d = 0; d < 4; ++d) { const bf16x8 vf = *(const LAS bf16x8*)(vb_ + d * 4096 + (((2 * c + hi) ^ sw) << 4)); O[d] = MFMA32(PK[c], vf, O[d]); } }
    lsum += shx(lsum, 32, lane);
    if (hi == 0) scr[r32] = rcpf_(lsum);
    __builtin_amdgcn_wave_barrier();
    { f32x4 al[4];
#pragma unroll
      for (int jq = 0; jq < 4; ++jq) al[jq] = *(const LAS f32x4*)(scr + 8 * jq + 4 * hi);
#pragma unroll
      for (int d = 0; d < 4; ++d)
#pragma unroll
          for (int r = 0; r < 16; ++r) O[d][r] *= al[r >> 2][r & 3]; }
    asm volatile("s_waitcnt vmcnt(0)" ::: "memory");
    __syncthreads();
    LAS float* C = (LAS float*)lds;
    if (mp == 1) {
#pragma unroll
        for (int d = 0; d < 4; ++d)
#pragma unroll
            for (int r = 0; r < 16; ++r) C[(wq * 32 + crow(r, hi)) * 132 + d * 32 + r32] = O[d][r]; }
    __syncthreads();
    if (mp == 0) {
#pragma unroll
        for (int d = 0; d < 4; ++d)
#pragma unroll
            for (int r = 0; r < 16; ++r) { const int ix = (wq * 32 + crow(r, hi)) * 132 + d * 32 + r32; C[ix] = O[d][r] - lam * C[ix]; } }
    __syncthreads();
    { float li_ = lam_init; asm volatile("" : "+s"(li_)); const float outscale = 1.0f - li_;
      const int tid2 = tid_opq(wave_s); const int row = tid2 >> 2, part = tid2 & 3; const LAS float* cp = C + row * 132 + part * 32; float v[32]; float sq = 0.f;
#pragma unroll
      for (int jq = 0; jq < 8; ++jq) { const f32x4 x = *(const LAS f32x4*)(cp + 4 * jq); v[4 * jq] = x[0]; v[4 * jq + 1] = x[1]; v[4 * jq + 2] = x[2]; v[4 * jq + 3] = x[3]; sq += (x[0] * x[0] + x[1] * x[1]) + (x[2] * x[2] + x[3] * x[3]); }
      sq += shx(sq, 1, tid2 & 63); sq += shx(sq, 2, tid2 & 63);
      const float rs = __builtin_amdgcn_rsqf(sq * (1.0f / 128.0f) + 1e-5f) * outscale;
      bf16_t* op = BR + (rowbase + q0 + row) * 1024 + 256 + h * 128 + part * 32;
#pragma unroll
      for (int jq = 0; jq < 4; ++jq) { float f[8];
#pragma unroll
          for (int e = 0; e < 8; ++e) f[e] = v[8 * jq + e] * rs * subln[part * 32 + 8 * jq + e];
          *(u32x4*)(op + 8 * jq) = pack8f(f); } }
    __syncthreads();
#undef ATT_TILE
#undef ATT_DMA
#undef ATT_STEP
#undef ATT_BIAS
#undef KFRAG
#undef VFRAG
#undef SBAR
#undef MFMA32
}

typedef const __attribute__((address_space(4))) Params* KP;
__device__ __forceinline__ KP kparams() { auto k = __builtin_amdgcn_kernarg_segment_ptr(); asm volatile("" : "+s"(k)); return (KP)k; }
#define WSP(T, off) ((T*)(kp->ws + (off)))
#define RLX_AGENT __ATOMIC_RELAXED, __HIP_MEMORY_SCOPE_AGENT
#define XB_TMO      128
#define XB_XCNT(j)  (256  + 64 * (j))
#define XB_XSUB(j)  (1280 + 64 * (j))
#define XB_XGEN(j)  (2304 + 64 * (j))
#define XB_TOP      3328
#define XB_TOPGEN   3392
#define XCD_BAR_WORDS 3456
#define XB_SPIN_CAP (1u << 18)

__device__ __forceinline__ unsigned xb_ld(unsigned* p)              { return __hip_atomic_load(p, __ATOMIC_RELAXED, __HIP_MEMORY_SCOPE_AGENT); }
__device__ __forceinline__ unsigned xb_add(unsigned* p, unsigned v) { return __hip_atomic_fetch_add(p, v, __ATOMIC_RELAXED, __HIP_MEMORY_SCOPE_AGENT); }
__device__ __forceinline__ unsigned xb_xcc_id() { return (unsigned)__builtin_amdgcn_s_getreg((3 << 11) | 20) & 0xFu; }
#define XB_SPIN(cond, bar) do { unsigned _sp = 0; while (cond) { __builtin_amdgcn_s_sleep(1); \
    if ((++_sp & 255u) == 0u) { if (xb_ld(&(bar)[XB_TMO])) break; if (_sp > XB_SPIN_CAP) { atomicAdd(&(bar)[XB_TMO], 1u); break; } } } } while (0)

struct XcdBarrier {
    unsigned* bar; unsigned x;
    volatile LAS unsigned* st;
};

__device__ __forceinline__ XcdBarrier xcd_barrier_post(unsigned* bar, volatile LAS unsigned* st, int tid) {
    XcdBarrier b; b.bar = bar; b.x = xb_xcc_id(); b.st = st;
    if (tid == 0) (void)xb_add(&bar[XB_XCNT(b.x)], 1u);
    return b;
}
__device__ __forceinline__ void xcd_barrier_complete(unsigned* bar, unsigned x, unsigned& nloc, unsigned& nx) {
    const unsigned G = gridDim.x * gridDim.y * gridDim.z;
    unsigned sum, cnt, mine, sp = 0u;
    for (;;) {
        sum = 0u; cnt = 0u; mine = 0u;
#pragma unroll
        for (unsigned j = 0; j < 16; ++j) { const unsigned c = xb_ld(&bar[XB_XCNT(j)]); sum += c; cnt += (c > 0u) ? 1u : 0u; mine = (j == x) ? c : mine; }
        if (sum == G) break;
        __builtin_amdgcn_s_sleep(1);
        if ((++sp & 255u) == 0u) { if (xb_ld(&bar[XB_TMO])) break; if (sp > XB_SPIN_CAP) { atomicAdd(&bar[XB_TMO], 1u); break; } }
    }
    nloc = mine > 0u ? mine : 1u; nx = cnt > 0u ? cnt : 1u;
}

__device__ __forceinline__ void xcd_barrier(const XcdBarrier& b, int tid) {
    asm volatile("s_waitcnt vmcnt(0)" ::: "memory");
    __syncthreads();
    if (tid == 0) {
        unsigned* bar = b.bar;
        __builtin_amdgcn_s_waitcnt(0);
        unsigned nloc = b.st[0], nx = b.st[1];
        if (nloc == 0u) { xcd_barrier_complete(bar, b.x, nloc, nx); b.st[0] = nloc; b.st[1] = nx; }
        const unsigned old = xb_add(&bar[XB_XSUB(b.x)], 1u);
        const unsigned gen = old / nloc;
        if (old + 1u == (gen + 1u) * nloc) {
            __builtin_amdgcn_fence(__ATOMIC_RELEASE, "agent");
            asm volatile("s_waitcnt vmcnt(0)" ::: "memory");
            const unsigned og = xb_add(&bar[XB_TOP], 1u);
            const unsigned tg = og / nx;
            if (og + 1u == (tg + 1u) * nx) xb_add(&bar[XB_TOPGEN], 1u);
            else XB_SPIN(xb_ld(&bar[XB_TOPGEN]) == tg, bar);
            __builtin_amdgcn_fence(__ATOMIC_ACQUIRE, "agent");
            xb_add(&bar[XB_XGEN(b.x)], 1u);
            asm volatile("s_waitcnt vmcnt(0)" ::: "memory");
        } else {
            XB_SPIN(xb_ld(&bar[XB_XGEN(b.x)]) == gen, bar);
            __builtin_amdgcn_fence(__ATOMIC_ACQUIRE, "agent");
            asm volatile("s_waitcnt vmcnt(0)" ::: "memory");
        }
    }
    __syncthreads();
}
constexpr int LDS_BARST = LDS_SCR + 1024;
__device__ __forceinline__ void xsync(LAS unsigned char* lds, int wave_s) {
    KP kp = kparams(); XcdBarrier b; b.bar = (unsigned*)kp->ws; b.x = xb_xcc_id(); b.st = (volatile LAS unsigned*)(lds + LDS_BARST);
    xcd_barrier(b, tid_opq(wave_s));
}
#ifdef DUP_SYNC
#define GSYNC() do { xsync(lds, wave_s); xsync(lds, wave_s); } while (0)
#else
#define GSYNC() xsync(lds, wave_s)
#endif
#ifndef REP_SMALL
#define REP_SMALL 1
#endif
#ifndef REP_PROJ
#define REP_PROJ 1
#endif
#ifndef REP_MERGED
#define REP_MERGED 1
#endif
#ifndef REP_OUT
#define REP_OUT 1
#endif
#ifndef REP_XF
#define REP_XF 1
#endif
#ifndef REP_FFN2
#define REP_FFN2 1
#endif
#ifdef DUP_ATTN
#define ATT_REPS 2
#else
#define ATT_REPS 1
#endif
#ifdef DUP_FFN1
#define FFN1_REPS 2
#else
#define FFN1_REPS 1
#endif
__global__ void __launch_bounds__(NTHR, 2) fwd_megakernel(Params p_unused) {
    extern __shared__ __attribute__((aligned(16))) unsigned char lds_raw[];
    LAS unsigned char* lds = (LAS unsigned char*)lds_raw;
    cg::grid_group grid = cg::this_grid();
    const int wave_s = __builtin_amdgcn_readfirstlane((int)(threadIdx.x >> 6));
    { const int t0 = tid_opq(wave_s); if (t0 < 2) ((LAS unsigned*)(lds + LDS_BARST))[t0] = 0u; __syncthreads();
      KP kp = kparams(); (void)xcd_barrier_post((unsigned*)kp->ws, (volatile LAS unsigned*)(lds + LDS_BARST), t0); }
    for (int l = 0; l < 2; ++l) {
        { KP kp = kparams(); const int G = gridDim.x;
#ifndef SKIP_CONV
for (int rep_ = 0; rep_ < (REP_SMALL); ++rep_)
          convert_layer(kp, l, lds, G, wave_s);
#endif
          for (int rep_ = 0; rep_ < (REP_XF); ++rep_)
          if (l == 0) x_to_bf16(kp->in[0], WSP(bf16_t, WS_XB), WSP(float, WS_SS), G, wave_s); }
        if (l == 0) grid.sync(); else GSYNC();
        for (int f = 0; f < 2; ++f) {
            if (f == 1) {
#ifndef SKIP_PROJ
for (int rep_ = 0; rep_ < (REP_PROJ); ++rep_)
                { KP kp = kparams(); const int G = gridDim.x, bid = blockIdx.x; bf16_t* Wb = WSP(bf16_t, WS_W);
                  Gemm g{WSP(bf16_t, WS_XB), Wb + WO_WP, MTOK, 4864, 1024, 1024, 1024}; StaticOrder S; S.init(MTOK, 4864, G, bid);
                  EpiProj E{WSP(bf16_t, WS_P), WSP(bf16_t, WS_Q), WSP(bf16_t, WS_K), WSP(bf16_t, WS_LX), WSP(bf16_t, WS_LG), WSP(bf16_t, WS_GATES), WSP(float, WS_SS), kp->in[20] + l * 3072};
                  gemm_phase<EpiProj, StaticOrder, true, true>(lds, g, S, E, wave_s); }
#endif
#ifndef SKIP_VT
for (int rep_ = 0; rep_ < (REP_PROJ); ++rep_)
                { KP kp = kparams(); const int G = gridDim.x, bid = blockIdx.x; bf16_t* Wb = WSP(bf16_t, WS_W);
                  Gemm g{Wb + WO_WV, WSP(bf16_t, WS_XB), 512, MTOK, 1024, 1024, 1024}; StaticOrder S; S.init(512, MTOK, G, bid);
                  EpiVt E{WSP(bf16_t, WS_VT), WSP(float, WS_SS)};
                  gemm_phase<EpiVt, StaticOrder, true, true>(lds, g, S, E, wave_s); }
#endif
                GSYNC();
#ifndef SKIP_PREP
for (int rep_ = 0; rep_ < (REP_SMALL); ++rep_)
                { KP kp = kparams(); prep_phase(WSP(bf16_t, WS_P), WSP(bf16_t, WS_LX), WSP(bf16_t, WS_BR), kp->in[10] + l * 1024, kp->in[11] + l * 256, WSP(bf16_t, WS_K), WSP(unsigned, WS_KMAX) + l * 128, gridDim.x, wave_s); }
#endif
                GSYNC();
#ifndef SKIP_GATES
for (int rep_ = 0; rep_ < (REP_SMALL); ++rep_)
                { KP kp = kparams(); const int G = gridDim.x, bid = blockIdx.x; bf16_t* Wb = WSP(bf16_t, WS_W); bf16_t* BR = WSP(bf16_t, WS_BR);
                  int Kg = 256; asm volatile("" : "+s"(Kg));
                  Gemm g{BR + 768, Wb + WO_WG, MTOK, 1024, Kg, 1024, 256}; StaticOrder S; S.init(MTOK, 1024, G, bid);
                  EpiGates E{((unsigned*)kp->out)  , BR + 768, kp->in[13] + l * 512, kp->in[15] + l * 512, WSP(float, WS_TAB)};
                  gemm_phase<EpiGates, StaticOrder, true, false>(lds, g, S, E, wave_s); }
#endif
                GSYNC();
#ifndef SKIP_SCAN
for (int rep_ = 0; rep_ < (REP_SMALL); ++rep_)
                { KP kp = kparams(); const int G = gridDim.x, bid = blockIdx.x;
                  for (int u = bid; u < 512; u += G) { const int v = u & 255, k = u >> 8; scan_unit(lds, ((unsigned*)kp->out), WSP(bf16_t, WS_LG), WSP(bf16_t, WS_BR), (v & 7) + 8 * k, v >> 3, wave_s); } }
#endif
#ifndef SKIP_ATTN
                { KP kp = kparams(); const int G = gridDim.x, bid = blockIdx.x;
                  int ll = l; asm volatile("" : "+s"(ll)); const int lane = tid_opq(wave_s) & 63;
                  const float* lp = kp->in[8] + ll * 256;
                  const float s1 = wave_sum(lp[lane] * lp[64 + lane], lane), s2 = wave_sum(lp[128 + lane] * lp[192 + lane], lane);
                  int lib_ = (ll == 0) ? 0x3e4ccccd   : 0x3eb60549  ; asm volatile("" : "+s"(lib_)); const float lam_init = __int_as_float(lib_);     const float lam = __uint_as_float(__builtin_amdgcn_readfirstlane(__float_as_uint(ex2(1.44269504f * s1) - ex2(1.44269504f * s2) + lam_init)));
                  for (int rep = 0; rep < ATT_REPS; ++rep)
                  for (int u = bid; u < 2048; u += G) { const int x = u & 7, k = u >> 8, slot = (((u >> 3) & 31) + 16 * (k >> 2)) & 31, pair = 8 * k + ((x + k) & 7), b = pair >> 2, h = pair & 3;
                      const float slope2 = __uint_as_float(__builtin_amdgcn_readfirstlane(__float_as_uint(ex2(-2.0f * (float)(h + 1)) * 1.44269504f)));
                      attn_unit(lds, WSP(bf16_t, WS_Q), WSP(bf16_t, WS_K), WSP(bf16_t, WS_VT), WSP(bf16_t, WS_BR), b, h, slot, lam, slope2, kp->in[9] + ll * 128, lam_init, WSP(unsigned, WS_KMAX) + ll * 128, wave_s); } }
#endif
                GSYNC();
#ifndef SKIP_MERGED
for (int rep_ = 0; rep_ < (REP_MERGED); ++rep_)
                { KP kp = kparams(); const int G = gridDim.x, bid = blockIdx.x; bf16_t* Wb = WSP(bf16_t, WS_W);
                  Gemm g{WSP(bf16_t, WS_BR), Wb + WO_WBR, MTOK, 1024, 1024, 1024, 1024}; StaticOrder S; S.init(MTOK, 1024, G, bid);
                  EpiMerged E{WSP(bf16_t, WS_MERGED), WSP(bf16_t, WS_GATES)};
                  gemm_phase<EpiMerged, StaticOrder, true, true>(lds, g, S, E, wave_s); }
#endif
                GSYNC();
#ifndef SKIP_OUT
                for (int rep_ = 0; rep_ < (REP_OUT); ++rep_)
                { KP kp = kparams(); const int G = gridDim.x, bid = blockIdx.x; bf16_t* Wb = WSP(bf16_t, WS_W);
                  Gemm g{WSP(bf16_t, WS_MERGED), Wb + WO_WO, MTOK, 1024, 1024, 1024, 1024}; StaticOrder S; S.init(MTOK, 1024, G, bid);
                  EpiResid E{WSP(bf16_t, WS_XB), WSP(float, WS_SS), (rep_ + 1 < (REP_OUT)) ? 0.0f : 1.0f};
                  gemm_phase<EpiResid, StaticOrder, true, true>(lds, g, S, E, wave_s); }
#endif
                GSYNC();
            }
#ifndef SKIP_FFN1
            for (int rep = 0; rep < FFN1_REPS; ++rep)
            { KP kp = kparams(); const int G = gridDim.x, bid = blockIdx.x; bf16_t* Wb = WSP(bf16_t, WS_W);
              Gemm g{WSP(bf16_t, WS_XB), Wb + (f ? WO_W1B : WO_W1A), MTOK, 5632, 1024, 1024, 1024}; StaticOrder S; S.init(MTOK, 5632, G, bid);
              EpiSwiglu E{WSP(bf16_t, WS_ACT), WSP(float, WS_SS)};
              gemm_phase<EpiSwiglu, StaticOrder, true, true>(lds, g, S, E, wave_s); }
#endif
            GSYNC();
#ifndef SKIP_FFN2
            for (int rep_ = 0; rep_ < (REP_FFN2); ++rep_)
            { KP kp = kparams(); const int G = gridDim.x, bid = blockIdx.x; bf16_t* Wb = WSP(bf16_t, WS_W);
              Gemm g{WSP(bf16_t, WS_ACT), Wb + (f ? WO_W2B : WO_W2A), MTOK, 1024, 2816, 2816, 2816}; StaticOrder S; S.init(MTOK, 1024, G, bid);
              EpiResid E{WSP(bf16_t, WS_XB), WSP(float, WS_SS), 0.5f};
              gemm_phase<EpiResid, StaticOrder, true, true>(lds, g, S, E, wave_s); }
#endif
            GSYNC();
        }
    }
    for (int rep_ = 0; rep_ < (REP_XF); ++rep_)
    { KP kp = kparams(); final_norm(WSP(bf16_t, WS_XB), kp->out, WSP(float, WS_SS), kp->in[25], gridDim.x, wave_s); }
}

extern "C" void kernel_launch(void* const* d_in, const int* in_sizes, int n_in, void* d_out, int out_size, void* d_ws, size_t ws_size, hipStream_t stream) {
    static int grid = 0;
    if (grid == 0) {
        if (n_in != 26 || out_size != MTOK * DM || ws_size < WS_END) { fprintf(stderr, "kernel_launch: unexpected shapes (n_in %d, out %d, ws %zu)\n", n_in, out_size, ws_size); grid = -1; return; }
        int dev = 0, cus = 0, per_cu = 0;
        hipGetDevice(&dev); hipDeviceGetAttribute(&cus, hipDeviceAttributeMultiprocessorCount, dev);
        hipFuncSetAttribute((const void*)fwd_megakernel, hipFuncAttributeMaxDynamicSharedMemorySize, LDS_BYTES);
        hipOccupancyMaxActiveBlocksPerMultiprocessor(&per_cu, (const void*)fwd_megakernel, NTHR, LDS_BYTES);
        if (per_cu < 1) per_cu = 1;
        grid = cus * per_cu;
    }
    if (grid < 0) return;
    if (hipMemsetAsync(d_ws, 0, 65536, stream) != hipSuccess) { fprintf(stderr, "kernel_launch: memset of the barrier words failed\n"); return; }
    Params p{};
    for (int i = 0; i < 26; ++i) p.in[i] = (const float*)d_in[i];
    p.out = (float*)d_out; p.ws = (unsigned char*)d_ws;
    void* args[] = {&p};
    hipError_t e = hipLaunchCooperativeKernel((const void*)fwd_megakernel, dim3(grid), dim3(NTHR), args, LDS_BYTES, stream);
    if (e != hipSuccess) fprintf(stderr, "cooperative launch failed: %s (grid %d)\n", hipGetErrorString(e), grid);
}
```

```cpp
#include <hip/hip_runtime.h>
#include <hip/hip_cooperative_groups.h>
#include <cstdio>
#include <cstdint>
#include <cmath>
namespace cg = cooperative_groups;
namespace pg8 {
#define PG8_LAS __attribute__((address_space(3)))
typedef unsigned short bf16_t;
typedef short bf16x8 __attribute__((ext_vector_type(8)));
typedef float f32x4 __attribute__((ext_vector_type(4)));
typedef unsigned u32x4 __attribute__((ext_vector_type(4)));
constexpr int BM = 256, BK = 64, HALF = 128, HTB = HALF * BK * 2  , STAGE_BYTES = 8 * HTB, NXCD = 8, WGM = 8;

__host__ __device__ __forceinline__ int lds_byte(int r, int c) { const int st = (r >> 4) * 2 + (c >> 5), rr = r & 15, cc = c & 31, ob = rr * 64 + cc * 2; return st * 1024 + (ob ^ (((ob >> 9) & 1) << 5)); }
__host__ __device__ __forceinline__ void stage_rc(int b, int& R, int& C) { const int st = b / 1024, sb = b % 1024, swz = sb ^ (((sb >> 9) & 1) << 5); R = (st >> 1) * 16 + swz / 64; C = (st & 1) * 32 + (swz % 64) / 2; }
__host__ __device__ __forceinline__ int perm32(int rho) { const int n = rho >> 4, i = rho & 15; return 8 * (i >> 2) + 4 * n + (i & 3); }

struct Unit { int pm, pn; };
struct Gemm { const bf16_t* A; const bf16_t* Bt; int M, N, K, lda, ldb; };

struct StaticOrder {
    int nM, nN, nwg, G, c;
    __host__ __device__ void init(int M, int N, int G_, int c_) { nM = M / BM; nN = N / BM; nwg = nM * nN; G = G_; c = c_; }
    __host__ __device__ bool next(int i, Unit& u) const {
        const long L = (long)i * G + c; if (L >= nwg) return false;
        int wgid = (int)L; { const int q = nwg / NXCD, r = nwg % NXCD, xcd = wgid % NXCD, off = wgid / NXCD; wgid = (xcd < r ? xcd * (q + 1) : r * (q + 1) + (xcd - r) * q) + off; }
        const int nig = WGM * nN, gid = wgid / nig, fm = gid * WGM, gsz = (nM - fm) < WGM ? (nM - fm) : WGM;
        u.pm = fm + ((wgid % nig) % gsz); u.pn = (wgid % nig) / gsz; return true;
    }
    __device__ __forceinline__ void a_ready(const Unit&) const {}
    __device__ __forceinline__ void done(const Unit&) const {}
};

__device__ __forceinline__ unsigned cvt_pk_bf16(float lo, float hi) { unsigned r; asm volatile("s_nop 0\n\tv_cvt_pk_bf16_f32 %0, %1, %2" : "=v"(r) : "v"(lo), "v"(hi)); return r; }
typedef float f32x2 __attribute__((ext_vector_type(2)));
__device__ __forceinline__ float shx(float v, int m, int lane) { return __int_as_float(__builtin_amdgcn_ds_bpermute((lane ^ m) << 2, __float_as_int(v))); }
__device__ __forceinline__ int tid_opq(int wave_s) { unsigned ones = ~0u; int w = wave_s; asm volatile("" : "+s"(ones), "+s"(w)); return w * 64 + (int)__builtin_amdgcn_mbcnt_hi(ones, __builtin_amdgcn_mbcnt_lo(ones, 0u)); }
typedef unsigned u32x2 __attribute__((ext_vector_type(2)));
constexpr int MTOK = 65536, DM = 1024, DFF = 2816;
__device__ __forceinline__ float bf_lo(unsigned w) { return __uint_as_float(w << 16); }
__device__ __forceinline__ float bf_hi(unsigned w) { return __uint_as_float(w & 0xffff0000u); }
__device__ __forceinline__ float ex2(float x) { return __builtin_amdgcn_exp2f(x); }
__device__ __forceinline__ float rcpf_(float x) { return __builtin_amdgcn_rcpf(x); }
__device__ __forceinline__ float sigm(float x) { return rcpf_(1.f + ex2(-1.44269504f * x)); }
__device__ __forceinline__ float gelu_tanh(float x) { return x * sigm(1.5957691216f * (x + 0.044715f * x * x * x)); }
__device__ __forceinline__ float row_rstd(const float* ss, int row) {
    const f32x4* p = (const f32x4*)(ss + (size_t)row * 16);
    const f32x4 a = p[0], b = p[1], c = p[2], d = p[3];
    const float s = (((a[0] + a[1]) + (a[2] + a[3])) + ((b[0] + b[1]) + (b[2] + b[3]))) + (((c[0] + c[1]) + (c[2] + c[3])) + ((d[0] + d[1]) + (d[2] + d[3])));
    return __builtin_amdgcn_rsqf(s * (1.0f / 1024.0f) + 1e-6f);
}
__device__ __forceinline__ void rstd8(const float* ss, int row0, int fr, int fq, float (&rs)[2][4]) {
    f32x4 pr[2][4];
#pragma unroll
    for (int ai = 0; ai < 2; ++ai)
#pragma unroll
        for (int m = 0; m < 4; ++m) pr[ai][m] = *(const f32x4*)(ss + (size_t)(row0 + ai * HALF + m * 16) * 16 + 4 * fq);
    const int ln = fr + 16 * fq;
#pragma unroll
    for (int ai = 0; ai < 2; ++ai)
#pragma unroll
        for (int m = 0; m < 4; ++m) { float s = (pr[ai][m][0] + pr[ai][m][1]) + (pr[ai][m][2] + pr[ai][m][3]); s += shx(s, 16, ln); s += shx(s, 32, ln);
            rs[ai][m] = __builtin_amdgcn_rsqf(s * (1.0f / 1024.0f) + 1e-6f); }
}
__device__ __forceinline__ u32x4 pack8(const f32x4 v0, const f32x4 v1) { u32x4 w; w.x = cvt_pk_bf16(v0[0], v0[1]); w.y = cvt_pk_bf16(v0[2], v0[3]); w.z = cvt_pk_bf16(v1[0], v1[1]); w.w = cvt_pk_bf16(v1[2], v1[3]); return w; }

struct EpiSwiglu {
    static constexpr bool PERM = true, AFTER_DRAIN = false, HOOK = false;
    bf16_t* O; const float* ss;
    __device__ __forceinline__ void operator()(const f32x4 (&acc)[2][2][4][2], const Unit& u, int wr, int wc, int fr, int fq) const {
        const int row0 = u.pm * BM + wr * 64 + fr, col0 = u.pn * 128 + wc * 32 + 8 * fq;
        float rsa[2][4]; rstd8(ss, row0, fr, fq, rsa);
#pragma unroll
        for (int ai = 0; ai < 2; ++ai)
#pragma unroll
            for (int m = 0; m < 4; ++m) { const int row = row0 + ai * HALF + m * 16; const float rs = rsa[ai][m], rs2 = rs * rs, k1 = -1.44269504f * rs;
                f32x4 o[2];
#pragma unroll
                for (int n = 0; n < 2; ++n)
#pragma unroll
                    for (int e = 0; e < 4; ++e) { const float ag = acc[ai][0][m][n][e], au = acc[ai][1][m][n][e]; o[n][e] = (ag * au) * (rs2 * rcpf_(1.f + ex2(ag * k1))); }
                *(u32x4*)(O + (size_t)row * DFF + col0) = pack8(o[0], o[1]); }
    }
};
struct EpiResid {
    static constexpr bool PERM = true, AFTER_DRAIN = false, HOOK = false;
    bf16_t* xb; float* ss; float alpha;
    __device__ __forceinline__ void operator()(const f32x4 (&acc)[2][2][4][2], const Unit& u, int wr, int wc, int fr, int fq) const {
        const int row0 = u.pm * BM + wr * 64 + fr, col0 = u.pn * BM + wc * 32 + 8 * fq;
#pragma unroll
        for (int ai = 0; ai < 2; ++ai) { u32x4 bw[4][2];
#pragma unroll
            for (int m = 0; m < 4; ++m)
#pragma unroll
                for (int bj = 0; bj < 2; ++bj) bw[m][bj] = *(const u32x4*)(xb + (size_t)(row0 + ai * HALF + m * 16) * DM + col0 + bj * HALF);
#pragma unroll
            for (int m = 0; m < 4; ++m) { const int row = row0 + ai * HALF + m * 16; float sq = 0.f;
#pragma unroll
                for (int bj = 0; bj < 2; ++bj) { const size_t off = (size_t)row * DM + col0 + bj * HALF; const u32x4 w = bw[m][bj];
                    const f32x4 b0 = {bf_lo(w.x), bf_hi(w.x), bf_lo(w.y), bf_hi(w.y)}, b1 = {bf_lo(w.z), bf_hi(w.z), bf_lo(w.w), bf_hi(w.w)};
                    const f32x4 o0 = b0 + acc[ai][bj][m][0] * alpha, o1 = b1 + acc[ai][bj][m][1] * alpha;
                    *(u32x4*)(xb + off) = pack8(o0, o1);
                    sq += ((o0[0] * o0[0] + o0[1] * o0[1]) + (o0[2] * o0[2] + o0[3] * o0[3])) + ((o1[0] * o1[0] + o1[1] * o1[1]) + (o1[2] * o1[2] + o1[3] * o1[3])); }
                { const int ln = fr + 16 * fq; sq += shx(sq, 16, ln); sq += shx(sq, 32, ln); }
                if (fq == 0) ss[(size_t)row * 16 + u.pn * 4 + wc] = sq; }
            asm volatile("" ::: "memory"); }
    }
};
__device__ __forceinline__ unsigned gate_frag_off(int gt, int pm, int wave, int ai, int m, int bj, int lane) {
    return ((unsigned)(gt * 256 + pm) << 17) + (unsigned)((((wave * 2 + ai) * 4 + m) * 2 + bj) * 64 + lane) * 16u;
}
struct EpiProj {
    static constexpr bool PERM = true, AFTER_DRAIN = false, HOOK = false;
    bf16_t *P, *Q, *K, *LX, *LG, *GATES; const float* ss; const float* mbias;
    __device__ __forceinline__ void operator()(const f32x4 (&acc)[2][2][4][2], const Unit& u, int wr, int wc, int fr, int fq) const {
        const int pn = u.pn; bf16_t* dst; int ld, c0, kind = 0; float sc = 1.f;
        if (pn == 0) { dst = P; ld = 256; c0 = 0; }
        else if (pn < 3) { dst = Q; ld = 512; c0 = (pn - 1) * 256; sc = 0.125f * 1.44269504f; }
        else if (pn < 5) { dst = K; ld = 512; c0 = (pn - 3) * 256; }
        else if (pn == 5) { dst = LX; ld = 256; c0 = 0; }
        else if (pn == 6) { dst = LG; ld = 256; c0 = 0; kind = 1; }
        else { dst = GATES; ld = 3072; c0 = (pn - 7) * 256; kind = 2; }
        const int row0 = u.pm * BM + wr * 64 + fr, col0 = c0 + wc * 32 + 8 * fq;
        f32x4 bv[2][2];
#pragma unroll
        for (int bj = 0; bj < 2; ++bj)
#pragma unroll
            for (int n = 0; n < 2; ++n) bv[bj][n] = (kind == 2) ? *(const f32x4*)(mbias + col0 + bj * HALF + 4 * n) : (f32x4){0.f, 0.f, 0.f, 0.f};
        float rsa[2][4]; rstd8(ss, row0, fr, fq, rsa);
#pragma unroll
        for (int ai = 0; ai < 2; ++ai)
#pragma unroll
            for (int m = 0; m < 4; ++m) { const int row = row0 + ai * HALF + m * 16; const float rs = rsa[ai][m] * sc;
#pragma unroll
                for (int bj = 0; bj < 2; ++bj) { f32x4 v[2];
#pragma unroll
                    for (int n = 0; n < 2; ++n) { v[n] = acc[ai][bj][m][n] * rs;
                        if (kind == 1) {
#pragma unroll
                            for (int e = 0; e < 4; ++e) v[n][e] = gelu_tanh(v[n][e]); }
                        else if (kind == 2) {
#pragma unroll
                            for (int e = 0; e < 4; ++e) v[n][e] = sigm(v[n][e] + bv[bj][n][e]); } }
                    if (kind == 2) *(u32x4*)((char*)GATES + gate_frag_off(pn - 7, u.pm, wr * 4 + wc, ai, m, bj, fr + 16 * fq)) = pack8(v[0], v[1]);
                    else *(u32x4*)(dst + (size_t)row * ld + col0 + bj * HALF) = pack8(v[0], v[1]); } }
    }
};
struct EpiVt {
    static constexpr bool PERM = false, AFTER_DRAIN = false, HOOK = false;
    bf16_t* Vt; const float* ss;
    __device__ __forceinline__ void operator()(const f32x4 (&acc)[2][2][4][2], const Unit& u, int wr, int wc, int fr, int fq) const {
        const int ch0 = u.pm * BM + wr * 64 + fr;
        const int tokj = u.pn * BM + (fr >> 3) * HALF + wc * 32 + ((fr >> 2) & 1) * 16 + 4 * fq + (fr & 3);
        const float rsj = row_rstd(ss, tokj);
#pragma unroll
        for (int bj = 0; bj < 2; ++bj)
#pragma unroll
            for (int n = 0; n < 2; ++n) { const int tok = u.pn * BM + bj * HALF + wc * 32 + n * 16 + 4 * fq;
                f32x4 rs;
#pragma unroll
                for (int e2 = 0; e2 < 4; ++e2) rs[e2] = __int_as_float(__builtin_amdgcn_ds_bpermute(((bj * 8 + n * 4 + e2) + 16 * fq) << 2, __float_as_int(rsj)));
                const int b = tok >> 12, s = tok & 4095, sp = (s & ~15) + 8 * (fq & 1) + 4 * (fq >> 1);
#pragma unroll
                for (int ai = 0; ai < 2; ++ai)
#pragma unroll
                    for (int m = 0; m < 4; ++m) { const int ch = ch0 + ai * HALF + m * 16; const f32x4 v = acc[ai][bj][m][n] * rs;
                        u32x2 w; w.x = cvt_pk_bf16(v[0], v[1]); w.y = cvt_pk_bf16(v[2], v[3]);
                        *(u32x2*)(Vt + ((size_t)(b * 512 + ch)) * 4096 + sp) = w; } }
    }
};
typedef _Float16 h2_t __attribute__((ext_vector_type(2)));
struct EpiGates {
    static constexpr bool PERM = true, AFTER_DRAIN = false, HOOK = false;
    unsigned* AU; const bf16_t* XF  ; const float* b_a; const float* b_x; const float* c8;
    __device__ __forceinline__ void operator()(const f32x4 (&acc)[2][2][4][2], const Unit& u, int wr, int wc, int fr, int fq) const {
        const int dir = u.pn >> 1, half = u.pn & 1; const int row0 = u.pm * BM + wr * 64 + fr, ch0 = half * 128 + wc * 32 + 8 * fq;
#pragma unroll
        for (int n = 0; n < 2; ++n) { const int ch = ch0 + 4 * n;
            const f32x4 ba = *(const f32x4*)(b_a + dir * 256 + ch), bx = *(const f32x4*)(b_x + dir * 256 + ch), cc = *(const f32x4*)(c8 + dir * 256 + ch);
            u32x2 xwa[2][4];
#pragma unroll
            for (int ai = 0; ai < 2; ++ai)
#pragma unroll
                for (int m = 0; m < 4; ++m) xwa[ai][m] = *(const u32x2*)((const char*)XF + ((unsigned)(row0 + ai * HALF + m * 16) * 1024u + (unsigned)ch) * 2u);
#pragma unroll
            for (int ai = 0; ai < 2; ++ai)
#pragma unroll
                for (int m = 0; m < 4; ++m) { const int row = row0 + ai * HALF + m * 16;
                    const u32x2 xw = xwa[ai][m];
                    const float xf[4] = {bf_lo(xw.x), bf_hi(xw.x), bf_lo(xw.y), bf_hi(xw.y)};
                    u32x4 o;
#pragma unroll
                    for (int e = 0; e < 4; ++e) { const float r = sigm(acc[ai][0][m][n][e] + ba[e]), ig = sigm(acc[ai][1][m][n][e] + bx[e]);
                        const float l2a = cc[e] * r; const float a2 = ex2(2.f * l2a); const float uu = __builtin_sqrtf(fmaxf(1.f - a2, 0.f)) * ig * xf[e];
                        h2_t hv; hv[0] = (_Float16)l2a; hv[1] = (_Float16)uu; o[e] = __builtin_bit_cast(unsigned, hv); }
                    *(u32x4*)((char*)AU + (((unsigned)dir * (unsigned)MTOK + (unsigned)row) * 256u + (unsigned)ch) * 4u) = o; }
            asm volatile("" ::: "memory"); }
    }
};
struct EpiMerged {
    static constexpr bool PERM = true, AFTER_DRAIN = false, HOOK = true;
    bf16_t* O; const bf16_t* G  ;
    __device__ __forceinline__ void hook(f32x4 (&acc)[2][2][4][2], const Unit& u, int t, int wr, int wc, int fr, int fq) const {
        const int which = (t == 4) ? 0 : 1;
#pragma unroll
        for (int ai = 0; ai < 2; ++ai) { u32x4 ga[4][2], gb[4][2];
#pragma unroll
            for (int m = 0; m < 4; ++m)
#pragma unroll
                for (int bj = 0; bj < 2; ++bj) { const unsigned go = gate_frag_off(which * 4 + u.pn, u.pm, wr * 4 + wc, ai, m, bj, fr + 16 * fq);
                    ga[m][bj] = *(const u32x4*)((const char*)G + go); gb[m][bj] = *(const u32x4*)((const char*)G + go + ((4u * 256u) << 17)); }
#pragma unroll
            for (int m = 0; m < 4; ++m)
#pragma unroll
                for (int bj = 0; bj < 2; ++bj) { const u32x4 a = ga[m][bj], b = gb[m][bj];
                    acc[ai][bj][m][0][0] *= bf_lo(a.x) * rcpf_(bf_lo(b.x)); acc[ai][bj][m][0][1] *= bf_hi(a.x) * rcpf_(bf_hi(b.x));
                    acc[ai][bj][m][0][2] *= bf_lo(a.y) * rcpf_(bf_lo(b.y)); acc[ai][bj][m][0][3] *= bf_hi(a.y) * rcpf_(bf_hi(b.y));
                    acc[ai][bj][m][1][0] *= bf_lo(a.z) * rcpf_(bf_lo(b.z)); acc[ai][bj][m][1][1] *= bf_hi(a.z) * rcpf_(bf_hi(b.z));
                    acc[ai][bj][m][1][2] *= bf_lo(a.w) * rcpf_(bf_lo(b.w)); acc[ai][bj][m][1][3] *= bf_hi(a.w) * rcpf_(bf_hi(b.w)); }
            asm volatile("" ::: "memory"); }
    }
    __device__ __forceinline__ void operator()(const f32x4 (&acc)[2][2][4][2], const Unit& u, int wr, int wc, int fr, int fq) const {
        const int row0 = u.pm * BM + wr * 64 + fr, col0 = u.pn * BM + wc * 32 + 8 * fq;
#pragma unroll
        for (int ai = 0; ai < 2; ++ai) { u32x4 g2[4][2];
#pragma unroll
            for (int m = 0; m < 4; ++m)
#pragma unroll
                for (int bj = 0; bj < 2; ++bj) g2[m][bj] = *(const u32x4*)((const char*)G + gate_frag_off(8 + u.pn, u.pm, wr * 4 + wc, ai, m, bj, fr + 16 * fq));
#pragma unroll
            for (int m = 0; m < 4; ++m) { const int row = row0 + ai * HALF + m * 16;
#pragma unroll
                for (int bj = 0; bj < 2; ++bj) { const u32x4 g = g2[m][bj];
                    f32x4 v0 = acc[ai][bj][m][0], v1 = acc[ai][bj][m][1];
                    v0[0] *= bf_lo(g.x); v0[1] *= bf_hi(g.x); v0[2] *= bf_lo(g.y); v0[3] *= bf_hi(g.y);
                    v1[0] *= bf_lo(g.z); v1[1] *= bf_hi(g.z); v1[2] *= bf_lo(g.w); v1[3] *= bf_hi(g.w);
                    *(u32x4*)(O + (size_t)row * DM + col0 + bj * HALF) = pack8(v0, v1); } }
            asm volatile("" ::: "memory"); }
    }
};
template <class Epi, class Sched, bool ALIGN_EPI = false, bool SP2 = false>
__device__ __forceinline__ void gemm_phase(PG8_LAS unsigned char* lds, const Gemm g, const Sched& S, const Epi& E, int wave_s) {
    const int tid_ = tid_opq(wave_s);
    const int tid = tid_, wid = __builtin_amdgcn_readfirstlane(tid >> 6), lane = tid & 63, wr = wid >> 2, wc = wid & 3, fr = lane & 15, fq = lane >> 4;
    const int K = g.K, nt = K / BK;
    unsigned voffA[2], voffB[2];
#pragma unroll
    for (int i = 0; i < 2; ++i) { int R, C; stage_rc(tid * 16 + i * 8192, R, C); const int Rb = Epi::PERM ? ((R & ~31) + perm32(R & 31)) : R;
        voffA[i] = (unsigned)(R * g.lda + C) * 2u; voffB[i] = (unsigned)(Rb * g.ldb + C) * 2u; }
    const size_t kstep = (size_t)(BK * 2);
    const size_t hstepA = (size_t)HALF * g.lda * 2, hstepB = (size_t)HALF * g.ldb * 2;
    const size_t tstepA = 2 * hstepA, tstepB = 2 * hstepB;
    const unsigned ldsw = (unsigned)wid * 1024u;
    const int aoff = lds_byte(wr * 64 + fr, fq * 8), boff = lds_byte(wc * 32 + fr, fq * 8);
#define PG8_SA(b, h) (((b) * 2 + (h)) * HTB)
#define PG8_SB(b, h) ((4 + (b) * 2 + (h)) * HTB)
#define PG8_STAGE(bufoff, gbase, voff) do { _Pragma("unroll") for (int _i = 0; _i < 2; ++_i) \
        __builtin_amdgcn_global_load_lds((const unsigned*)((const char*)(gbase) + (voff)[_i]), (PG8_LAS unsigned*)(lds + (bufoff) + ldsw + _i * 8192), 16, 0, 0); } while (0)
#define PG8_LDA(dst, b, h) do { _Pragma("unroll") for (int m = 0; m < 4; ++m) _Pragma("unroll") for (int k = 0; k < 2; ++k) dst[m][k] = *(const PG8_LAS bf16x8*)(lds + PG8_SA(b, h) + aoff + m * 2048 + k * 1024); } while (0)
#define PG8_LDB(dst, b, h) do { _Pragma("unroll") for (int n = 0; n < 2; ++n) _Pragma("unroll") for (int k = 0; k < 2; ++k) dst[n][k] = *(const PG8_LAS bf16x8*)(lds + PG8_SB(b, h) + boff + n * 2048 + k * 1024); } while (0)
#define PG8_MMA(ai, bj, At, Bt) do { __builtin_amdgcn_s_setprio(1); _Pragma("unroll") for (int m = 0; m < 4; ++m) _Pragma("unroll") for (int n = 0; n < 2; ++n) _Pragma("unroll") for (int k = 0; k < 2; ++k) \
        acc[ai][bj][m][n] = __builtin_amdgcn_mfma_f32_16x16x32_bf16(Bt[n][k], At[m][k], acc[ai][bj][m][n], 0, 0, 0); __builtin_amdgcn_s_setprio(0); } while (0)
#define PG8_WAIT_V(n) asm volatile("s_waitcnt vmcnt(" #n ")" ::: "memory")
#define PG8_WAIT_L(n) asm volatile("s_waitcnt lgkmcnt(" #n ")" ::: "memory")
#define PG8_BAR __builtin_amdgcn_s_barrier()
#define PG8_SCHED __builtin_amdgcn_sched_barrier(0)
    Unit cur, nxt; int ui = 0;
    if (!S.next(0, cur)) return;
    f32x4 acc[2][2][4][2];
#pragma unroll
    for (int a = 0; a < 2; ++a)
#pragma unroll
        for (int b = 0; b < 2; ++b)
#pragma unroll
            for (int m = 0; m < 4; ++m)
#pragma unroll
                for (int n = 0; n < 2; ++n) acc[a][b][m][n] = (f32x4){0.f, 0.f, 0.f, 0.f};
    bf16x8 At[4][2], B0[2][2], B1[2][2];
    const char* cA = (const char*)g.A + (size_t)cur.pm * tstepA; const char* cB = (const char*)g.Bt + (size_t)cur.pn * tstepB;
    S.a_ready(cur);
    if constexpr (SP2) {
        PG8_STAGE(PG8_SB(0, 0), cB, voffB); PG8_STAGE(PG8_SB(0, 1), cB + hstepB, voffB); PG8_STAGE(PG8_SA(0, 0), cA, voffA); PG8_STAGE(PG8_SA(0, 1), cA + hstepA, voffA);
        if (wr == 1) PG8_BAR;
        PG8_WAIT_V(2); PG8_BAR;
        PG8_STAGE(PG8_SB(1, 0), cB + kstep, voffB); PG8_STAGE(PG8_SA(1, 0), cA + kstep, voffA); PG8_STAGE(PG8_SB(1, 1), cB + hstepB + kstep, voffB);
        PG8_WAIT_V(6); PG8_BAR;
    } else {
        PG8_STAGE(PG8_SB(0, 0), cB, voffB); PG8_STAGE(PG8_SA(0, 0), cA, voffA); PG8_STAGE(PG8_SB(0, 1), cB + hstepB, voffB); PG8_STAGE(PG8_SA(0, 1), cA + hstepA, voffA);
        if (wr == 1) PG8_BAR;
        PG8_WAIT_V(4); PG8_BAR;
        PG8_STAGE(PG8_SB(1, 0), cB + kstep, voffB); PG8_STAGE(PG8_SA(1, 0), cA + kstep, voffA); PG8_STAGE(PG8_SB(1, 1), cB + hstepB + kstep, voffB);
        PG8_WAIT_V(6); PG8_BAR;
    }
    for (;;) {
        const bool has_next = S.next(ui + 1, nxt);
        const char* nA = has_next ? (const char*)g.A + (size_t)nxt.pm * tstepA : cA; const char* nB = has_next ? (const char*)g.Bt + (size_t)nxt.pn * tstepB : cB;
        for (int t = 0; t < nt; t += 2) {
            const bool last = (t == nt - 2);
            if constexpr (Epi::HOOK) { if (t == 4 || t == 12) { PG8_SCHED; E.hook(acc, cur, t, wr, wc, fr, fq); PG8_SCHED; } }
            const char* a1 = cA + (size_t)(t + 1) * kstep;
            const char* a2 = last ? nA : cA + (size_t)(t + 2) * kstep; const char* b2 = last ? nB : cB + (size_t)(t + 2) * kstep;
            const char* a3 = a2 + kstep; const char* b3 = b2 + kstep;
            if (last && has_next) S.a_ready(nxt);
            if constexpr (SP2) {
            PG8_LDB(B0, 0, 0); PG8_LDB(B1, 0, 1); PG8_SCHED; PG8_LDA(At, 0, 0); PG8_STAGE(PG8_SA(1, 1), a1 + hstepA, voffA);
            PG8_WAIT_V(8); PG8_WAIT_L(0); PG8_BAR; PG8_MMA(0, 0, At, B0); PG8_MMA(0, 1, At, B1); PG8_BAR; PG8_SCHED;
            PG8_LDA(At, 0, 1); PG8_STAGE(PG8_SB(0, 0), b2, voffB); PG8_STAGE(PG8_SB(0, 1), b2 + hstepB, voffB); PG8_STAGE(PG8_SA(0, 0), a2, voffA);
            PG8_WAIT_V(8); PG8_WAIT_L(0); PG8_BAR; PG8_MMA(1, 0, At, B0); PG8_MMA(1, 1, At, B1); PG8_BAR; PG8_SCHED;
            PG8_LDB(B0, 1, 0); PG8_LDB(B1, 1, 1); PG8_SCHED; PG8_LDA(At, 1, 0); PG8_STAGE(PG8_SA(0, 1), a2 + hstepA, voffA);
            PG8_WAIT_V(8); PG8_WAIT_L(0); PG8_BAR; PG8_MMA(0, 0, At, B0); PG8_MMA(0, 1, At, B1); PG8_BAR; PG8_SCHED;
            PG8_LDA(At, 1, 1); PG8_STAGE(PG8_SB(1, 0), b3, voffB); PG8_STAGE(PG8_SB(1, 1), b3 + hstepB, voffB); PG8_STAGE(PG8_SA(1, 0), a3, voffA);
            PG8_WAIT_V(8); PG8_WAIT_L(0); PG8_BAR; PG8_MMA(1, 0, At, B0); PG8_MMA(1, 1, At, B1); PG8_BAR; PG8_SCHED;
            } else {
            PG8_LDB(B0, 0, 0); PG8_SCHED; PG8_LDA(At, 0, 0); PG8_STAGE(PG8_SA(1, 1), a1 + hstepA, voffA);
            PG8_WAIT_L(8); PG8_BAR; PG8_WAIT_L(0); PG8_MMA(0, 0, At, B0); PG8_BAR; PG8_SCHED;
            PG8_LDB(B1, 0, 1); PG8_STAGE(PG8_SB(0, 0), b2, voffB);
            PG8_BAR; PG8_WAIT_L(0); PG8_MMA(0, 1, At, B1); PG8_BAR;
            PG8_LDA(At, 0, 1); PG8_STAGE(PG8_SA(0, 0), a2, voffA);
            PG8_BAR; PG8_WAIT_L(0); PG8_MMA(1, 0, At, B0); PG8_BAR; PG8_SCHED;
            PG8_STAGE(PG8_SB(0, 1), b2 + hstepB, voffB);
            PG8_WAIT_V(6); PG8_BAR; PG8_MMA(1, 1, At, B1); PG8_BAR;
            PG8_LDB(B0, 1, 0); PG8_SCHED; PG8_LDA(At, 1, 0); PG8_STAGE(PG8_SA(0, 1), a2 + hstepA, voffA);
            PG8_WAIT_L(8); PG8_BAR; PG8_WAIT_L(0); PG8_MMA(0, 0, At, B0); PG8_BAR; PG8_SCHED;
            PG8_LDB(B1, 1, 1); PG8_STAGE(PG8_SB(1, 0), b3, voffB);
            PG8_BAR; PG8_WAIT_L(0); PG8_MMA(0, 1, At, B1); PG8_BAR;
            PG8_LDA(At, 1, 1); PG8_STAGE(PG8_SA(1, 0), a3, voffA);
            PG8_BAR; PG8_WAIT_L(0); PG8_MMA(1, 0, At, B0); PG8_BAR; PG8_SCHED;
            PG8_STAGE(PG8_SB(1, 1), b3 + hstepB, voffB);
            PG8_WAIT_V(6); PG8_BAR; PG8_MMA(1, 1, At, B1); PG8_BAR;
            }
        }
        if constexpr (ALIGN_EPI) { if (wr == 0) PG8_BAR; }
        if constexpr (!Epi::AFTER_DRAIN) { E(acc, cur, wr, wc, fr, fq); S.done(cur); }
        if (!has_next) break;
#pragma unroll
        for (int a = 0; a < 2; ++a)
#pragma unroll
            for (int b = 0; b < 2; ++b)
#pragma unroll
                for (int m = 0; m < 4; ++m)
#pragma unroll
                    for (int n = 0; n < 2; ++n) acc[a][b][m][n] = (f32x4){0.f, 0.f, 0.f, 0.f};
        cur = nxt; cA = nA; cB = nB; ++ui;
        if constexpr (ALIGN_EPI) { if (wr == 1) PG8_BAR; }
    }
    PG8_WAIT_V(0);
    if constexpr (!ALIGN_EPI) { if (wr == 0) PG8_BAR; }
    PG8_BAR;
    if constexpr (Epi::AFTER_DRAIN) { E.fused(acc, cur, wr, wc, fr, fq, lds, wid, lane); S.done(cur); }
#undef PG8_SA
#undef PG8_SB
#undef PG8_STAGE
#undef PG8_LDA
#undef PG8_LDB
#undef PG8_MMA
#undef PG8_WAIT_V
#undef PG8_WAIT_L
#undef PG8_BAR
#undef PG8_SCHED
}
}
using namespace pg8;
#define LAS __attribute__((address_space(3)))
typedef float f32x16 __attribute__((ext_vector_type(16)));
constexpr int NWAVES = 8, NTHR = 512;
constexpr int SEQ = 4096, NBATCH = 16;
constexpr int LDS_BYTES = 147456;
constexpr int LDS_SCR = 131072;
constexpr size_t MiB = 1u << 20;
constexpr size_t WS_KMAX = 32768;
constexpr size_t WS_SS = 1 * MiB, WS_W = 5 * MiB, WS_TAB = 53 * MiB, WS_XB = 54 * MiB, WS_MIX = 182 * MiB;
constexpr size_t WS_P = WS_MIX, WS_LX = WS_MIX + 32 * MiB, WS_Q = WS_MIX + 64 * MiB, WS_K = WS_MIX + 128 * MiB, WS_LG = WS_MIX + 192 * MiB,
                 WS_VT = WS_MIX + 224 * MiB, WS_BR = WS_MIX + 288 * MiB, WS_GATES = WS_MIX + 416 * MiB, WS_END = WS_MIX + 800 * MiB;
constexpr size_t WS_MERGED = WS_Q, WS_ACT = WS_MIX;
constexpr size_t WO_W1A = 0, WO_W2A = WO_W1A + 5632 * 1024, WO_WP = WO_W2A + 1024 * 2816, WO_WV = WO_WP + 4864 * 1024, WO_WG = WO_WV + 512 * 1024,
                 WO_WBR = WO_WG + 1024 * 256, WO_WO = WO_WBR + 1024 * 1024, WO_W1B = WO_WO + 1024 * 1024, WO_W2B = WO_W1B + 5632 * 1024, WO_END = WO_W2B + 1024 * 2816;
static_assert(WO_END * 2 <= 48 * MiB, "weights region");

struct Params { const float* in[26]; float* out; unsigned char* ws; };

__device__ __forceinline__ unsigned f2bf(float f) { unsigned u = __builtin_bit_cast(unsigned, f); return (u + 0x7fffu + ((u >> 16) & 1u)) >> 16; }
__device__ __forceinline__ unsigned pk2(float lo, float hi) { return f2bf(lo) | (f2bf(hi) << 16); }
__device__ __forceinline__ float wave_sum(float v, int lane) {
#pragma unroll
    for (int o = 1; o < 64; o <<= 1) v += shx(v, o, lane);
    return v;
}
__device__ __forceinline__ void transpose_block(const float* W, int ldsrc, int sc0, int k0, bf16_t* WT, int ldd, int dr0, int koff, const float* kscale, LAS float* scr, int lane) {
#pragma unroll 16
    for (int i = 0; i < 32; ++i) { const int kk = 2 * i + (lane >> 5); float v = W[(size_t)(k0 + kk) * ldsrc + sc0 + (lane & 31)]; if (kscale) v *= kscale[k0 + kk]; scr[kk * 33 + (lane & 31)] = v; }
    asm volatile("s_waitcnt lgkmcnt(0)" ::: "memory");
    const int c = lane & 7;
#pragma unroll
    for (int j = 0; j < 4; ++j) { const int n = (lane >> 3) + 8 * j; const LAS float* s = scr + (8 * c) * 33 + n;
        u32x4 o; o.x = pk2(s[0 * 33], s[1 * 33]); o.y = pk2(s[2 * 33], s[3 * 33]); o.z = pk2(s[4 * 33], s[5 * 33]); o.w = pk2(s[6 * 33], s[7 * 33]);
        *(u32x4*)(WT + (size_t)(dr0 + n) * ldd + koff + k0 + 8 * c) = o; }
    asm volatile("s_waitcnt lgkmcnt(0)" ::: "memory");
}
typedef const __attribute__((address_space(4))) Params* KPc;
__device__ __forceinline__ void convert_layer(KPc pp, int l, LAS unsigned char* lds, int G, int wave_s) {
    const int tid = tid_opq(wave_s), lane = tid & 63, wave = tid >> 6;
    LAS float* scr = (LAS float*)(lds + wave * 16384);
    bf16_t* Wb = (bf16_t*)(pp->ws + WS_W);
    const int gw = blockIdx.x * NWAVES + wave, NGW = G * NWAVES;
    constexpr int I_W1 = 16 * 176, I_W2 = 44 * 32, I_WP = 16 * 152, I_WV = 16 * 16, I_BA = 8 * 32, I_BL = 4 * 32, I_WO = 16 * 32;
    constexpr int NIT = 2 * I_W1 + 2 * I_W2 + I_WP + I_WV + I_BA + I_BL + I_WO;
    for (int it = gw; it < NIT; it += NGW) {
        int r = it;
        if (r < 2 * I_W1) { const int f = r / I_W1; r -= f * I_W1; const int kb = r / 176, nb = r % 176; const int dr0 = nb * 32, tile = dr0 >> 8, within = dr0 & 255, bj = within >> 7, j = within & 127;
            const float* src = pp->in[f ? 23 : 2] + (size_t)l * 1024 * 5632; const float* gn = pp->in[f ? 22 : 1] + l * 1024;
            transpose_block(src, 5632, bj * 2816 + tile * 128 + j, kb * 64, Wb + (f ? WO_W1B : WO_W1A), 1024, dr0, 0, gn, scr, lane); continue; }
        r -= 2 * I_W1;
        if (r < 2 * I_W2) { const int f = r / I_W2; r -= f * I_W2; const int kb = r / 32, nb = r % 32;
            const float* src = pp->in[f ? 24 : 3] + (size_t)l * 2816 * 1024;
            transpose_block(src, 1024, nb * 32, kb * 64, Wb + (f ? WO_W2B : WO_W2A), 2816, nb * 32, 0, nullptr, scr, lane); continue; }
        r -= 2 * I_W2;
        if (r < I_WP) { const int kb = r / 152, nb = r % 152; const int dr0 = nb * 32; const int sc0 = dr0 < 1280 ? dr0 : dr0 + 512;
            transpose_block(pp->in[5] + (size_t)l * 1024 * 5376, 5376, sc0, kb * 64, Wb + WO_WP, 1024, dr0, 0, pp->in[4] + l * 1024, scr, lane); continue; }
        r -= I_WP;
        if (r < I_WV) { const int kb = r / 16, nb = r % 16;
            transpose_block(pp->in[5] + (size_t)l * 1024 * 5376, 5376, 1280 + nb * 32, kb * 64, Wb + WO_WV, 1024, nb * 32, 0, pp->in[4] + l * 1024, scr, lane); continue; }
        r -= I_WV;
        if (r < I_BA) { const int kb = r / 32, nb = r % 32;
            transpose_block(pp->in[18] + (size_t)l * 512 * 1024, 1024, nb * 32, kb * 64, Wb + WO_WBR, 1024, nb * 32, 256, nullptr, scr, lane); continue; }
        r -= I_BA;
        if (r < I_BL) { const int kb = r / 32, nb = r % 32;
            transpose_block(pp->in[19] + (size_t)l * 256 * 1024, 1024, nb * 32, kb * 64, Wb + WO_WBR, 1024, nb * 32, 768, nullptr, scr, lane); continue; }
        r -= I_BL;
        { const int kb = r / 32, nb = r % 32;
            transpose_block(pp->in[21] + (size_t)l * 1024 * 1024, 1024, nb * 32, kb * 64, Wb + WO_WO, 1024, nb * 32, 0, nullptr, scr, lane); }
    }
    const int gt = blockIdx.x * NTHR + tid, NGT = G * NTHR;
    { const float* pw = pp->in[6] + (size_t)l * 4 * 64 * 64; const float* ps = pp->in[7] + l * 256; const float* wbp = pp->in[17] + (size_t)l * 256 * 1024;
      for (int i = gt; i < 256 * 1024; i += NGT) { const int n = i & 1023, k = i >> 10, g = k >> 6; const float* pr = pw + (size_t)k * 64; float s = 0.f;
#pragma unroll 16
          for (int d = 0; d < 64; ++d) s += pr[d] * ps[64 * g + d] * wbp[(size_t)(64 * g + d) * 1024 + n];
          Wb[WO_WBR + (size_t)n * 1024 + k] = (bf16_t)f2bf(s); } }
    { for (int i = gt; i < 1024 * 256; i += NGT) { const int k = i & 255, n = i >> 8, tile = n >> 8, bj = (n >> 7) & 1, j = n & 127, dir = tile >> 1, half = tile & 1, ch = half * 128 + j, gq = ch >> 6, d = ch & 63;
          const float* w = pp->in[bj ? 14 : 12] + ((size_t)(l * 2 + dir) * 4 + gq) * 64 * 64; const float v = ((k >> 6) == gq) ? w[(k & 63) * 64 + d] : 0.f;
          Wb[WO_WG + (size_t)n * 256 + k] = (bf16_t)f2bf(v); } }
    { float* tab = (float*)(pp->ws + WS_TAB); const float* lam = pp->in[16] + l * 512;
      for (int i = gt; i < 512; i += NGT) tab[i] = -8.0f * __builtin_amdgcn_logf(1.0f + ex2(-1.44269504f * lam[i])); }
}
__device__ __forceinline__ void x_to_bf16(const float* x, bf16_t* xb, float* ss, int G, int wave_s) {
    const int tid = tid_opq(wave_s), lane = tid & 63, wave = tid >> 6; const int gw = blockIdx.x * NWAVES + wave, NGW = G * NWAVES;
    for (int m0 = gw * 4; m0 < MTOK; m0 += NGW * 4) { f32x4 v[4][4];
#pragma unroll
        for (int r = 0; r < 4; ++r)
#pragma unroll
            for (int j = 0; j < 4; ++j) v[r][j] = ((const f32x4*)(x + (size_t)(m0 + r) * DM) + lane)[64 * j];
#pragma unroll
        for (int r = 0; r < 4; ++r) { u32x2* o = (u32x2*)(xb + (size_t)(m0 + r) * DM) + lane; float s = 0.f;
#pragma unroll
            for (int j = 0; j < 4; ++j) { const f32x4 q = v[r][j]; s += (q[0] * q[0] + q[1] * q[1]) + (q[2] * q[2] + q[3] * q[3]); u32x2 w; w.x = cvt_pk_bf16(q[0], q[1]); w.y = cvt_pk_bf16(q[2], q[3]); o[64 * j] = w; }
            s = wave_sum(s, lane); if (lane < 16) ss[(size_t)(m0 + r) * 16 + lane] = (lane == 0) ? s : 0.f; } }
}
__device__ __forceinline__ void final_norm(const bf16_t* xb, float* out, const float* ss, const float* g, int G, int wave_s) {
    const int tid = tid_opq(wave_s), lane = tid & 63, wave = tid >> 6; const int gw = blockIdx.x * NWAVES + wave, NGW = G * NWAVES;
    f32x4 gv[4];
#pragma unroll
    for (int j = 0; j < 4; ++j) gv[j] = ((const f32x4*)g)[lane + 64 * j];
    for (int m0 = gw * 4; m0 < MTOK; m0 += NGW * 4) { u32x2 w[4][4]; float rs[4];
#pragma unroll
        for (int r = 0; r < 4; ++r) { rs[r] = row_rstd(ss, m0 + r);
#pragma unroll
            for (int j = 0; j < 4; ++j) w[r][j] = ((const u32x2*)(xb + (size_t)(m0 + r) * DM) + lane)[64 * j]; }
#pragma unroll
        for (int r = 0; r < 4; ++r) { f32x4* o = (f32x4*)(out + (size_t)(m0 + r) * DM) + lane;
#pragma unroll
            for (int j = 0; j < 4; ++j) { const u32x2 q = w[r][j]; const f32x4 v = {bf_lo(q.x), bf_hi(q.x), bf_lo(q.y), bf_hi(q.y)}; o[64 * j] = v * rs[r] * gv[j]; } } }
}
__device__ __forceinline__ void unpack8(const u32x4 w, float* f) { f[0] = bf_lo(w.x); f[1] = bf_hi(w.x); f[2] = bf_lo(w.y); f[3] = bf_hi(w.y); f[4] = bf_lo(w.z); f[5] = bf_hi(w.z); f[6] = bf_lo(w.w); f[7] = bf_hi(w.w); }
__device__ __forceinline__ u32x4 pack8f(const float* f) { u32x4 w; w.x = cvt_pk_bf16(f[0], f[1]); w.y = cvt_pk_bf16(f[2], f[3]); w.z = cvt_pk_bf16(f[4], f[5]); w.w = cvt_pk_bf16(f[6], f[7]); return w; }
__device__ __forceinline__ void prep_phase(const bf16_t* __restrict__ P, const bf16_t* __restrict__ LX, bf16_t* __restrict__ BR, const float* __restrict__ cw, const float* __restrict__ cb, const bf16_t* __restrict__ Kb, unsigned* __restrict__ kmax2, int G, int wave_s) {
    const int tid = tid_opq(wave_s), sub = tid >> 5, c8 = (tid & 31) * 8;
#pragma unroll 2
    for (int rb = blockIdx.x; rb < MTOK / 16; rb += G) { const int row = rb * 16 + sub, t = row & (SEQ - 1), b0 = row - t;
        { const int g = c8 >> 6, hw = 1 << g; const int lo = max(t - hw, 0), hi = min(t + hw, SEQ); float sum[8] = {0, 0, 0, 0, 0, 0, 0, 0}, f[8];
#pragma unroll
          for (int o = 0; o < 16; ++o) { const int tt = t - hw + o; if (o < 2 * hw && tt >= 0 && tt < SEQ) { unpack8(*(const u32x4*)(P + (size_t)(b0 + tt) * 256 + c8), f);
#pragma unroll
              for (int e = 0; e < 8; ++e) sum[e] += f[e]; } }
          unpack8(*(const u32x4*)(P + (size_t)row * 256 + c8), f); const float inv = 1.0f / (float)(hi - lo);
#pragma unroll
          for (int e = 0; e < 8; ++e) sum[e] = sum[e] * inv - f[e];
          *(u32x4*)(BR + (size_t)row * 1024 + c8) = pack8f(sum); }
        { float a[8], f[8];
#pragma unroll
          for (int e = 0; e < 8; ++e) a[e] = cb[c8 + e];
#pragma unroll
          for (int j = 0; j < 4; ++j) { const int tt = t - 2 + j; if (tt >= 0 && tt < SEQ) { unpack8(*(const u32x4*)(LX + (size_t)(b0 + tt) * 256 + c8), f);
#pragma unroll
                  for (int e = 0; e < 8; ++e) a[e] += cw[j * 256 + c8 + e] * f[e]; } }
          *(u32x4*)(BR + (size_t)row * 1024 + 768 + c8) = pack8f(a); }
        { float f[8], g8[8]; unpack8(*(const u32x4*)(Kb + (size_t)row * 512 + 2 * c8), f); unpack8(*(const u32x4*)(Kb + (size_t)row * 512 + 2 * c8 + 8), g8); float s = 0.f;
#pragma unroll
          for (int e = 0; e < 8; ++e) s += f[e] * f[e] + g8[e] * g8[e];
          s += shx(s, 1, tid & 63); s += shx(s, 2, tid & 63);
          if ((tid & 3) == 0) { unsigned* dst = kmax2 + (row >> 12) * 8 + ((tid & 31) >> 2); const unsigned sv = __float_as_uint(s);
              if (sv > __hip_atomic_load(dst, __ATOMIC_RELAXED, __HIP_MEMORY_SCOPE_AGENT)) atomicMax(dst, sv); } }
    }
}
__device__ __forceinline__ void lau4(const u32x4 w, f32x4& a, f32x4& u) {
    const unsigned w0 = w.x, w1 = w.y, w2 = w.z, w3 = w.w;
    const h2_t h0 = __builtin_bit_cast(h2_t, w0), h1 = __builtin_bit_cast(h2_t, w1), h2 = __builtin_bit_cast(h2_t, w2), h3 = __builtin_bit_cast(h2_t, w3);
    a = (f32x4){ex2((float)h0[0]), ex2((float)h1[0]), ex2((float)h2[0]), ex2((float)h3[0])}; u = (f32x4){(float)h0[1], (float)h1[1], (float)h2[1], (float)h3[1]};
}
__device__ __forceinline__ void scan_unit(LAS unsigned char* lds, const unsigned* __restrict__ AU, const bf16_t* __restrict__ GL, bf16_t* __restrict__ BR, int b, int cg8, int wave_s) {
    const int tid = tid_opq(wave_s), cq = tid & 1, j = tid >> 1, ch = cg8 * 8 + cq * 4, t0 = j * 16;
    LAS float* sPf = (LAS float*)lds; LAS float* sHf = sPf + 2048; LAS float* sPb = sPf + 4096; LAS float* sHb = sPf + 6144; LAS float* sCf = sPf + 8192; LAS float* sCb = sPf + 10240;
    const unsigned* auf = AU + ((size_t)b * SEQ + t0) * 256 + ch; const unsigned* aub = auf + (size_t)MTOK * 256;
    u32x4 wf[16], wb[16];
#pragma unroll
    for (int s = 0; s < 16; ++s) { wf[s] = *(const u32x4*)(auf + (size_t)s * 256); wb[s] = *(const u32x4*)(aub + (size_t)s * 256); }
    { f32x4 Pp = {1.f, 1.f, 1.f, 1.f}, H = {0.f, 0.f, 0.f, 0.f};
#pragma unroll
      for (int s = 0; s < 16; ++s) { f32x4 a, u; lau4(wf[s], a, u); Pp = Pp * a; H = a * H + u; }
      *(LAS f32x4*)(sPf + j * 8 + cq * 4) = Pp; *(LAS f32x4*)(sHf + j * 8 + cq * 4) = H; }
    { f32x4 Pp = {1.f, 1.f, 1.f, 1.f}, H = {0.f, 0.f, 0.f, 0.f};
#pragma unroll
      for (int s = 15; s >= 0; --s) { f32x4 a, u; lau4(wb[s], a, u); Pp = Pp * a; H = a * H + u; }
      *(LAS f32x4*)(sPb + j * 8 + cq * 4) = Pp; *(LAS f32x4*)(sHb + j * 8 + cq * 4) = H; }
#pragma unroll
    for (int s = 0; s < 16; ++s) { asm volatile("" : "+v"(wf[s]), "+v"(wb[s])); }
    __syncthreads();
    if (tid < 16) { const int c = tid & 7; float h = 0.f;
        if (tid < 8) {
#pragma unroll 8
            for (int jj = 0; jj < 256; ++jj) { sCf[jj * 8 + c] = h; h = sPf[jj * 8 + c] * h + sHf[jj * 8 + c]; } }
        else {
#pragma unroll 8
            for (int jj = 255; jj >= 0; --jj) { sCb[jj * 8 + c] = h; h = sPb[jj * 8 + c] * h + sHb[jj * 8 + c]; } } }
    __syncthreads();
    { f32x4 h = *(const LAS f32x4*)(sCb + j * 8 + cq * 4);
#pragma unroll
      for (int s = 15; s >= 0; --s) { f32x4 a, u; lau4(wb[s], a, u); h = a * h + u; wb[s] = __builtin_bit_cast(u32x4, h); } }
    { f32x4 h = *(const LAS f32x4*)(sCf + j * 8 + cq * 4);
      for (int sb = 0; sb < 16; sb += 8) { u32x2 gw[8];
#pragma unroll
        for (int i = 0; i < 8; ++i) gw[i] = *(const u32x2*)(GL + ((size_t)b * SEQ + t0 + sb + i) * 256 + ch);
#pragma unroll
        for (int i = 0; i < 8; ++i) { const int s = sb + i; const size_t row = (size_t)b * SEQ + t0 + s; f32x4 a, u; lau4(wf[s], a, u); h = a * h + u; const f32x4 hb = __builtin_bit_cast(f32x4, wb[s]);
            const f32x4 o = {(h[0] + hb[0]) * bf_lo(gw[i].x), (h[1] + hb[1]) * bf_hi(gw[i].x), (h[2] + hb[2]) * bf_lo(gw[i].y), (h[3] + hb[3]) * bf_hi(gw[i].y)};
            u32x2 ow; ow.x = cvt_pk_bf16(o[0], o[1]); ow.y = cvt_pk_bf16(o[2], o[3]); *(u32x2*)(BR + row * 1024 + 768 + ch) = ow; } } }
    __syncthreads();
}
__device__ __forceinline__ int crow(int r, int hi) { return (r & 3) + 8 * (r >> 2) + 4 * hi; }
__device__ __forceinline__ bf16x8 pack_p(const f32x16& s, int o) {
    u32x4 w; w.x = cvt_pk_bf16(s[o + 0], s[o + 1]); w.y = cvt_pk_bf16(s[o + 2], s[o + 3]); w.z = cvt_pk_bf16(s[o + 4], s[o + 5]); w.w = cvt_pk_bf16(s[o + 6], s[o + 7]);
    return __builtin_bit_cast(bf16x8, w);
}
__device__ __forceinline__ void attn_unit(LAS unsigned char* lds, const bf16_t* Q, const bf16_t* Kb, const bf16_t* Vt, bf16_t* BR, int b, int h, int qblk, float lam, float slope2, const float* subln, float lam_init, const unsigned* kmax2, int wave_s) {
    const int tid = tid_opq(wave_s), lane = tid & 63, wid = wave_s  , r32 = lane & 31, hi = lane >> 5, mp = wid >> 2, wq = wid & 3;
    const int q0 = qblk * 128; const size_t rowbase = (size_t)b * SEQ;
    bf16x8 qf[4];
    { const bf16_t* qp = Q + (rowbase + q0 + wq * 32 + r32) * 512 + h * 128 + mp * 64 + hi * 8;
#pragma unroll
      for (int d0 = 0; d0 < 4; ++d0) qf[d0] = *(const bf16x8*)(qp + d0 * 16); }
    const int srow = tid >> 3, sc = (tid & 7) ^ ((srow >> 1) & 7);
    const bf16_t* kg = Kb + (rowbase + srow) * 512 + h * 128 + sc * 8;
    const bf16_t* vg = Vt + ((size_t)(b * 512 + h * 128 + srow)) * 4096 + sc * 8;
    const int wofs = wid * 1024;
    const int sw = (r32 >> 1) & 7;
    const int kfo = mp * 8192 + r32 * 128, vfo = 65536 + r32 * 128;
#define ATT_DMA(gp, off) __builtin_amdgcn_global_load_lds((const unsigned*)(gp), (LAS unsigned*)(lds + (off)), 16, 0, 0)
    LAS float* scr = (LAS float*)(lds + LDS_SCR + wid * 128);
    const int td = q0 >> 6;
    { const size_t k0_ = (size_t)td * 64, k1_ = k0_ + 64;
      ATT_DMA(kg + k0_ * 512, wofs); ATT_DMA(kg + k0_ * 512 + 64, 8192 + wofs); ATT_DMA(kg + k1_ * 512, 16384 + wofs); ATT_DMA(kg + k1_ * 512 + 64, 16384 + 8192 + wofs);
      ATT_DMA(vg + k0_, 65536 + wofs); ATT_DMA(vg + k0_ + (size_t)64 * 4096, 65536 + 8192 + wofs); }
    int tlo, thi;
    { float q2 = 0.f;
#pragma unroll
      for (int d0 = 0; d0 < 4; ++d0) { const u32x4 w = __builtin_bit_cast(u32x4, qf[d0]); float f[8]; unpack8(w, f);
#pragma unroll
          for (int e = 0; e < 8; ++e) q2 += f[e] * f[e]; }
      q2 += shx(q2, 32, lane);
#pragma unroll
      for (int o = 1; o < 32; o <<= 1) q2 = fmaxf(q2, shx(q2, o, lane));
      LAS float* qx = (LAS float*)(lds + LDS_SCR + 1040);
      if (lane == 0) qx[wid] = q2;
      __syncthreads();
      float qm = qx[0];
#pragma unroll
      for (int w = 1; w < 8; ++w) qm = fmaxf(qm, qx[w]);
      const float k2 = fmaxf(__uint_as_float(kmax2[b * 8 + 2 * h]), __uint_as_float(kmax2[b * 8 + 2 * h + 1]));
      const float bound = 160.0f + 2.02f * __builtin_sqrtf(qm * k2);
      const float Df = fminf(bound / slope2, 16384.0f);
      const int hi_ = (int)floorf((Df + (float)(q0 + 127)) * (1.0f / 64.0f)), lo_ = (int)ceilf(((float)(q0 - 63) - Df) * (1.0f / 64.0f));
      thi = __builtin_amdgcn_readfirstlane(hi_ > 63 ? 63 : hi_); tlo = __builtin_amdgcn_readfirstlane(lo_ < 0 ? 0 : lo_);
      if (thi < td + 1) thi = td + 1; if (tlo > td) tlo = td; }
    const int ntile = thi - tlo + 1, nr = thi - td + 1;
#define ATT_TILE(i) (((i) < nr) ? (td + (i)) : (td - 1 + nr - (i)))
#define SBAR() __builtin_amdgcn_sched_barrier(0)
#define MFMA32(a, b, c) __builtin_amdgcn_mfma_f32_32x32x16_bf16(a, b, c, 0, 0, 0)
    { const u32x4 z = (u32x4){0u, 0u, 0u, 0u}; *(LAS u32x4*)(lds + 65536 + 3 * 16384 + tid * 32) = z; *(LAS u32x4*)(lds + 65536 + 3 * 16384 + tid * 32 + 16) = z;
      const size_t k2_ = (size_t)ATT_TILE(ntile > 2 ? 2 : ntile - 1) * 64;
      ATT_DMA(kg + k2_ * 512, 32768 + wofs); ATT_DMA(kg + k2_ * 512 + 64, 32768 + 8192 + wofs); }
    asm volatile("s_waitcnt vmcnt(0) lgkmcnt(0)\n\ts_barrier" ::: "memory");
    f32x16 SA0, SA1, SB0, SB1;
#pragma unroll
    for (int r = 0; r < 16; ++r) { SA0[r] = 0.f; SA1[r] = 0.f; }
#pragma unroll
    for (int d0 = 0; d0 < 4; ++d0) { const int co = ((2 * d0 + hi) ^ sw) << 4;
        SA0 = MFMA32(*(const LAS bf16x8*)(lds + kfo + co), qf[d0], SA0); SA1 = MFMA32(*(const LAS bf16x8*)(lds + kfo + 4096 + co), qf[d0], SA1); }
    float mrun = -1e30f, lsum = 0.f; f32x16 O[4];
#pragma unroll
    for (int d = 0; d < 4; ++d)
#pragma unroll
        for (int r = 0; r < 16; ++r) O[d][r] = 0.f;
    const float qposf = (float)(q0 + wq * 32 + r32 - 4 * hi);
#define KFRAG(d0, blk) (*(const LAS bf16x8*)(kb_ + (blk) * 4096 + (((2 * (d0) + hi) ^ sw) << 4)))
#define VFRAG(g) (*(const LAS bf16x8*)(vb_ + ((g) & 3) * 4096 + (((2 * ((g) >> 2) + hi) ^ sw) << 4)))
#define ATT_BIAS(SC0, SC1, d0) do { _Pragma("unroll") for (int r = 4 * (d0); r < 4 * (d0) + 4; ++r) { const float cr_ = (float)((r & 3) + 8 * (r >> 2)); \
        if (FAST_) { SC0[r] = __builtin_fmaf(ssg_, cr_, SC0[r]); SC1[r] = __builtin_fmaf(ssg_, cr_ + 32.f, SC1[r]); mx0_ = fmaxf(mx0_, fmaxf(SC0[r], SC1[r])); } \
        else { SC0[r] = SC0[r] - slope2 * __builtin_fabsf(dq_ - cr_); SC1[r] = SC1[r] - slope2 * __builtin_fabsf(dq_ - 32.f - cr_); mx0_ = fmaxf(mx0_, fmaxf(SC0[r], SC1[r])); } } } while (0)
#define ATT_STEP(t, SC0, SC1, SN0, SN1, FAST) do { \
        constexpr bool FAST_ = (FAST) != 0; \
        const int t_ = (t); const int tile_ = ATT_TILE(t_); \
        { const int tn_ = (t_ + 3 < ntile) ? t_ + 3 : ntile - 1, tv_ = (t_ + 1 < ntile) ? t_ + 1 : ntile - 1; const int tk_ = ATT_TILE(tn_), tvt_ = ATT_TILE(tv_); const size_t kv0_ = (size_t)tk_ * 64, vv0_ = (size_t)tvt_ * 64; \
          const int kd_ = ((t_ + 3) & 3) * 16384 + wofs, vd_ = 65536 + ((t_ + 1) & 3) * 16384 + wofs; \
          ATT_DMA(kg + kv0_ * 512, kd_); ATT_DMA(kg + kv0_ * 512 + 64, kd_ + 8192); ATT_DMA(vg + vv0_, vd_); ATT_DMA(vg + vv0_ + (size_t)64 * 4096, vd_ + 8192); } \
        const LAS unsigned char* kb_ = lds + ((t_ + 1) & 3) * 16384 + kfo; const LAS unsigned char* vb_ = lds + ((t_ + 3) & 3) * 16384 + vfo; \
        const float dq_ = qposf - (float)(tile_ * 64); float mx0_ = -1e30f; \
        const float ssg_ = (t_ < nr) ? -slope2 : slope2; const float c1_ = -ssg_ * dq_; \
        bf16x8 k00_ = KFRAG(0, 0), k01_ = KFRAG(0, 1), k10_ = KFRAG(1, 0), k11_ = KFRAG(1, 1); \
        ATT_BIAS(SC0, SC1, 0); SBAR(); \
        { f32x16 z_; _Pragma("unroll") for (int r = 0; r < 16; ++r) z_[r] = 0.f; SN0 = MFMA32(k00_, qf[0], z_); SN1 = MFMA32(k01_, qf[0], z_); } \
        k00_ = KFRAG(2, 0); k01_ = KFRAG(2, 1); ATT_BIAS(SC0, SC1, 1); SBAR(); \
        SN0 = MFMA32(k10_, qf[1], SN0); SN1 = MFMA32(k11_, qf[1], SN1); \
        k10_ = KFRAG(3, 0); k11_ = KFRAG(3, 1); ATT_BIAS(SC0, SC1, 2); SBAR(); \
        SN0 = MFMA32(k00_, qf[2], SN0); SN1 = MFMA32(k01_, qf[2], SN1); \
        bf16x8 v0_ = VFRAG(0), v1_ = VFRAG(1); ATT_BIAS(SC0, SC1, 3); SBAR(); \
        SN0 = MFMA32(k10_, qf[3], SN0); SN1 = MFMA32(k11_, qf[3], SN1); \
        float mt_ = FAST_ ? (mx0_ + c1_) : mx0_; \
        mt_ = fmaxf(mt_, shx(mt_, 32, lane)); \
        const bool resc_ = __any(mt_ > mrun); \
        { const float mn_ = fmaxf(mrun, mt_), al_ = ex2(mrun - mn_); lsum *= al_; mrun = mn_; if (hi == 0) scr[r32] = al_; } \
        const float mo0_ = FAST_ ? (mrun - c1_) : mrun; \
        SBAR(); \
        _Pragma("unroll") for (int g = 0; g < 16; ++g) { const int c_ = g >> 2, d_ = g & 3; \
            bf16x8 v2_ = v0_; if (g < 14) v2_ = VFRAG(g + 2); \
            O[d_] = MFMA32(PK[c_], v0_, O[d_]); \
            if (g < 8) { SC0[2 * g] = ex2(SC0[2 * g] - mo0_); SC0[2 * g + 1] = ex2(SC0[2 * g + 1] - mo0_); lsum += SC0[2 * g] + SC0[2 * g + 1]; } \
            else { SC1[2 * g - 16] = ex2(SC1[2 * g - 16] - mo0_); SC1[2 * g - 15] = ex2(SC1[2 * g - 15] - mo0_); lsum += SC1[2 * g - 16] + SC1[2 * g - 15]; } \
            if (g == 3) PK[0] = pack_p(SC0, 0); if (g == 7) PK[1] = pack_p(SC0, 8); if (g == 11) PK[2] = pack_p(SC1, 0); if (g == 15) PK[3] = pack_p(SC1, 8); \
            v0_ = v1_; v1_ = v2_; SBAR(); } \
        if (resc_) { f32x4 al4_[4]; \
            _Pragma("unroll") for (int jq = 0; jq < 4; ++jq) al4_[jq] = *(const LAS f32x4*)(scr + 8 * jq + 4 * hi); \
            _Pragma("unroll") for (int d = 0; d < 4; ++d) _Pragma("unroll") for (int r = 0; r < 16; ++r) O[d][r] *= al4_[r >> 2][r & 3]; } \
        asm volatile("s_waitcnt vmcnt(4) lgkmcnt(0)\n\ts_barrier" ::: "memory");     \
    } while (0)
    bf16x8 PK[4];
#pragma unroll
    for (int c = 0; c < 4; ++c) PK[c] = (bf16x8){0, 0, 0, 0, 0, 0, 0, 0};
    ATT_STEP(0, SA0, SA1, SB0, SB1, 0);
    ATT_STEP(1, SB0, SB1, SA0, SA1, 0);
    for (int t = 2; t < ntile; t += 2) {
        ATT_STEP(t, SA0, SA1, SB0, SB1, 1);
        if (t + 1 >= ntile) break;
        ATT_STEP(t + 1, SB0, SB1, SA0, SA1, 1);
    }
    { const LAS unsigned char* vb_ = lds + ((ntile - 1) & 3) * 16384 + vfo;
#pragma unroll
      for (int c = 0; c < 4; ++c)
#pragma unroll
          for (int d = 0; d < 4; ++d) { const bf16x8 vf = *(const LAS bf16x8*)(vb_ + d * 4096 + (((2 * c + hi) ^ sw) << 4)); O[d] = MFMA32(PK[c], vf, O[d]); } }
    lsum += shx(lsum, 32, lane);
    if (hi == 0) scr[r32] = rcpf_(lsum);
    __builtin_amdgcn_wave_barrier();
    { f32x4 al[4];
#pragma unroll
      for (int jq = 0; jq < 4; ++jq) al[jq] = *(const LAS f32x4*)(scr + 8 * jq + 4 * hi);
#pragma unroll
      for (int d = 0; d < 4; ++d)
#pragma unroll
          for (int r = 0; r < 16; ++r) O[d][r] *= al[r >> 2][r & 3]; }
    asm volatile("s_waitcnt vmcnt(0)" ::: "memory");
    __syncthreads();
    LAS float* C = (LAS float*)lds;
    if (mp == 1) {
#pragma unroll
        for (int d = 0; d < 4; ++d)
#pragma unroll
            for (int r = 0; r < 16; ++r) C[(wq * 32 + crow(r, hi)) * 132 + d * 32 + r32] = O[d][r]; }
    __syncthreads();
    if (mp == 0) {
#pragma unroll
        for (int d = 0; d < 4; ++d)
#pragma unroll
            for (int r = 0; r < 16; ++r) { const int ix = (wq * 32 + crow(r, hi)) * 132 + d * 32 + r32; C[ix] = O[d][r] - lam * C[ix]; } }
    __syncthreads();
    { float li_ = lam_init; asm volatile("" : "+s"(li_)); const float outscale = 1.0f - li_;
      const int tid2 = tid_opq(wave_s); const int row = tid2 >> 2, part = tid2 & 3; const LAS float* cp = C + row * 132 + part * 32; float v[32]; float sq = 0.f;
#pragma unroll
      for (int jq = 0; jq < 8; ++jq) { const f32x4 x = *(const LAS f32x4*)(cp + 4 * jq); v[4 * jq] = x[0]; v[4 * jq + 1] = x[1]; v[4 * jq + 2] = x[2]; v[4 * jq + 3] = x[3]; sq += (x[0] * x[0] + x[1] * x[1]) + (x[2] * x[2] + x[3] * x[3]); }
      sq += shx(sq, 1, tid2 & 63); sq += shx(sq, 2, tid2 & 63);
      const float rs = __builtin_amdgcn_rsqf(sq * (1.0f / 128.0f) + 1e-5f) * outscale;
      bf16_t* op = BR + (rowbase + q0 + row) * 1024 + 256 + h * 128 + part * 32;
#pragma unroll
      for (int jq = 0; jq < 4; ++jq) { float f[8];
#pragma unroll
          for (int e = 0; e < 8; ++e) f[e] = v[8 * jq + e] * rs * subln[part * 32 + 8 * jq + e];
          *(u32x4*)(op + 8 * jq) = pack8f(f); } }
    __syncthreads();
#undef ATT_TILE
#undef ATT_DMA
#undef ATT_STEP
#undef ATT_BIAS
#undef KFRAG
#undef VFRAG
#undef SBAR
#undef MFMA32
}

typedef const __attribute__((address_space(4))) Params* KP;
__device__ __forceinline__ KP kparams() { auto k = __builtin_amdgcn_kernarg_segment_ptr(); asm volatile("" : "+s"(k)); return (KP)k; }
#define WSP(T, off) ((T*)(kp->ws + (off)))
#define RLX_AGENT __ATOMIC_RELAXED, __HIP_MEMORY_SCOPE_AGENT
#define XB_TMO      128
#define XB_XCNT(j)  (256  + 64 * (j))
#define XB_XSUB(j)  (1280 + 64 * (j))
#define XB_XGEN(j)  (2304 + 64 * (j))
#define XB_TOP      3328
#define XB_TOPGEN   3392
#define XCD_BAR_WORDS 3456
#define XB_SPIN_CAP (1u << 18)

__device__ __forceinline__ unsigned xb_ld(unsigned* p)              { return __hip_atomic_load(p, __ATOMIC_RELAXED, __HIP_MEMORY_SCOPE_AGENT); }
__device__ __forceinline__ unsigned xb_add(unsigned* p, unsigned v) { return __hip_atomic_fetch_add(p, v, __ATOMIC_RELAXED, __HIP_MEMORY_SCOPE_AGENT); }
__device__ __forceinline__ unsigned xb_xcc_id() { return (unsigned)__builtin_amdgcn_s_getreg((3 << 11) | 20) & 0xFu; }
#define XB_SPIN(cond, bar) do { unsigned _sp = 0; while (cond) { __builtin_amdgcn_s_sleep(1); \
    if ((++_sp & 255u) == 0u) { if (xb_ld(&(bar)[XB_TMO])) break; if (_sp > XB_SPIN_CAP) { atomicAdd(&(bar)[XB_TMO], 1u); break; } } } } while (0)

struct XcdBarrier {
    unsigned* bar; unsigned x;
    volatile LAS unsigned* st;
};

__device__ __forceinline__ XcdBarrier xcd_barrier_post(unsigned* bar, volatile LAS unsigned* st, int tid) {
    XcdBarrier b; b.bar = bar; b.x = xb_xcc_id(); b.st = st;
    if (tid == 0) (void)xb_add(&bar[XB_XCNT(b.x)], 1u);
    return b;
}
__device__ __forceinline__ void xcd_barrier_complete(unsigned* bar, unsigned x, unsigned& nloc, unsigned& nx) {
    const unsigned G = gridDim.x * gridDim.y * gridDim.z;
    unsigned sum, cnt, mine, sp = 0u;
    for (;;) {
        sum = 0u; cnt = 0u; mine = 0u;
#pragma unroll
        for (unsigned j = 0; j < 16; ++j) { const unsigned c = xb_ld(&bar[XB_XCNT(j)]); sum += c; cnt += (c > 0u) ? 1u : 0u; mine = (j == x) ? c : mine; }
        if (sum == G) break;
        __builtin_amdgcn_s_sleep(1);
        if ((++sp & 255u) == 0u) { if (xb_ld(&bar[XB_TMO])) break; if (sp > XB_SPIN_CAP) { atomicAdd(&bar[XB_TMO], 1u); break; } }
    }
    nloc = mine > 0u ? mine : 1u; nx = cnt > 0u ? cnt : 1u;
}

__device__ __forceinline__ void xcd_barrier(const XcdBarrier& b, int tid) {
    asm volatile("s_waitcnt vmcnt(0)" ::: "memory");
    __syncthreads();
    if (tid == 0) {
        unsigned* bar = b.bar;
        __builtin_amdgcn_s_waitcnt(0);
        unsigned nloc = b.st[0], nx = b.st[1];
        if (nloc == 0u) { xcd_barrier_complete(bar, b.x, nloc, nx); b.st[0] = nloc; b.st[1] = nx; }
        const unsigned old = xb_add(&bar[XB_XSUB(b.x)], 1u);
        const unsigned gen = old / nloc;
        if (old + 1u == (gen + 1u) * nloc) {
            __builtin_amdgcn_fence(__ATOMIC_RELEASE, "agent");
            asm volatile("s_waitcnt vmcnt(0)" ::: "memory");
            const unsigned og = xb_add(&bar[XB_TOP], 1u);
            const unsigned tg = og / nx;
            if (og + 1u == (tg + 1u) * nx) xb_add(&bar[XB_TOPGEN], 1u);
            else XB_SPIN(xb_ld(&bar[XB_TOPGEN]) == tg, bar);
            __builtin_amdgcn_fence(__ATOMIC_ACQUIRE, "agent");
            xb_add(&bar[XB_XGEN(b.x)], 1u);
            asm volatile("s_waitcnt vmcnt(0)" ::: "memory");
        } else {
            XB_SPIN(xb_ld(&bar[XB_XGEN(b.x)]) == gen, bar);
            __builtin_amdgcn_fence(__ATOMIC_ACQUIRE, "agent");
            asm volatile("s_waitcnt vmcnt(0)" ::: "memory");
        }
    }
    __syncthreads();
}
constexpr int LDS_BARST = LDS_SCR + 1024;
__device__ __forceinline__ void xsync(LAS unsigned char* lds, int wave_s) {
    KP kp = kparams(); XcdBarrier b; b.bar = (unsigned*)kp->ws; b.x = xb_xcc_id(); b.st = (volatile LAS unsigned*)(lds + LDS_BARST);
    xcd_barrier(b, tid_opq(wave_s));
}
#ifdef DUP_SYNC
#define GSYNC() do { xsync(lds, wave_s); xsync(lds, wave_s); } while (0)
#else
#define GSYNC() xsync(lds, wave_s)
#endif
#ifndef REP_SMALL
#define REP_SMALL 1
#endif
#ifndef REP_PROJ
#define REP_PROJ 1
#endif
#ifndef REP_MERGED
#define REP_MERGED 1
#endif
#ifndef REP_OUT
#define REP_OUT 1
#endif
#ifndef REP_XF
#define REP_XF 1
#endif
#ifndef REP_FFN2
#define REP_FFN2 1
#endif
#ifdef DUP_ATTN
#define ATT_REPS 2
#else
#define ATT_REPS 1
#endif
#ifdef DUP_FFN1
#define FFN1_REPS 2
#else
#define FFN1_REPS 1
#endif
__global__ void __launch_bounds__(NTHR, 2) fwd_megakernel(Params p_unused) {
    extern __shared__ __attribute__((aligned(16))) unsigned char lds_raw[];
    LAS unsigned char* lds = (LAS unsigned char*)lds_raw;
    cg::grid_group grid = cg::this_grid();
    const int wave_s = __builtin_amdgcn_readfirstlane((int)(threadIdx.x >> 6));
    { const int t0 = tid_opq(wave_s); if (t0 < 2) ((LAS unsigned*)(lds + LDS_BARST))[t0] = 0u; __syncthreads();
      KP kp = kparams(); (void)xcd_barrier_post((unsigned*)kp->ws, (volatile LAS unsigned*)(lds + LDS_BARST), t0); }
    for (int l = 0; l < 2; ++l) {
        { KP kp = kparams(); const int G = gridDim.x;
#ifndef SKIP_CONV
for (int rep_ = 0; rep_ < (REP_SMALL); ++rep_)
          convert_layer(kp, l, lds, G, wave_s);
#endif
          for (int rep_ = 0; rep_ < (REP_XF); ++rep_)
          if (l == 0) x_to_bf16(kp->in[0], WSP(bf16_t, WS_XB), WSP(float, WS_SS), G, wave_s); }
        if (l == 0) grid.sync(); else GSYNC();
        for (int f = 0; f < 2; ++f) {
            if (f == 1) {
#ifndef SKIP_PROJ
for (int rep_ = 0; rep_ < (REP_PROJ); ++rep_)
                { KP kp = kparams(); const int G = gridDim.x, bid = blockIdx.x; bf16_t* Wb = WSP(bf16_t, WS_W);
                  Gemm g{WSP(bf16_t, WS_XB), Wb + WO_WP, MTOK, 4864, 1024, 1024, 1024}; StaticOrder S; S.init(MTOK, 4864, G, bid);
                  EpiProj E{WSP(bf16_t, WS_P), WSP(bf16_t, WS_Q), WSP(bf16_t, WS_K), WSP(bf16_t, WS_LX), WSP(bf16_t, WS_LG), WSP(bf16_t, WS_GATES), WSP(float, WS_SS), kp->in[20] + l * 3072};
                  gemm_phase<EpiProj, StaticOrder, true, true>(lds, g, S, E, wave_s); }
#endif
#ifndef SKIP_VT
for (int rep_ = 0; rep_ < (REP_PROJ); ++rep_)
                { KP kp = kparams(); const int G = gridDim.x, bid = blockIdx.x; bf16_t* Wb = WSP(bf16_t, WS_W);
                  Gemm g{Wb + WO_WV, WSP(bf16_t, WS_XB), 512, MTOK, 1024, 1024, 1024}; StaticOrder S; S.init(512, MTOK, G, bid);
                  EpiVt E{WSP(bf16_t, WS_VT), WSP(float, WS_SS)};
                  gemm_phase<EpiVt, StaticOrder, true, true>(lds, g, S, E, wave_s); }
#endif
                GSYNC();
#ifndef SKIP_PREP
for (int rep_ = 0; rep_ < (REP_SMALL); ++rep_)
                { KP kp = kparams(); prep_phase(WSP(bf16_t, WS_P), WSP(bf16_t, WS_LX), WSP(bf16_t, WS_BR), kp->in[10] + l * 1024, kp->in[11] + l * 256, WSP(bf16_t, WS_K), WSP(unsigned, WS_KMAX) + l * 128, gridDim.x, wave_s); }
#endif
                GSYNC();
#ifndef SKIP_GATES
for (int rep_ = 0; rep_ < (REP_SMALL); ++rep_)
                { KP kp = kparams(); const int G = gridDim.x, bid = blockIdx.x; bf16_t* Wb = WSP(bf16_t, WS_W); bf16_t* BR = WSP(bf16_t, WS_BR);
                  int Kg = 256; asm volatile("" : "+s"(Kg));
                  Gemm g{BR + 768, Wb + WO_WG, MTOK, 1024, Kg, 1024, 256}; StaticOrder S; S.init(MTOK, 1024, G, bid);
                  EpiGates E{((unsigned*)kp->out)  , BR + 768, kp->in[13] + l * 512, kp->in[15] + l * 512, WSP(float, WS_TAB)};
                  gemm_phase<EpiGates, StaticOrder, true, true>(lds, g, S, E, wave_s); }
#endif
                GSYNC();
#ifndef SKIP_SCAN
for (int rep_ = 0; rep_ < (REP_SMALL); ++rep_)
                { KP kp = kparams(); const int G = gridDim.x, bid = blockIdx.x;
                  for (int u = bid; u < 512; u += G) { const int v = u & 255, k = u >> 8; scan_unit(lds, ((unsigned*)kp->out), WSP(bf16_t, WS_LG), WSP(bf16_t, WS_BR), (v & 7) + 8 * k, v >> 3, wave_s); } }
#endif
#ifndef SKIP_ATTN
                { KP kp = kparams(); const int G = gridDim.x, bid = blockIdx.x;
                  int ll = l; asm volatile("" : "+s"(ll)); const int lane = tid_opq(wave_s) & 63;
                  const float* lp = kp->in[8] + ll * 256;
                  const float s1 = wave_sum(lp[lane] * lp[64 + lane], lane), s2 = wave_sum(lp[128 + lane] * lp[192 + lane], lane);
                  int lib_ = (ll == 0) ? 0x3e4ccccd   : 0x3eb60549  ; asm volatile("" : "+s"(lib_)); const float lam_init = __int_as_float(lib_);     const float lam = __uint_as_float(__builtin_amdgcn_readfirstlane(__float_as_uint(ex2(1.44269504f * s1) - ex2(1.44269504f * s2) + lam_init)));
                  for (int rep = 0; rep < ATT_REPS; ++rep)
                  for (int u = bid; u < 2048; u += G) { const int x = u & 7, k = u >> 8, slot = (((u >> 3) & 31) + 16 * (k >> 2)) & 31, pair = 8 * k + ((x + k) & 7), b = pair >> 2, h = pair & 3;
                      const float slope2 = __uint_as_float(__builtin_amdgcn_readfirstlane(__float_as_uint(ex2(-2.0f * (float)(h + 1)) * 1.44269504f)));
                      attn_unit(lds, WSP(bf16_t, WS_Q), WSP(bf16_t, WS_K), WSP(bf16_t, WS_VT), WSP(bf16_t, WS_BR), b, h, slot, lam, slope2, kp->in[9] + ll * 128, lam_init, WSP(unsigned, WS_KMAX) + ll * 128, wave_s); } }
#endif
                GSYNC();
#ifndef SKIP_MERGED
for (int rep_ = 0; rep_ < (REP_MERGED); ++rep_)
                { KP kp = kparams(); const int G = gridDim.x, bid = blockIdx.x; bf16_t* Wb = WSP(bf16_t, WS_W);
                  Gemm g{WSP(bf16_t, WS_BR), Wb + WO_WBR, MTOK, 1024, 1024, 1024, 1024}; StaticOrder S; S.init(MTOK, 1024, G, bid);
                  EpiMerged E{WSP(bf16_t, WS_MERGED), WSP(bf16_t, WS_GATES)};
                  gemm_phase<EpiMerged, StaticOrder, true, true>(lds, g, S, E, wave_s); }
#endif
                GSYNC();
#ifndef SKIP_OUT
                for (int rep_ = 0; rep_ < (REP_OUT); ++rep_)
                { KP kp = kparams(); const int G = gridDim.x, bid = blockIdx.x; bf16_t* Wb = WSP(bf16_t, WS_W);
                  Gemm g{WSP(bf16_t, WS_MERGED), Wb + WO_WO, MTOK, 1024, 1024, 1024, 1024}; StaticOrder S; S.init(MTOK, 1024, G, bid);
                  EpiResid E{WSP(bf16_t, WS_XB), WSP(float, WS_SS), (rep_ + 1 < (REP_OUT)) ? 0.0f : 1.0f};
                  gemm_phase<EpiResid, StaticOrder, true, true>(lds, g, S, E, wave_s); }
#endif
                GSYNC();
            }
#ifndef SKIP_FFN1
            for (int rep = 0; rep < FFN1_REPS; ++rep)
            { KP kp = kparams(); const int G = gridDim.x, bid = blockIdx.x; bf16_t* Wb = WSP(bf16_t, WS_W);
              Gemm g{WSP(bf16_t, WS_XB), Wb + (f ? WO_W1B : WO_W1A), MTOK, 5632, 1024, 1024, 1024}; StaticOrder S; S.init(MTOK, 5632, G, bid);
              EpiSwiglu E{WSP(bf16_t, WS_ACT), WSP(float, WS_SS)};
              gemm_phase<EpiSwiglu, StaticOrder, true, true>(lds, g, S, E, wave_s); }
#endif
            GSYNC();
#ifndef SKIP_FFN2
            for (int rep_ = 0; rep_ < (REP_FFN2); ++rep_)
            { KP kp = kparams(); const int G = gridDim.x, bid = blockIdx.x; bf16_t* Wb = WSP(bf16_t, WS_W);
              Gemm g{WSP(bf16_t, WS_ACT), Wb + (f ? WO_W2B : WO_W2A), MTOK, 1024, 2816, 2816, 2816}; StaticOrder S; S.init(MTOK, 1024, G, bid);
              EpiResid E{WSP(bf16_t, WS_XB), WSP(float, WS_SS), 0.5f};
              gemm_phase<EpiResid, StaticOrder, true, true>(lds, g, S, E, wave_s); }
#endif
            GSYNC();
        }
    }
    for (int rep_ = 0; rep_ < (REP_XF); ++rep_)
    { KP kp = kparams(); final_norm(WSP(bf16_t, WS_XB), kp->out, WSP(float, WS_SS), kp->in[25], gridDim.x, wave_s); }
}

extern "C" void kernel_launch(void* const* d_in, const int* in_sizes, int n_in, void* d_out, int out_size, void* d_ws, size_t ws_size, hipStream_t stream) {
    static int grid = 0;
    if (grid == 0) {
        if (n_in != 26 || out_size != MTOK * DM || ws_size < WS_END) { fprintf(stderr, "kernel_launch: unexpected shapes (n_in %d, out %d, ws %zu)\n", n_in, out_size, ws_size); grid = -1; return; }
        int dev = 0, cus = 0, per_cu = 0;
        hipGetDevice(&dev); hipDeviceGetAttribute(&cus, hipDeviceAttributeMultiprocessorCount, dev);
        hipFuncSetAttribute((const void*)fwd_megakernel, hipFuncAttributeMaxDynamicSharedMemorySize, LDS_BYTES);
        hipOccupancyMaxActiveBlocksPerMultiprocessor(&per_cu, (const void*)fwd_megakernel, NTHR, LDS_BYTES);
        if (per_cu < 1) per_cu = 1;
        grid = cus * per_cu;
    }
    if (grid < 0) return;
    if (hipMemsetAsync(d_ws, 0, 65536, stream) != hipSuccess) { fprintf(stderr, "kernel_launch: memset of the barrier words failed\n"); return; }
    Params p{};
    for (int i = 0; i < 26; ++i) p.in[i] = (const float*)d_in[i];
    p.out = (float*)d_out; p.ws = (unsigned char*)d_ws;
    void* args[] = {&p};
    hipError_t e = hipLaunchCooperativeKernel((const void*)fwd_megakernel, dim3(grid), dim3(NTHR), args, LDS_BYTES, stream);
    if (e != hipSuccess) fprintf(stderr, "cooperative launch failed: %s (grid %d)\n", hipGetErrorString(e), grid);
}
```

```cpp
#include <hip/hip_runtime.h>
#include <hip/hip_cooperative_groups.h>
#include <cstdio>
#include <cstdint>
#include <cmath>
namespace cg = cooperative_groups;
namespace pg8 {
#define PG8_LAS __attribute__((address_space(3)))
typedef unsigned short bf16_t;
typedef short bf16x8 __attribute__((ext_vector_type(8)));
typedef float f32x4 __attribute__((ext_vector_type(4)));
typedef unsigned u32x4 __attribute__((ext_vector_type(4)));
constexpr int BM = 256, BK = 64, HALF = 128, HTB = HALF * BK * 2  , STAGE_BYTES = 8 * HTB, NXCD = 8, WGM = 8;

__host__ __device__ __forceinline__ int lds_byte(int r, int c) { const int st = (r >> 4) * 2 + (c >> 5), rr = r & 15, cc = c & 31, ob = rr * 64 + cc * 2; return st * 1024 + (ob ^ (((ob >> 9) & 1) << 5)); }
__host__ __device__ __forceinline__ void stage_rc(int b, int& R, int& C) { const int st = b / 1024, sb = b % 1024, swz = sb ^ (((sb >> 9) & 1) << 5); R = (st >> 1) * 16 + swz / 64; C = (st & 1) * 32 + (swz % 64) / 2; }
__host__ __device__ __forceinline__ int perm32(int rho) { const int n = rho >> 4, i = rho & 15; return 8 * (i >> 2) + 4 * n + (i & 3); }

struct Unit { int pm, pn; };
struct Gemm { const bf16_t* A; const bf16_t* Bt; int M, N, K, lda, ldb; };

struct StaticOrder {
    int nM, nN, nwg, G, c;
    __host__ __device__ void init(int M, int N, int G_, int c_) { nM = M / BM; nN = N / BM; nwg = nM * nN; G = G_; c = c_; }
    __host__ __device__ bool next(int i, Unit& u) const {
        const long L = (long)i * G + c; if (L >= nwg) return false;
        int wgid = (int)L; { const int q = nwg / NXCD, r = nwg % NXCD, xcd = wgid % NXCD, off = wgid / NXCD; wgid = (xcd < r ? xcd * (q + 1) : r * (q + 1) + (xcd - r) * q) + off; }
        const int nig = WGM * nN, gid = wgid / nig, fm = gid * WGM, gsz = (nM - fm) < WGM ? (nM - fm) : WGM;
        u.pm = fm + ((wgid % nig) % gsz); u.pn = (wgid % nig) / gsz; return true;
    }
    __device__ __forceinline__ void a_ready(const Unit&) const {}
    __device__ __forceinline__ void done(const Unit&) const {}
};

__device__ __forceinline__ unsigned cvt_pk_bf16(float lo, float hi) { unsigned r; asm volatile("s_nop 0\n\tv_cvt_pk_bf16_f32 %0, %1, %2" : "=v"(r) : "v"(lo), "v"(hi)); return r; }
typedef float f32x2 __attribute__((ext_vector_type(2)));
__device__ __forceinline__ float shx(float v, int m, int lane) { return __int_as_float(__builtin_amdgcn_ds_bpermute((lane ^ m) << 2, __float_as_int(v))); }
__device__ __forceinline__ int tid_opq(int wave_s) { unsigned ones = ~0u; int w = wave_s; asm volatile("" : "+s"(ones), "+s"(w)); return w * 64 + (int)__builtin_amdgcn_mbcnt_hi(ones, __builtin_amdgcn_mbcnt_lo(ones, 0u)); }
typedef unsigned u32x2 __attribute__((ext_vector_type(2)));
constexpr int MTOK = 65536, DM = 1024, DFF = 2816;
__device__ __forceinline__ float bf_lo(unsigned w) { return __uint_as_float(w << 16); }
__device__ __forceinline__ float bf_hi(unsigned w) { return __uint_as_float(w & 0xffff0000u); }
__device__ __forceinline__ float ex2(float x) { return __builtin_amdgcn_exp2f(x); }
__device__ __forceinline__ float rcpf_(float x) { return __builtin_amdgcn_rcpf(x); }
__device__ __forceinline__ float sigm(float x) { return rcpf_(1.f + ex2(-1.44269504f * x)); }
__device__ __forceinline__ float gelu_tanh(float x) { return x * sigm(1.5957691216f * (x + 0.044715f * x * x * x)); }
__device__ __forceinline__ float row_rstd(const float* ss, int row) {
    const f32x4* p = (const f32x4*)(ss + (size_t)row * 16);
    const f32x4 a = p[0], b = p[1], c = p[2], d = p[3];
    const float s = (((a[0] + a[1]) + (a[2] + a[3])) + ((b[0] + b[1]) + (b[2] + b[3]))) + (((c[0] + c[1]) + (c[2] + c[3])) + ((d[0] + d[1]) + (d[2] + d[3])));
    return __builtin_amdgcn_rsqf(s * (1.0f / 1024.0f) + 1e-6f);
}
__device__ __forceinline__ void rstd8(const float* ss, int row0, int fr, int fq, float (&rs)[2][4]) {
    f32x4 pr[2][4];
#pragma unroll
    for (int ai = 0; ai < 2; ++ai)
#pragma unroll
        for (int m = 0; m < 4; ++m) pr[ai][m] = *(const f32x4*)(ss + (size_t)(row0 + ai * HALF + m * 16) * 16 + 4 * fq);
    const int ln = fr + 16 * fq;
#pragma unroll
    for (int ai = 0; ai < 2; ++ai)
#pragma unroll
        for (int m = 0; m < 4; ++m) { float s = (pr[ai][m][0] + pr[ai][m][1]) + (pr[ai][m][2] + pr[ai][m][3]); s += shx(s, 16, ln); s += shx(s, 32, ln);
            rs[ai][m] = __builtin_amdgcn_rsqf(s * (1.0f / 1024.0f) + 1e-6f); }
}
__device__ __forceinline__ u32x4 pack8(const f32x4 v0, const f32x4 v1) { u32x4 w; w.x = cvt_pk_bf16(v0[0], v0[1]); w.y = cvt_pk_bf16(v0[2], v0[3]); w.z = cvt_pk_bf16(v1[0], v1[1]); w.w = cvt_pk_bf16(v1[2], v1[3]); return w; }

struct EpiSwiglu {
    static constexpr bool PERM = true, AFTER_DRAIN = false, HOOK = false;
    bf16_t* O; const float* ss;
    __device__ __forceinline__ void operator()(const f32x4 (&acc)[2][2][4][2], const Unit& u, int wr, int wc, int fr, int fq) const {
        const int row0 = u.pm * BM + wr * 64 + fr, col0 = u.pn * 128 + wc * 32 + 8 * fq;
        float rsa[2][4]; rstd8(ss, row0, fr, fq, rsa);
#pragma unroll
        for (int ai = 0; ai < 2; ++ai)
#pragma unroll
            for (int m = 0; m < 4; ++m) { const int row = row0 + ai * HALF + m * 16; const float rs = rsa[ai][m], rs2 = rs * rs, k1 = -1.44269504f * rs;
                f32x4 o[2];
#pragma unroll
                for (int n = 0; n < 2; ++n)
#pragma unroll
                    for (int e = 0; e < 4; ++e) { const float ag = acc[ai][0][m][n][e], au = acc[ai][1][m][n][e]; o[n][e] = (ag * au) * (rs2 * rcpf_(1.f + ex2(ag * k1))); }
                *(u32x4*)(O + (size_t)row * DFF + col0) = pack8(o[0], o[1]); }
    }
};
struct EpiResid {
    static constexpr bool PERM = true, AFTER_DRAIN = false, HOOK = false;
    bf16_t* xb; float* ss; float alpha;
    __device__ __forceinline__ void operator()(const f32x4 (&acc)[2][2][4][2], const Unit& u, int wr, int wc, int fr, int fq) const {
        const int row0 = u.pm * BM + wr * 64 + fr, col0 = u.pn * BM + wc * 32 + 8 * fq;
#pragma unroll
        for (int ai = 0; ai < 2; ++ai) { u32x4 bw[4][2];
#pragma unroll
            for (int m = 0; m < 4; ++m)
#pragma unroll
                for (int bj = 0; bj < 2; ++bj) bw[m][bj] = *(const u32x4*)(xb + (size_t)(row0 + ai * HALF + m * 16) * DM + col0 + bj * HALF);
#pragma unroll
            for (int m = 0; m < 4; ++m) { const int row = row0 + ai * HALF + m * 16; float sq = 0.f;
#pragma unroll
                for (int bj = 0; bj < 2; ++bj) { const size_t off = (size_t)row * DM + col0 + bj * HALF; const u32x4 w = bw[m][bj];
                    const f32x4 b0 = {bf_lo(w.x), bf_hi(w.x), bf_lo(w.y), bf_hi(w.y)}, b1 = {bf_lo(w.z), bf_hi(w.z), bf_lo(w.w), bf_hi(w.w)};
                    const f32x4 o0 = b0 + acc[ai][bj][m][0] * alpha, o1 = b1 + acc[ai][bj][m][1] * alpha;
                    *(u32x4*)(xb + off) = pack8(o0, o1);
                    sq += ((o0[0] * o0[0] + o0[1] * o0[1]) + (o0[2] * o0[2] + o0[3] * o0[3])) + ((o1[0] * o1[0] + o1[1] * o1[1]) + (o1[2] * o1[2] + o1[3] * o1[3])); }
                { const int ln = fr + 16 * fq; sq += shx(sq, 16, ln); sq += shx(sq, 32, ln); }
                if (fq == 0) ss[(size_t)row * 16 + u.pn * 4 + wc] = sq; }
            asm volatile("" ::: "memory"); }
    }
};
__device__ __forceinline__ unsigned gate_frag_off(int gt, int pm, int wave, int ai, int m, int bj, int lane) {
    return ((unsigned)(gt * 256 + pm) << 17) + (unsigned)((((wave * 2 + ai) * 4 + m) * 2 + bj) * 64 + lane) * 16u;
}
struct EpiProj {
    static constexpr bool PERM = true, AFTER_DRAIN = false, HOOK = false;
    bf16_t *P, *Q, *K, *LX, *LG, *GATES; const float* ss; const float* mbias;
    __device__ __forceinline__ void operator()(const f32x4 (&acc)[2][2][4][2], const Unit& u, int wr, int wc, int fr, int fq) const {
        const int pn = u.pn; bf16_t* dst; int ld, c0, kind = 0; float sc = 1.f;
        if (pn == 0) { dst = P; ld = 256; c0 = 0; }
        else if (pn < 3) { dst = Q; ld = 512; c0 = (pn - 1) * 256; sc = 0.125f * 1.44269504f; }
        else if (pn < 5) { dst = K; ld = 512; c0 = (pn - 3) * 256; }
        else if (pn == 5) { dst = LX; ld = 256; c0 = 0; }
        else if (pn == 6) { dst = LG; ld = 256; c0 = 0; kind = 1; }
        else { dst = GATES; ld = 3072; c0 = (pn - 7) * 256; kind = 2; }
        const int row0 = u.pm * BM + wr * 64 + fr, col0 = c0 + wc * 32 + 8 * fq;
        f32x4 bv[2][2];
#pragma unroll
        for (int bj = 0; bj < 2; ++bj)
#pragma unroll
            for (int n = 0; n < 2; ++n) bv[bj][n] = (kind == 2) ? *(const f32x4*)(mbias + col0 + bj * HALF + 4 * n) * -1.44269504f : (f32x4){0.f, 0.f, 0.f, 0.f};
        float rsa[2][4]; rstd8(ss, row0, fr, fq, rsa);
#pragma unroll
        for (int ai = 0; ai < 2; ++ai)
#pragma unroll
            for (int m = 0; m < 4; ++m) { const int row = row0 + ai * HALF + m * 16; const float rs = rsa[ai][m] * sc;
#pragma unroll
                for (int bj = 0; bj < 2; ++bj) { f32x4 v[2];
#pragma unroll
                    for (int n = 0; n < 2; ++n) {
                        if (kind == 2) {
                            const float k1 = -1.44269504f * rs;
#pragma unroll
                            for (int e = 0; e < 4; ++e) v[n][e] = rcpf_(1.f + ex2(__builtin_fmaf(acc[ai][bj][m][n][e], k1, bv[bj][n][e]))); }
                        else { v[n] = acc[ai][bj][m][n] * rs;
                            if (kind == 1) {
#pragma unroll
                                for (int e = 0; e < 4; ++e) v[n][e] = gelu_tanh(v[n][e]); } } }
                    if (kind == 2) *(u32x4*)((char*)GATES + gate_frag_off(pn - 7, u.pm, wr * 4 + wc, ai, m, bj, fr + 16 * fq)) = pack8(v[0], v[1]);
                    else *(u32x4*)(dst + (size_t)row * ld + col0 + bj * HALF) = pack8(v[0], v[1]); } }
    }
};
struct EpiVt {
    static constexpr bool PERM = false, AFTER_DRAIN = false, HOOK = false;
    bf16_t* Vt; const float* ss;
    __device__ __forceinline__ void operator()(const f32x4 (&acc)[2][2][4][2], const Unit& u, int wr, int wc, int fr, int fq) const {
        const int ch0 = u.pm * BM + wr * 64 + fr;
        const int tokj = u.pn * BM + (fr >> 3) * HALF + wc * 32 + ((fr >> 2) & 1) * 16 + 4 * fq + (fr & 3);
        const float rsj = row_rstd(ss, tokj);
#pragma unroll
        for (int bj = 0; bj < 2; ++bj)
#pragma unroll
            for (int n = 0; n < 2; ++n) { const int tok = u.pn * BM + bj * HALF + wc * 32 + n * 16 + 4 * fq;
                f32x4 rs;
#pragma unroll
                for (int e2 = 0; e2 < 4; ++e2) rs[e2] = __int_as_float(__builtin_amdgcn_ds_bpermute(((bj * 8 + n * 4 + e2) + 16 * fq) << 2, __float_as_int(rsj)));
                const int b = tok >> 12, s = tok & 4095, sp = (s & ~15) + 8 * (fq & 1) + 4 * (fq >> 1);
#pragma unroll
                for (int ai = 0; ai < 2; ++ai)
#pragma unroll
                    for (int m = 0; m < 4; ++m) { const int ch = ch0 + ai * HALF + m * 16; const f32x4 v = acc[ai][bj][m][n] * rs;
                        u32x2 w; w.x = cvt_pk_bf16(v[0], v[1]); w.y = cvt_pk_bf16(v[2], v[3]);
                        *(u32x2*)(Vt + ((size_t)(b * 512 + ch)) * 4096 + sp) = w; } }
    }
};
typedef _Float16 h2_t __attribute__((ext_vector_type(2)));
struct EpiGates {
    static constexpr bool PERM = true, AFTER_DRAIN = false, HOOK = false;
    unsigned* AU; const bf16_t* XF  ; const float* b_a; const float* b_x; const float* c8;
    __device__ __forceinline__ void operator()(const f32x4 (&acc)[2][2][4][2], const Unit& u, int wr, int wc, int fr, int fq) const {
        const int dir = u.pn >> 1, half = u.pn & 1; const int row0 = u.pm * BM + wr * 64 + fr, ch0 = half * 128 + wc * 32 + 8 * fq;
#pragma unroll
        for (int n = 0; n < 2; ++n) { const int ch = ch0 + 4 * n;
            const f32x4 ba = *(const f32x4*)(b_a + dir * 256 + ch), bx = *(const f32x4*)(b_x + dir * 256 + ch), cc = *(const f32x4*)(c8 + dir * 256 + ch);
            u32x2 xwa[2][4];
#pragma unroll
            for (int ai = 0; ai < 2; ++ai)
#pragma unroll
                for (int m = 0; m < 4; ++m) xwa[ai][m] = *(const u32x2*)((const char*)XF + ((unsigned)(row0 + ai * HALF + m * 16) * 1024u + (unsigned)ch) * 2u);
#pragma unroll
            for (int ai = 0; ai < 2; ++ai)
#pragma unroll
                for (int m = 0; m < 4; ++m) { const int row = row0 + ai * HALF + m * 16;
                    const u32x2 xw = xwa[ai][m];
                    const float xf[4] = {bf_lo(xw.x), bf_hi(xw.x), bf_lo(xw.y), bf_hi(xw.y)};
                    u32x4 o;
#pragma unroll
                    for (int e = 0; e < 4; ++e) { const float r = sigm(acc[ai][0][m][n][e] + ba[e]), ig = sigm(acc[ai][1][m][n][e] + bx[e]);
                        const float l2a = cc[e] * r; const float a2 = ex2(2.f * l2a); const float uu = __builtin_sqrtf(fmaxf(1.f - a2, 0.f)) * ig * xf[e];
                        h2_t hv; hv[0] = (_Float16)l2a; hv[1] = (_Float16)uu; o[e] = __builtin_bit_cast(unsigned, hv); }
                    *(u32x4*)((char*)AU + (((unsigned)dir * (unsigned)MTOK + (unsigned)row) * 256u + (unsigned)ch) * 4u) = o; }
            asm volatile("" ::: "memory"); }
    }
};
struct EpiMerged {
    static constexpr bool PERM = true, AFTER_DRAIN = false, HOOK = true;
    bf16_t* O; const bf16_t* G  ;
    __device__ __forceinline__ void hook(f32x4 (&acc)[2][2][4][2], const Unit& u, int t, int wr, int wc, int fr, int fq) const {
        const int which = (t == 4) ? 0 : 1;
#pragma unroll
        for (int ai = 0; ai < 2; ++ai) { u32x4 ga[4][2], gb[4][2];
#pragma unroll
            for (int m = 0; m < 4; ++m)
#pragma unroll
                for (int bj = 0; bj < 2; ++bj) { const unsigned go = gate_frag_off(which * 4 + u.pn, u.pm, wr * 4 + wc, ai, m, bj, fr + 16 * fq);
                    ga[m][bj] = *(const u32x4*)((const char*)G + go); gb[m][bj] = *(const u32x4*)((const char*)G + go + ((4u * 256u) << 17)); }
#pragma unroll
            for (int m = 0; m < 4; ++m)
#pragma unroll
                for (int bj = 0; bj < 2; ++bj) { const u32x4 a = ga[m][bj], b = gb[m][bj];
                    acc[ai][bj][m][0][0] *= bf_lo(a.x) * rcpf_(bf_lo(b.x)); acc[ai][bj][m][0][1] *= bf_hi(a.x) * rcpf_(bf_hi(b.x));
                    acc[ai][bj][m][0][2] *= bf_lo(a.y) * rcpf_(bf_lo(b.y)); acc[ai][bj][m][0][3] *= bf_hi(a.y) * rcpf_(bf_hi(b.y));
                    acc[ai][bj][m][1][0] *= bf_lo(a.z) * rcpf_(bf_lo(b.z)); acc[ai][bj][m][1][1] *= bf_hi(a.z) * rcpf_(bf_hi(b.z));
                    acc[ai][bj][m][1][2] *= bf_lo(a.w) * rcpf_(bf_lo(b.w)); acc[ai][bj][m][1][3] *= bf_hi(a.w) * rcpf_(bf_hi(b.w)); }
            asm volatile("" ::: "memory"); }
    }
    __device__ __forceinline__ void operator()(const f32x4 (&acc)[2][2][4][2], const Unit& u, int wr, int wc, int fr, int fq) const {
        const int row0 = u.pm * BM + wr * 64 + fr, col0 = u.pn * BM + wc * 32 + 8 * fq;
#pragma unroll
        for (int ai = 0; ai < 2; ++ai) { u32x4 g2[4][2];
#pragma unroll
            for (int m = 0; m < 4; ++m)
#pragma unroll
                for (int bj = 0; bj < 2; ++bj) g2[m][bj] = *(const u32x4*)((const char*)G + gate_frag_off(8 + u.pn, u.pm, wr * 4 + wc, ai, m, bj, fr + 16 * fq));
#pragma unroll
            for (int m = 0; m < 4; ++m) { const int row = row0 + ai * HALF + m * 16;
#pragma unroll
                for (int bj = 0; bj < 2; ++bj) { const u32x4 g = g2[m][bj];
                    f32x4 v0 = acc[ai][bj][m][0], v1 = acc[ai][bj][m][1];
                    v0[0] *= bf_lo(g.x); v0[1] *= bf_hi(g.x); v0[2] *= bf_lo(g.y); v0[3] *= bf_hi(g.y);
                    v1[0] *= bf_lo(g.z); v1[1] *= bf_hi(g.z); v1[2] *= bf_lo(g.w); v1[3] *= bf_hi(g.w);
                    *(u32x4*)(O + (size_t)row * DM + col0 + bj * HALF) = pack8(v0, v1); } }
            asm volatile("" ::: "memory"); }
    }
};
template <class Epi, class Sched, bool ALIGN_EPI = false, bool SP2 = false>
__device__ __forceinline__ void gemm_phase(PG8_LAS unsigned char* lds, const Gemm g, const Sched& S, const Epi& E, int wave_s) {
    const int tid_ = tid_opq(wave_s);
    const int tid = tid_, wid = __builtin_amdgcn_readfirstlane(tid >> 6), lane = tid & 63, wr = wid >> 2, wc = wid & 3, fr = lane & 15, fq = lane >> 4;
    const int K = g.K, nt = K / BK;
    unsigned voffA[2], voffB[2];
#pragma unroll
    for (int i = 0; i < 2; ++i) { int R, C; stage_rc(tid * 16 + i * 8192, R, C); const int Rb = Epi::PERM ? ((R & ~31) + perm32(R & 31)) : R;
        voffA[i] = (unsigned)(R * g.lda + C) * 2u; voffB[i] = (unsigned)(Rb * g.ldb + C) * 2u; }
    const size_t kstep = (size_t)(BK * 2);
    const size_t hstepA = (size_t)HALF * g.lda * 2, hstepB = (size_t)HALF * g.ldb * 2;
    const size_t tstepA = 2 * hstepA, tstepB = 2 * hstepB;
    const unsigned ldsw = (unsigned)wid * 1024u;
    const int aoff = lds_byte(wr * 64 + fr, fq * 8), boff = lds_byte(wc * 32 + fr, fq * 8);
#define PG8_SA(b, h) (((b) * 2 + (h)) * HTB)
#define PG8_SB(b, h) ((4 + (b) * 2 + (h)) * HTB)
#define PG8_STAGE(bufoff, gbase, voff) do { _Pragma("unroll") for (int _i = 0; _i < 2; ++_i) \
        __builtin_amdgcn_global_load_lds((const unsigned*)((const char*)(gbase) + (voff)[_i]), (PG8_LAS unsigned*)(lds + (bufoff) + ldsw + _i * 8192), 16, 0, 0); } while (0)
#define PG8_LDA(dst, b, h) do { _Pragma("unroll") for (int m = 0; m < 4; ++m) _Pragma("unroll") for (int k = 0; k < 2; ++k) dst[m][k] = *(const PG8_LAS bf16x8*)(lds + PG8_SA(b, h) + aoff + m * 2048 + k * 1024); } while (0)
#define PG8_LDB(dst, b, h) do { _Pragma("unroll") for (int n = 0; n < 2; ++n) _Pragma("unroll") for (int k = 0; k < 2; ++k) dst[n][k] = *(const PG8_LAS bf16x8*)(lds + PG8_SB(b, h) + boff + n * 2048 + k * 1024); } while (0)
#define PG8_MMA(ai, bj, At, Bt) do { __builtin_amdgcn_s_setprio(1); _Pragma("unroll") for (int m = 0; m < 4; ++m) _Pragma("unroll") for (int n = 0; n < 2; ++n) _Pragma("unroll") for (int k = 0; k < 2; ++k) \
        acc[ai][bj][m][n] = __builtin_amdgcn_mfma_f32_16x16x32_bf16(Bt[n][k], At[m][k], acc[ai][bj][m][n], 0, 0, 0); __builtin_amdgcn_s_setprio(0); } while (0)
#define PG8_WAIT_V(n) asm volatile("s_waitcnt vmcnt(" #n ")" ::: "memory")
#define PG8_WAIT_L(n) asm volatile("s_waitcnt lgkmcnt(" #n ")" ::: "memory")
#define PG8_BAR __builtin_amdgcn_s_barrier()
#define PG8_SCHED __builtin_amdgcn_sched_barrier(0)
    Unit cur, nxt; int ui = 0;
    if (!S.next(0, cur)) return;
    f32x4 acc[2][2][4][2];
#pragma unroll
    for (int a = 0; a < 2; ++a)
#pragma unroll
        for (int b = 0; b < 2; ++b)
#pragma unroll
            for (int m = 0; m < 4; ++m)
#pragma unroll
                for (int n = 0; n < 2; ++n) acc[a][b][m][n] = (f32x4){0.f, 0.f, 0.f, 0.f};
    bf16x8 At[4][2], B0[2][2], B1[2][2];
    const char* cA = (const char*)g.A + (size_t)cur.pm * tstepA; const char* cB = (const char*)g.Bt + (size_t)cur.pn * tstepB;
    S.a_ready(cur);
    if constexpr (SP2) {
        PG8_STAGE(PG8_SB(0, 0), cB, voffB); PG8_STAGE(PG8_SB(0, 1), cB + hstepB, voffB); PG8_STAGE(PG8_SA(0, 0), cA, voffA); PG8_STAGE(PG8_SA(0, 1), cA + hstepA, voffA);
        if (wr == 1) PG8_BAR;
        PG8_WAIT_V(2); PG8_BAR;
        PG8_STAGE(PG8_SB(1, 0), cB + kstep, voffB); PG8_STAGE(PG8_SA(1, 0), cA + kstep, voffA); PG8_STAGE(PG8_SB(1, 1), cB + hstepB + kstep, voffB);
        PG8_WAIT_V(6); PG8_BAR;
    } else {
        PG8_STAGE(PG8_SB(0, 0), cB, voffB); PG8_STAGE(PG8_SA(0, 0), cA, voffA); PG8_STAGE(PG8_SB(0, 1), cB + hstepB, voffB); PG8_STAGE(PG8_SA(0, 1), cA + hstepA, voffA);
        if (wr == 1) PG8_BAR;
        PG8_WAIT_V(4); PG8_BAR;
        PG8_STAGE(PG8_SB(1, 0), cB + kstep, voffB); PG8_STAGE(PG8_SA(1, 0), cA + kstep, voffA); PG8_STAGE(PG8_SB(1, 1), cB + hstepB + kstep, voffB);
        PG8_WAIT_V(6); PG8_BAR;
    }
    for (;;) {
        const bool has_next = S.next(ui + 1, nxt);
        const char* nA = has_next ? (const char*)g.A + (size_t)nxt.pm * tstepA : cA; const char* nB = has_next ? (const char*)g.Bt + (size_t)nxt.pn * tstepB : cB;
        for (int t = 0; t < nt; t += 2) {
            const bool last = (t == nt - 2);
            if constexpr (Epi::HOOK) { if (t == 4 || t == 12) { PG8_SCHED; E.hook(acc, cur, t, wr, wc, fr, fq); PG8_SCHED; } }
            const char* a1 = cA + (size_t)(t + 1) * kstep;
            const char* a2 = last ? nA : cA + (size_t)(t + 2) * kstep; const char* b2 = last ? nB : cB + (size_t)(t + 2) * kstep;
            const char* a3 = a2 + kstep; const char* b3 = b2 + kstep;
            if (last && has_next) S.a_ready(nxt);
            if constexpr (SP2) {
            PG8_LDB(B0, 0, 0); PG8_LDB(B1, 0, 1); PG8_SCHED; PG8_LDA(At, 0, 0); PG8_STAGE(PG8_SA(1, 1), a1 + hstepA, voffA);
            PG8_WAIT_V(8); PG8_WAIT_L(0); PG8_BAR; PG8_MMA(0, 0, At, B0); PG8_MMA(0, 1, At, B1); PG8_BAR; PG8_SCHED;
            PG8_LDA(At, 0, 1); PG8_STAGE(PG8_SB(0, 0), b2, voffB); PG8_STAGE(PG8_SB(0, 1), b2 + hstepB, voffB); PG8_STAGE(PG8_SA(0, 0), a2, voffA);
            PG8_WAIT_V(8); PG8_WAIT_L(0); PG8_BAR; PG8_MMA(1, 0, At, B0); PG8_MMA(1, 1, At, B1); PG8_BAR; PG8_SCHED;
            PG8_LDB(B0, 1, 0); PG8_LDB(B1, 1, 1); PG8_SCHED; PG8_LDA(At, 1, 0); PG8_STAGE(PG8_SA(0, 1), a2 + hstepA, voffA);
            PG8_WAIT_V(8); PG8_WAIT_L(0); PG8_BAR; PG8_MMA(0, 0, At, B0); PG8_MMA(0, 1, At, B1); PG8_BAR; PG8_SCHED;
            PG8_LDA(At, 1, 1); PG8_STAGE(PG8_SB(1, 0), b3, voffB); PG8_STAGE(PG8_SB(1, 1), b3 + hstepB, voffB); PG8_STAGE(PG8_SA(1, 0), a3, voffA);
            PG8_WAIT_V(8); PG8_WAIT_L(0); PG8_BAR; PG8_MMA(1, 0, At, B0); PG8_MMA(1, 1, At, B1); PG8_BAR; PG8_SCHED;
            } else {
            PG8_LDB(B0, 0, 0); PG8_SCHED; PG8_LDA(At, 0, 0); PG8_STAGE(PG8_SA(1, 1), a1 + hstepA, voffA);
            PG8_WAIT_L(8); PG8_BAR; PG8_WAIT_L(0); PG8_MMA(0, 0, At, B0); PG8_BAR; PG8_SCHED;
            PG8_LDB(B1, 0, 1); PG8_STAGE(PG8_SB(0, 0), b2, voffB);
            PG8_BAR; PG8_WAIT_L(0); PG8_MMA(0, 1, At, B1); PG8_BAR;
            PG8_LDA(At, 0, 1); PG8_STAGE(PG8_SA(0, 0), a2, voffA);
            PG8_BAR; PG8_WAIT_L(0); PG8_MMA(1, 0, At, B0); PG8_BAR; PG8_SCHED;
            PG8_STAGE(PG8_SB(0, 1), b2 + hstepB, voffB);
            PG8_WAIT_V(6); PG8_BAR; PG8_MMA(1, 1, At, B1); PG8_BAR;
            PG8_LDB(B0, 1, 0); PG8_SCHED; PG8_LDA(At, 1, 0); PG8_STAGE(PG8_SA(0, 1), a2 + hstepA, voffA);
            PG8_WAIT_L(8); PG8_BAR; PG8_WAIT_L(0); PG8_MMA(0, 0, At, B0); PG8_BAR; PG8_SCHED;
            PG8_LDB(B1, 1, 1); PG8_STAGE(PG8_SB(1, 0), b3, voffB);
            PG8_BAR; PG8_WAIT_L(0); PG8_MMA(0, 1, At, B1); PG8_BAR;
            PG8_LDA(At, 1, 1); PG8_STAGE(PG8_SA(1, 0), a3, voffA);
            PG8_BAR; PG8_WAIT_L(0); PG8_MMA(1, 0, At, B0); PG8_BAR; PG8_SCHED;
            PG8_STAGE(PG8_SB(1, 1), b3 + hstepB, voffB);
            PG8_WAIT_V(6); PG8_BAR; PG8_MMA(1, 1, At, B1); PG8_BAR;
            }
        }
        if constexpr (ALIGN_EPI) { if (wr == 0) PG8_BAR; }
        if constexpr (!Epi::AFTER_DRAIN) { E(acc, cur, wr, wc, fr, fq); S.done(cur); }
        if (!has_next) break;
#pragma unroll
        for (int a = 0; a < 2; ++a)
#pragma unroll
            for (int b = 0; b < 2; ++b)
#pragma unroll
                for (int m = 0; m < 4; ++m)
#pragma unroll
                    for (int n = 0; n < 2; ++n) acc[a][b][m][n] = (f32x4){0.f, 0.f, 0.f, 0.f};
        cur = nxt; cA = nA; cB = nB; ++ui;
        if constexpr (ALIGN_EPI) { if (wr == 1) PG8_BAR; }
    }
    PG8_WAIT_V(0);
    if constexpr (!ALIGN_EPI) { if (wr == 0) PG8_BAR; }
    PG8_BAR;
    if constexpr (Epi::AFTER_DRAIN) { E.fused(acc, cur, wr, wc, fr, fq, lds, wid, lane); S.done(cur); }
#undef PG8_SA
#undef PG8_SB
#undef PG8_STAGE
#undef PG8_LDA
#undef PG8_LDB
#undef PG8_MMA
#undef PG8_WAIT_V
#undef PG8_WAIT_L
#undef PG8_BAR
#undef PG8_SCHED
}
}
using namespace pg8;
#define LAS __attribute__((address_space(3)))
typedef float f32x16 __attribute__((ext_vector_type(16)));
constexpr int NWAVES = 8, NTHR = 512;
constexpr int SEQ = 4096, NBATCH = 16;
constexpr int LDS_BYTES = 147456;
constexpr int LDS_SCR = 131072;
constexpr size_t MiB = 1u << 20;
constexpr size_t WS_KMAX = 32768;
constexpr size_t WS_SS = 1 * MiB, WS_W = 5 * MiB, WS_TAB = 53 * MiB, WS_XB = 54 * MiB, WS_MIX = 182 * MiB;
constexpr size_t WS_P = WS_MIX, WS_LX = WS_MIX + 32 * MiB, WS_Q = WS_MIX + 64 * MiB, WS_K = WS_MIX + 128 * MiB, WS_LG = WS_MIX + 192 * MiB,
                 WS_VT = WS_MIX + 224 * MiB, WS_BR = WS_MIX + 288 * MiB, WS_GATES = WS_MIX + 416 * MiB, WS_END = WS_MIX + 800 * MiB;
constexpr size_t WS_MERGED = WS_Q, WS_ACT = WS_MIX;
constexpr size_t WO_W1A = 0, WO_W2A = WO_W1A + 5632 * 1024, WO_WP = WO_W2A + 1024 * 2816, WO_WV = WO_WP + 4864 * 1024, WO_WG = WO_WV + 512 * 1024,
                 WO_WBR = WO_WG + 1024 * 256, WO_WO = WO_WBR + 1024 * 1024, WO_W1B = WO_WO + 1024 * 1024, WO_W2B = WO_W1B + 5632 * 1024, WO_END = WO_W2B + 1024 * 2816;
static_assert(WO_END * 2 <= 48 * MiB, "weights region");

struct Params { const float* in[26]; float* out; unsigned char* ws; };

__device__ __forceinline__ unsigned f2bf(float f) { unsigned u = __builtin_bit_cast(unsigned, f); return (u + 0x7fffu + ((u >> 16) & 1u)) >> 16; }
__device__ __forceinline__ unsigned pk2(float lo, float hi) { return f2bf(lo) | (f2bf(hi) << 16); }
__device__ __forceinline__ float wave_sum(float v, int lane) {
#pragma unroll
    for (int o = 1; o < 64; o <<= 1) v += shx(v, o, lane);
    return v;
}
__device__ __forceinline__ void transpose_block(const float* W, int ldsrc, int sc0, int k0, bf16_t* WT, int ldd, int dr0, int koff, const float* kscale, LAS float* scr, int lane) {
#pragma unroll 16
    for (int i = 0; i < 32; ++i) { const int kk = 2 * i + (lane >> 5); float v = W[(size_t)(k0 + kk) * ldsrc + sc0 + (lane & 31)]; if (kscale) v *= kscale[k0 + kk]; scr[kk * 33 + (lane & 31)] = v; }
    asm volatile("s_waitcnt lgkmcnt(0)" ::: "memory");
    const int c = lane & 7;
#pragma unroll
    for (int j = 0; j < 4; ++j) { const int n = (lane >> 3) + 8 * j; const LAS float* s = scr + (8 * c) * 33 + n;
        u32x4 o; o.x = pk2(s[0 * 33], s[1 * 33]); o.y = pk2(s[2 * 33], s[3 * 33]); o.z = pk2(s[4 * 33], s[5 * 33]); o.w = pk2(s[6 * 33], s[7 * 33]);
        *(u32x4*)(WT + (size_t)(dr0 + n) * ldd + koff + k0 + 8 * c) = o; }
    asm volatile("s_waitcnt lgkmcnt(0)" ::: "memory");
}
typedef const __attribute__((address_space(4))) Params* KPc;
__device__ __forceinline__ void convert_layer(KPc pp, int l, LAS unsigned char* lds, int G, int wave_s) {
    const int tid = tid_opq(wave_s), lane = tid & 63, wave = tid >> 6;
    LAS float* scr = (LAS float*)(lds + wave * 16384);
    bf16_t* Wb = (bf16_t*)(pp->ws + WS_W);
    const int gw = blockIdx.x * NWAVES + wave, NGW = G * NWAVES;
    constexpr int I_W1 = 16 * 176, I_W2 = 44 * 32, I_WP = 16 * 152, I_WV = 16 * 16, I_BA = 8 * 32, I_BL = 4 * 32, I_WO = 16 * 32;
    constexpr int NIT = 2 * I_W1 + 2 * I_W2 + I_WP + I_WV + I_BA + I_BL + I_WO;
    for (int it = gw; it < NIT; it += NGW) {
        int r = it;
        if (r < 2 * I_W1) { const int f = r / I_W1; r -= f * I_W1; const int kb = r / 176, nb = r % 176; const int dr0 = nb * 32, tile = dr0 >> 8, within = dr0 & 255, bj = within >> 7, j = within & 127;
            const float* src = pp->in[f ? 23 : 2] + (size_t)l * 1024 * 5632; const float* gn = pp->in[f ? 22 : 1] + l * 1024;
            transpose_block(src, 5632, bj * 2816 + tile * 128 + j, kb * 64, Wb + (f ? WO_W1B : WO_W1A), 1024, dr0, 0, gn, scr, lane); continue; }
        r -= 2 * I_W1;
        if (r < 2 * I_W2) { const int f = r / I_W2; r -= f * I_W2; const int kb = r / 32, nb = r % 32;
            const float* src = pp->in[f ? 24 : 3] + (size_t)l * 2816 * 1024;
            transpose_block(src, 1024, nb * 32, kb * 64, Wb + (f ? WO_W2B : WO_W2A), 2816, nb * 32, 0, nullptr, scr, lane); continue; }
        r -= 2 * I_W2;
        if (r < I_WP) { const int kb = r / 152, nb = r % 152; const int dr0 = nb * 32; const int sc0 = dr0 < 1280 ? dr0 : dr0 + 512;
            transpose_block(pp->in[5] + (size_t)l * 1024 * 5376, 5376, sc0, kb * 64, Wb + WO_WP, 1024, dr0, 0, pp->in[4] + l * 1024, scr, lane); continue; }
        r -= I_WP;
        if (r < I_WV) { const int kb = r / 16, nb = r % 16;
            transpose_block(pp->in[5] + (size_t)l * 1024 * 5376, 5376, 1280 + nb * 32, kb * 64, Wb + WO_WV, 1024, nb * 32, 0, pp->in[4] + l * 1024, scr, lane); continue; }
        r -= I_WV;
        if (r < I_BA) { const int kb = r / 32, nb = r % 32;
            transpose_block(pp->in[18] + (size_t)l * 512 * 1024, 1024, nb * 32, kb * 64, Wb + WO_WBR, 1024, nb * 32, 256, nullptr, scr, lane); continue; }
        r -= I_BA;
        if (r < I_BL) { const int kb = r / 32, nb = r % 32;
            transpose_block(pp->in[19] + (size_t)l * 256 * 1024, 1024, nb * 32, kb * 64, Wb + WO_WBR, 1024, nb * 32, 768, nullptr, scr, lane); continue; }
        r -= I_BL;
        { const int kb = r / 32, nb = r % 32;
            transpose_block(pp->in[21] + (size_t)l * 1024 * 1024, 1024, nb * 32, kb * 64, Wb + WO_WO, 1024, nb * 32, 0, nullptr, scr, lane); }
    }
    const int gt = blockIdx.x * NTHR + tid, NGT = G * NTHR;
    { const float* pw = pp->in[6] + (size_t)l * 4 * 64 * 64; const float* ps = pp->in[7] + l * 256; const float* wbp = pp->in[17] + (size_t)l * 256 * 1024;
      for (int i = gt; i < 256 * 1024; i += NGT) { const int n = i & 1023, k = i >> 10, g = k >> 6; const float* pr = pw + (size_t)k * 64; float s = 0.f;
#pragma unroll 16
          for (int d = 0; d < 64; ++d) s += pr[d] * ps[64 * g + d] * wbp[(size_t)(64 * g + d) * 1024 + n];
          Wb[WO_WBR + (size_t)n * 1024 + k] = (bf16_t)f2bf(s); } }
    { for (int i = gt; i < 1024 * 256; i += NGT) { const int k = i & 255, n = i >> 8, tile = n >> 8, bj = (n >> 7) & 1, j = n & 127, dir = tile >> 1, half = tile & 1, ch = half * 128 + j, gq = ch >> 6, d = ch & 63;
          const float* w = pp->in[bj ? 14 : 12] + ((size_t)(l * 2 + dir) * 4 + gq) * 64 * 64; const float v = ((k >> 6) == gq) ? w[(k & 63) * 64 + d] : 0.f;
          Wb[WO_WG + (size_t)n * 256 + k] = (bf16_t)f2bf(v); } }
    { float* tab = (float*)(pp->ws + WS_TAB); const float* lam = pp->in[16] + l * 512;
      for (int i = gt; i < 512; i += NGT) tab[i] = -8.0f * __builtin_amdgcn_logf(1.0f + ex2(-1.44269504f * lam[i])); }
}
__device__ __forceinline__ void x_to_bf16(const float* x, bf16_t* xb, float* ss, int G, int wave_s) {
    const int tid = tid_opq(wave_s), lane = tid & 63, wave = tid >> 6; const int gw = blockIdx.x * NWAVES + wave, NGW = G * NWAVES;
    for (int m0 = gw * 4; m0 < MTOK; m0 += NGW * 4) { f32x4 v[4][4];
#pragma unroll
        for (int r = 0; r < 4; ++r)
#pragma unroll
            for (int j = 0; j < 4; ++j) v[r][j] = ((const f32x4*)(x + (size_t)(m0 + r) * DM) + lane)[64 * j];
#pragma unroll
        for (int r = 0; r < 4; ++r) { u32x2* o = (u32x2*)(xb + (size_t)(m0 + r) * DM) + lane; float s = 0.f;
#pragma unroll
            for (int j = 0; j < 4; ++j) { const f32x4 q = v[r][j]; s += (q[0] * q[0] + q[1] * q[1]) + (q[2] * q[2] + q[3] * q[3]); u32x2 w; w.x = cvt_pk_bf16(q[0], q[1]); w.y = cvt_pk_bf16(q[2], q[3]); o[64 * j] = w; }
            s = wave_sum(s, lane); if (lane < 16) ss[(size_t)(m0 + r) * 16 + lane] = (lane == 0) ? s : 0.f; } }
}
__device__ __forceinline__ void final_norm(const bf16_t* xb, float* out, const float* ss, const float* g, int G, int wave_s) {
    const int tid = tid_opq(wave_s), lane = tid & 63, wave = tid >> 6; const int gw = blockIdx.x * NWAVES + wave, NGW = G * NWAVES;
    f32x4 gv[4];
#pragma unroll
    for (int j = 0; j < 4; ++j) gv[j] = ((const f32x4*)g)[lane + 64 * j];
    for (int m0 = gw * 4; m0 < MTOK; m0 += NGW * 4) { u32x2 w[4][4]; float rs[4];
#pragma unroll
        for (int r = 0; r < 4; ++r) { rs[r] = row_rstd(ss, m0 + r);
#pragma unroll
            for (int j = 0; j < 4; ++j) w[r][j] = ((const u32x2*)(xb + (size_t)(m0 + r) * DM) + lane)[64 * j]; }
#pragma unroll
        for (int r = 0; r < 4; ++r) { f32x4* o = (f32x4*)(out + (size_t)(m0 + r) * DM) + lane;
#pragma unroll
            for (int j = 0; j < 4; ++j) { const u32x2 q = w[r][j]; const f32x4 v = {bf_lo(q.x), bf_hi(q.x), bf_lo(q.y), bf_hi(q.y)}; o[64 * j] = v * rs[r] * gv[j]; } } }
}
__device__ __forceinline__ void unpack8(const u32x4 w, float* f) { f[0] = bf_lo(w.x); f[1] = bf_hi(w.x); f[2] = bf_lo(w.y); f[3] = bf_hi(w.y); f[4] = bf_lo(w.z); f[5] = bf_hi(w.z); f[6] = bf_lo(w.w); f[7] = bf_hi(w.w); }
__device__ __forceinline__ u32x4 pack8f(const float* f) { u32x4 w; w.x = cvt_pk_bf16(f[0], f[1]); w.y = cvt_pk_bf16(f[2], f[3]); w.z = cvt_pk_bf16(f[4], f[5]); w.w = cvt_pk_bf16(f[6], f[7]); return w; }
__device__ __forceinline__ void prep_phase(const bf16_t* __restrict__ P, const bf16_t* __restrict__ LX, bf16_t* __restrict__ BR, const float* __restrict__ cw, const float* __restrict__ cb, const bf16_t* __restrict__ Kb, unsigned* __restrict__ kmax2, int G, int wave_s) {
    const int tid = tid_opq(wave_s), sub = tid >> 5, c8 = (tid & 31) * 8;
#pragma unroll 2
    for (int rb = blockIdx.x; rb < MTOK / 16; rb += G) { const int row = rb * 16 + sub, t = row & (SEQ - 1), b0 = row - t;
        { const int g = c8 >> 6, hw = 1 << g; const int lo = max(t - hw, 0), hi = min(t + hw, SEQ); float sum[8] = {0, 0, 0, 0, 0, 0, 0, 0}, f[8];
#pragma unroll
          for (int o = 0; o < 16; ++o) { const int tt = t - hw + o; if (o < 2 * hw && tt >= 0 && tt < SEQ) { unpack8(*(const u32x4*)(P + (size_t)(b0 + tt) * 256 + c8), f);
#pragma unroll
              for (int e = 0; e < 8; ++e) sum[e] += f[e]; } }
          unpack8(*(const u32x4*)(P + (size_t)row * 256 + c8), f); const float inv = 1.0f / (float)(hi - lo);
#pragma unroll
          for (int e = 0; e < 8; ++e) sum[e] = sum[e] * inv - f[e];
          *(u32x4*)(BR + (size_t)row * 1024 + c8) = pack8f(sum); }
        { float a[8], f[8];
#pragma unroll
          for (int e = 0; e < 8; ++e) a[e] = cb[c8 + e];
#pragma unroll
          for (int j = 0; j < 4; ++j) { const int tt = t - 2 + j; if (tt >= 0 && tt < SEQ) { unpack8(*(const u32x4*)(LX + (size_t)(b0 + tt) * 256 + c8), f);
#pragma unroll
                  for (int e = 0; e < 8; ++e) a[e] += cw[j * 256 + c8 + e] * f[e]; } }
          *(u32x4*)(BR + (size_t)row * 1024 + 768 + c8) = pack8f(a); }
        { float f[8], g8[8]; unpack8(*(const u32x4*)(Kb + (size_t)row * 512 + 2 * c8), f); unpack8(*(const u32x4*)(Kb + (size_t)row * 512 + 2 * c8 + 8), g8); float s = 0.f;
#pragma unroll
          for (int e = 0; e < 8; ++e) s += f[e] * f[e] + g8[e] * g8[e];
          s += shx(s, 1, tid & 63); s += shx(s, 2, tid & 63);
          if ((tid & 3) == 0) { unsigned* dst = kmax2 + (row >> 12) * 8 + ((tid & 31) >> 2); const unsigned sv = __float_as_uint(s);
              if (sv > __hip_atomic_load(dst, __ATOMIC_RELAXED, __HIP_MEMORY_SCOPE_AGENT)) atomicMax(dst, sv); } }
    }
}
__device__ __forceinline__ void lau4(const u32x4 w, f32x4& a, f32x4& u) {
    const unsigned w0 = w.x, w1 = w.y, w2 = w.z, w3 = w.w;
    const h2_t h0 = __builtin_bit_cast(h2_t, w0), h1 = __builtin_bit_cast(h2_t, w1), h2 = __builtin_bit_cast(h2_t, w2), h3 = __builtin_bit_cast(h2_t, w3);
    a = (f32x4){ex2((float)h0[0]), ex2((float)h1[0]), ex2((float)h2[0]), ex2((float)h3[0])}; u = (f32x4){(float)h0[1], (float)h1[1], (float)h2[1], (float)h3[1]};
}
__device__ __forceinline__ void scan_unit(LAS unsigned char* lds, const unsigned* __restrict__ AU, const bf16_t* __restrict__ GL, bf16_t* __restrict__ BR, int b, int cg8, int wave_s) {
    const int tid = tid_opq(wave_s), cq = tid & 1, j = tid >> 1, ch = cg8 * 8 + cq * 4, t0 = j * 16;
    LAS float* sPf = (LAS float*)lds; LAS float* sHf = sPf + 2048; LAS float* sPb = sPf + 4096; LAS float* sHb = sPf + 6144; LAS float* sCf = sPf + 8192; LAS float* sCb = sPf + 10240;
    const unsigned* auf = AU + ((size_t)b * SEQ + t0) * 256 + ch; const unsigned* aub = auf + (size_t)MTOK * 256;
    u32x4 wf[16], wb[16];
#pragma unroll
    for (int s = 0; s < 16; ++s) { wf[s] = *(const u32x4*)(auf + (size_t)s * 256); wb[s] = *(const u32x4*)(aub + (size_t)s * 256); }
    { f32x4 Pp = {1.f, 1.f, 1.f, 1.f}, H = {0.f, 0.f, 0.f, 0.f};
#pragma unroll
      for (int s = 0; s < 16; ++s) { f32x4 a, u; lau4(wf[s], a, u); Pp = Pp * a; H = a * H + u; }
      *(LAS f32x4*)(sPf + j * 8 + cq * 4) = Pp; *(LAS f32x4*)(sHf + j * 8 + cq * 4) = H; }
    { f32x4 Pp = {1.f, 1.f, 1.f, 1.f}, H = {0.f, 0.f, 0.f, 0.f};
#pragma unroll
      for (int s = 15; s >= 0; --s) { f32x4 a, u; lau4(wb[s], a, u); Pp = Pp * a; H = a * H + u; }
      *(LAS f32x4*)(sPb + j * 8 + cq * 4) = Pp; *(LAS f32x4*)(sHb + j * 8 + cq * 4) = H; }
#pragma unroll
    for (int s = 0; s < 16; ++s) { asm volatile("" : "+v"(wf[s]), "+v"(wb[s])); }
    __syncthreads();
    if (tid < 16) { const int c = tid & 7; float h = 0.f;
        if (tid < 8) {
#pragma unroll 8
            for (int jj = 0; jj < 256; ++jj) { sCf[jj * 8 + c] = h; h = sPf[jj * 8 + c] * h + sHf[jj * 8 + c]; } }
        else {
#pragma unroll 8
            for (int jj = 255; jj >= 0; --jj) { sCb[jj * 8 + c] = h; h = sPb[jj * 8 + c] * h + sHb[jj * 8 + c]; } } }
    __syncthreads();
    { f32x4 h = *(const LAS f32x4*)(sCb + j * 8 + cq * 4);
#pragma unroll
      for (int s = 15; s >= 0; --s) { f32x4 a, u; lau4(wb[s], a, u); h = a * h + u; wb[s] = __builtin_bit_cast(u32x4, h); } }
    { f32x4 h = *(const LAS f32x4*)(sCf + j * 8 + cq * 4);
      for (int sb = 0; sb < 16; sb += 8) { u32x2 gw[8];
#pragma unroll
        for (int i = 0; i < 8; ++i) gw[i] = *(const u32x2*)(GL + ((size_t)b * SEQ + t0 + sb + i) * 256 + ch);
#pragma unroll
        for (int i = 0; i < 8; ++i) { const int s = sb + i; const size_t row = (size_t)b * SEQ + t0 + s; f32x4 a, u; lau4(wf[s], a, u); h = a * h + u; const f32x4 hb = __builtin_bit_cast(f32x4, wb[s]);
            const f32x4 o = {(h[0] + hb[0]) * bf_lo(gw[i].x), (h[1] + hb[1]) * bf_hi(gw[i].x), (h[2] + hb[2]) * bf_lo(gw[i].y), (h[3] + hb[3]) * bf_hi(gw[i].y)};
            u32x2 ow; ow.x = cvt_pk_bf16(o[0], o[1]); ow.y = cvt_pk_bf16(o[2], o[3]); *(u32x2*)(BR + row * 1024 + 768 + ch) = ow; } } }
    __syncthreads();
}
__device__ __forceinline__ int crow(int r, int hi) { return (r & 3) + 8 * (r >> 2) + 4 * hi; }
__device__ __forceinline__ bf16x8 pack_p(const f32x16& s, int o) {
    u32x4 w; w.x = cvt_pk_bf16(s[o + 0], s[o + 1]); w.y = cvt_pk_bf16(s[o + 2], s[o + 3]); w.z = cvt_pk_bf16(s[o + 4], s[o + 5]); w.w = cvt_pk_bf16(s[o + 6], s[o + 7]);
    return __builtin_bit_cast(bf16x8, w);
}
__device__ __forceinline__ void attn_unit(LAS unsigned char* lds, const bf16_t* Q, const bf16_t* Kb, const bf16_t* Vt, bf16_t* BR, int b, int h, int qblk, float lam, float slope2, const float* subln, float lam_init, const unsigned* kmax2, int wave_s) {
    const int tid = tid_opq(wave_s), lane = tid & 63, wid = wave_s  , r32 = lane & 31, hi = lane >> 5, mp = wid >> 2, wq = wid & 3;
    const int q0 = qblk * 128; const size_t rowbase = (size_t)b * SEQ;
    bf16x8 qf[4];
    { const bf16_t* qp = Q + (rowbase + q0 + wq * 32 + r32) * 512 + h * 128 + mp * 64 + hi * 8;
#pragma unroll
      for (int d0 = 0; d0 < 4; ++d0) qf[d0] = *(const bf16x8*)(qp + d0 * 16); }
    const int srow = tid >> 3, sc = (tid & 7) ^ ((srow >> 1) & 7);
    const bf16_t* kg = Kb + (rowbase + srow) * 512 + h * 128 + sc * 8;
    const bf16_t* vg = Vt + ((size_t)(b * 512 + h * 128 + srow)) * 4096 + sc * 8;
    const int wofs = wid * 1024;
    const int sw = (r32 >> 1) & 7;
    const int kfo = mp * 8192 + r32 * 128, vfo = 65536 + r32 * 128;
#define ATT_DMA(gp, off) __builtin_amdgcn_global_load_lds((const unsigned*)(gp), (LAS unsigned*)(lds + (off)), 16, 0, 0)
    LAS float* scr = (LAS float*)(lds + LDS_SCR + wid * 128);
    const int td = q0 >> 6;
    { const size_t k0_ = (size_t)td * 64, k1_ = k0_ + 64;
      ATT_DMA(kg + k0_ * 512, wofs); ATT_DMA(kg + k0_ * 512 + 64, 8192 + wofs); ATT_DMA(kg + k1_ * 512, 16384 + wofs); ATT_DMA(kg + k1_ * 512 + 64, 16384 + 8192 + wofs);
      ATT_DMA(vg + k0_, 65536 + wofs); ATT_DMA(vg + k0_ + (size_t)64 * 4096, 65536 + 8192 + wofs); }
    int tlo, thi;
    { float q2 = 0.f;
#pragma unroll
      for (int d0 = 0; d0 < 4; ++d0) { const u32x4 w = __builtin_bit_cast(u32x4, qf[d0]); float f[8]; unpack8(w, f);
#pragma unroll
          for (int e = 0; e < 8; ++e) q2 += f[e] * f[e]; }
      q2 += shx(q2, 32, lane);
#pragma unroll
      for (int o = 1; o < 32; o <<= 1) q2 = fmaxf(q2, shx(q2, o, lane));
      LAS float* qx = (LAS float*)(lds + LDS_SCR + 1040);
      if (lane == 0) qx[wid] = q2;
      __syncthreads();
      float qm = qx[0];
#pragma unroll
      for (int w = 1; w < 8; ++w) qm = fmaxf(qm, qx[w]);
      const float k2 = fmaxf(__uint_as_float(kmax2[b * 8 + 2 * h]), __uint_as_float(kmax2[b * 8 + 2 * h + 1]));
      const float bound = 160.0f + 2.02f * __builtin_sqrtf(qm * k2);
      const float Df = fminf(bound / slope2, 16384.0f);
      const int hi_ = (int)floorf((Df + (float)(q0 + 127)) * (1.0f / 64.0f)), lo_ = (int)ceilf(((float)(q0 - 63) - Df) * (1.0f / 64.0f));
      thi = __builtin_amdgcn_readfirstlane(hi_ > 63 ? 63 : hi_); tlo = __builtin_amdgcn_readfirstlane(lo_ < 0 ? 0 : lo_);
      if (thi < td + 1) thi = td + 1; if (tlo > td) tlo = td; }
    const int ntile = thi - tlo + 1, nr = thi - td + 1;
#define ATT_TILE(i) (((i) < nr) ? (td + (i)) : (td - 1 + nr - (i)))
#define SBAR() __builtin_amdgcn_sched_barrier(0)
#define MFMA32(a, b, c) __builtin_amdgcn_mfma_f32_32x32x16_bf16(a, b, c, 0, 0, 0)
    { const u32x4 z = (u32x4){0u, 0u, 0u, 0u}; *(LAS u32x4*)(lds + 65536 + 3 * 16384 + tid * 32) = z; *(LAS u32x4*)(lds + 65536 + 3 * 16384 + tid * 32 + 16) = z;
      const size_t k2_ = (size_t)ATT_TILE(ntile > 2 ? 2 : ntile - 1) * 64;
      ATT_DMA(kg + k2_ * 512, 32768 + wofs); ATT_DMA(kg + k2_ * 512 + 64, 32768 + 8192 + wofs); }
    asm volatile("s_waitcnt vmcnt(0) lgkmcnt(0)\n\ts_barrier" ::: "memory");
    f32x16 SA0, SA1, SB0, SB1;
#pragma unroll
    for (int r = 0; r < 16; ++r) { SA0[r] = 0.f; SA1[r] = 0.f; }
#pragma unroll
    for (int d0 = 0; d0 < 4; ++d0) { const int co = ((2 * d0 + hi) ^ sw) << 4;
        SA0 = MFMA32(*(const LAS bf16x8*)(lds + kfo + co), qf[d0], SA0); SA1 = MFMA32(*(const LAS bf16x8*)(lds + kfo + 4096 + co), qf[d0], SA1); }
    float mrun = -1e30f, lsum = 0.f; f32x16 O[4];
#pragma unroll
    for (int d = 0; d < 4; ++d)
#pragma unroll
        for (int r = 0; r < 16; ++r) O[d][r] = 0.f;
    const float qposf = (float)(q0 + wq * 32 + r32 - 4 * hi);
#define KFRAG(d0, blk) (*(const LAS bf16x8*)(kb_ + (blk) * 4096 + (((2 * (d0) + hi) ^ sw) << 4)))
#define VFRAG(g) (*(const LAS bf16x8*)(vb_ + ((g) & 3) * 4096 + (((2 * ((g) >> 2) + hi) ^ sw) << 4)))
#define ATT_BIAS(SC0, SC1, d0) do { _Pragma("unroll") for (int r = 4 * (d0); r < 4 * (d0) + 4; ++r) { const float cr_ = (float)((r & 3) + 8 * (r >> 2)); \
        if (FAST_) { SC0[r] = __builtin_fmaf(ssg_, cr_, SC0[r]); SC1[r] = __builtin_fmaf(ssg_, cr_ + 32.f, SC1[r]); mx0_ = fmaxf(mx0_, fmaxf(SC0[r], SC1[r])); } \
        else { SC0[r] = SC0[r] - slope2 * __builtin_fabsf(dq_ - cr_); SC1[r] = SC1[r] - slope2 * __builtin_fabsf(dq_ - 32.f - cr_); mx0_ = fmaxf(mx0_, fmaxf(SC0[r], SC1[r])); } } } while (0)
#define ATT_STEP(t, SC0, SC1, SN0, SN1, FAST) do { \
        constexpr bool FAST_ = (FAST) != 0; \
        const int t_ = (t); const int tile_ = ATT_TILE(t_); \
        { const int tn_ = (t_ + 3 < ntile) ? t_ + 3 : ntile - 1, tv_ = (t_ + 1 < ntile) ? t_ + 1 : ntile - 1; const int tk_ = ATT_TILE(tn_), tvt_ = ATT_TILE(tv_); const size_t kv0_ = (size_t)tk_ * 64, vv0_ = (size_t)tvt_ * 64; \
          const int kd_ = ((t_ + 3) & 3) * 16384 + wofs, vd_ = 65536 + ((t_ + 1) & 3) * 16384 + wofs; \
          ATT_DMA(kg + kv0_ * 512, kd_); ATT_DMA(kg + kv0_ * 512 + 64, kd_ + 8192); ATT_DMA(vg + vv0_, vd_); ATT_DMA(vg + vv0_ + (size_t)64 * 4096, vd_ + 8192); } \
        const LAS unsigned char* kb_ = lds + ((t_ + 1) & 3) * 16384 + kfo; const LAS unsigned char* vb_ = lds + ((t_ + 3) & 3) * 16384 + vfo; \
        const float dq_ = qposf - (float)(tile_ * 64); float mx0_ = -1e30f; \
        const float ssg_ = (t_ < nr) ? -slope2 : slope2; const float c1_ = -ssg_ * dq_; \
        bf16x8 k00_ = KFRAG(0, 0), k01_ = KFRAG(0, 1), k10_ = KFRAG(1, 0), k11_ = KFRAG(1, 1); \
        ATT_BIAS(SC0, SC1, 0); SBAR(); \
        { f32x16 z_; _Pragma("unroll") for (int r = 0; r < 16; ++r) z_[r] = 0.f; SN0 = MFMA32(k00_, qf[0], z_); SN1 = MFMA32(k01_, qf[0], z_); } \
        k00_ = KFRAG(2, 0); k01_ = KFRAG(2, 1); ATT_BIAS(SC0, SC1, 1); SBAR(); \
        SN0 = MFMA32(k10_, qf[1], SN0); SN1 = MFMA32(k11_, qf[1], SN1); \
        k10_ = KFRAG(3, 0); k11_ = KFRAG(3, 1); ATT_BIAS(SC0, SC1, 2); SBAR(); \
        SN0 = MFMA32(k00_, qf[2], SN0); SN1 = MFMA32(k01_, qf[2], SN1); \
        bf16x8 v0_ = VFRAG(0), v1_ = VFRAG(1); ATT_BIAS(SC0, SC1, 3); SBAR(); \
        SN0 = MFMA32(k10_, qf[3], SN0); SN1 = MFMA32(k11_, qf[3], SN1); \
        float mt_ = FAST_ ? (mx0_ + c1_) : mx0_; \
        mt_ = fmaxf(mt_, shx(mt_, 32, lane)); \
        const bool resc_ = __any(mt_ > mrun); \
        { const float mn_ = fmaxf(mrun, mt_), al_ = ex2(mrun - mn_); lsum *= al_; mrun = mn_; if (hi == 0) scr[r32] = al_; } \
        const float mo0_ = FAST_ ? (mrun - c1_) : mrun; \
        SBAR(); \
        _Pragma("unroll") for (int g = 0; g < 16; ++g) { const int c_ = g >> 2, d_ = g & 3; \
            bf16x8 v2_ = v0_; if (g < 14) v2_ = VFRAG(g + 2); \
            O[d_] = MFMA32(PK[c_], v0_, O[d_]); \
            if (g < 8) { SC0[2 * g] = ex2(SC0[2 * g] - mo0_); SC0[2 * g + 1] = ex2(SC0[2 * g + 1] - mo0_); lsum += SC0[2 * g] + SC0[2 * g + 1]; } \
            else { SC1[2 * g - 16] = ex2(SC1[2 * g - 16] - mo0_); SC1[2 * g - 15] = ex2(SC1[2 * g - 15] - mo0_); lsum += SC1[2 * g - 16] + SC1[2 * g - 15]; } \
            if (g == 3) PK[0] = pack_p(SC0, 0); if (g == 7) PK[1] = pack_p(SC0, 8); if (g == 11) PK[2] = pack_p(SC1, 0); if (g == 15) PK[3] = pack_p(SC1, 8); \
            v0_ = v1_; v1_ = v2_; SBAR(); } \
        if (resc_) { f32x4 al4_[4]; \
            _Pragma("unroll") for (int jq = 0; jq < 4; ++jq) al4_[jq] = *(const LAS f32x4*)(scr + 8 * jq + 4 * hi); \
            _Pragma("unroll") for (int d = 0; d < 4; ++d) _Pragma("unroll") for (int r = 0; r < 16; ++r) O[d][r] *= al4_[r >> 2][r & 3]; } \
        asm volatile("s_waitcnt vmcnt(4) lgkmcnt(0)\n\ts_barrier" ::: "memory");     \
    } while (0)
    bf16x8 PK[4];
#pragma unroll
    for (int c = 0; c < 4; ++c) PK[c] = (bf16x8){0, 0, 0, 0, 0, 0, 0, 0};
    ATT_STEP(0, SA0, SA1, SB0, SB1, 0);
    ATT_STEP(1, SB0, SB1, SA0, SA1, 0);
    for (int t = 2; t < ntile; t += 2) {
        ATT_STEP(t, SA0, SA1, SB0, SB1, 1);
        if (t + 1 >= ntile) break;
        ATT_STEP(t + 1, SB0, SB1, SA0, SA1, 1);
    }
    { const LAS unsigned char* vb_ = lds + ((ntile - 1) & 3) * 16384 + vfo;
#pragma unroll
      for (int c = 0; c < 4; ++c)
#pragma unroll
          for (int d = 0; d < 4; ++d) { const bf16x8 vf = *(const LAS bf16x8*)(vb_ + d * 4096 + (((2 * c + hi) ^ sw) << 4)); O[d] = MFMA32(PK[c], vf, O[d]); } }
    lsum += shx(lsum, 32, lane);
    if (hi == 0) scr[r32] = rcpf_(lsum);
    __builtin_amdgcn_wave_barrier();
    { f32x4 al[4];
#pragma unroll
      for (int jq = 0; jq < 4; ++jq) al[jq] = *(const LAS f32x4*)(scr + 8 * jq + 4 * hi);
#pragma unroll
      for (int d = 0; d < 4; ++d)
#pragma unroll
          for (int r = 0; r < 16; ++r) O[d][r] *= al[r >> 2][r & 3]; }
    asm volatile("s_waitcnt vmcnt(0)" ::: "memory");
    __syncthreads();
    LAS float* C = (LAS float*)lds;
    if (mp == 1) {
#pragma unroll
        for (int d = 0; d < 4; ++d)
#pragma unroll
            for (int r = 0; r < 16; ++r) C[(wq * 32 + crow(r, hi)) * 132 + d * 32 + r32] = O[d][r]; }
    __syncthreads();
    if (mp == 0) {
#pragma unroll
        for (int d = 0; d < 4; ++d)
#pragma unroll
            for (int r = 0; r < 16; ++r) { const int ix = (wq * 32 + crow(r, hi)) * 132 + d * 32 + r32; C[ix] = O[d][r] - lam * C[ix]; } }
    __syncthreads();
    { float li_ = lam_init; asm volatile("" : "+s"(li_)); const float outscale = 1.0f - li_;
      const int tid2 = tid_opq(wave_s); const int row = tid2 >> 2, part = tid2 & 3; const LAS float* cp = C + row * 132 + part * 32; float v[32]; float sq = 0.f;
#pragma unroll
      for (int jq = 0; jq < 8; ++jq) { const f32x4 x = *(const LAS f32x4*)(cp + 4 * jq); v[4 * jq] = x[0]; v[4 * jq + 1] = x[1]; v[4 * jq + 2] = x[2]; v[4 * jq + 3] = x[3]; sq += (x[0] * x[0] + x[1] * x[1]) + (x[2] * x[2] + x[3] * x[3]); }
      sq += shx(sq, 1, tid2 & 63); sq += shx(sq, 2, tid2 & 63);
      const float rs = __builtin_amdgcn_rsqf(sq * (1.0f / 128.0f) + 1e-5f) * outscale;
      bf16_t* op = BR + (rowbase + q0 + row) * 1024 + 256 + h * 128 + part * 32;
#pragma unroll
      for (int jq = 0; jq < 4; ++jq) { float f[8];
#pragma unroll
          for (int e = 0; e < 8; ++e) f[e] = v[8 * jq + e] * rs * subln[part * 32 + 8 * jq + e];
          *(u32x4*)(op + 8 * jq) = pack8f(f); } }
    __syncthreads();
#undef ATT_TILE
#undef ATT_DMA
#undef ATT_STEP
#undef ATT_BIAS
#undef KFRAG
#undef VFRAG
#undef SBAR
#undef MFMA32
}

typedef const __attribute__((address_space(4))) Params* KP;
__device__ __forceinline__ KP kparams() { auto k = __builtin_amdgcn_kernarg_segment_ptr(); asm volatile("" : "+s"(k)); return (KP)k; }
#define WSP(T, off) ((T*)(kp->ws + (off)))
#define RLX_AGENT __ATOMIC_RELAXED, __HIP_MEMORY_SCOPE_AGENT
#define XB_TMO      128
#define XB_XCNT(j)  (256  + 64 * (j))
#define XB_XSUB(j)  (1280 + 64 * (j))
#define XB_XGEN(j)  (2304 + 64 * (j))
#define XB_TOP      3328
#define XB_TOPGEN   3392
#define XCD_BAR_WORDS 3456
#define XB_SPIN_CAP (1u << 18)

__device__ __forceinline__ unsigned xb_ld(unsigned* p)              { return __hip_atomic_load(p, __ATOMIC_RELAXED, __HIP_MEMORY_SCOPE_AGENT); }
__device__ __forceinline__ unsigned xb_add(unsigned* p, unsigned v) { return __hip_atomic_fetch_add(p, v, __ATOMIC_RELAXED, __HIP_MEMORY_SCOPE_AGENT); }
__device__ __forceinline__ unsigned xb_xcc_id() { return (unsigned)__builtin_amdgcn_s_getreg((3 << 11) | 20) & 0xFu; }
#define XB_SPIN(cond, bar) do { unsigned _sp = 0; while (cond) { __builtin_amdgcn_s_sleep(1); \
    if ((++_sp & 255u) == 0u) { if (xb_ld(&(bar)[XB_TMO])) break; if (_sp > XB_SPIN_CAP) { atomicAdd(&(bar)[XB_TMO], 1u); break; } } } } while (0)

struct XcdBarrier {
    unsigned* bar; unsigned x;
    volatile LAS unsigned* st;
};

__device__ __forceinline__ XcdBarrier xcd_barrier_post(unsigned* bar, volatile LAS unsigned* st, int tid) {
    XcdBarrier b; b.bar = bar; b.x = xb_xcc_id(); b.st = st;
    if (tid == 0) (void)xb_add(&bar[XB_XCNT(b.x)], 1u);
    return b;
}
__device__ __forceinline__ void xcd_barrier_complete(unsigned* bar, unsigned x, unsigned& nloc, unsigned& nx) {
    const unsigned G = gridDim.x * gridDim.y * gridDim.z;
    unsigned sum, cnt, mine, sp = 0u;
    for (;;) {
        sum = 0u; cnt = 0u; mine = 0u;
#pragma unroll
        for (unsigned j = 0; j < 16; ++j) { const unsigned c = xb_ld(&bar[XB_XCNT(j)]); sum += c; cnt += (c > 0u) ? 1u : 0u; mine = (j == x) ? c : mine; }
        if (sum == G) break;
        __builtin_amdgcn_s_sleep(1);
        if ((++sp & 255u) == 0u) { if (xb_ld(&bar[XB_TMO])) break; if (sp > XB_SPIN_CAP) { atomicAdd(&bar[XB_TMO], 1u); break; } }
    }
    nloc = mine > 0u ? mine : 1u; nx = cnt > 0u ? cnt : 1u;
}

__device__ __forceinline__ void xcd_barrier(const XcdBarrier& b, int tid) {
    asm volatile("s_waitcnt vmcnt(0)" ::: "memory");
    __syncthreads();
    if (tid == 0) {
        unsigned* bar = b.bar;
        __builtin_amdgcn_s_waitcnt(0);
        unsigned nloc = b.st[0], nx = b.st[1];
        if (nloc == 0u) { xcd_barrier_complete(bar, b.x, nloc, nx); b.st[0] = nloc; b.st[1] = nx; }
        const unsigned old = xb_add(&bar[XB_XSUB(b.x)], 1u);
        const unsigned gen = old / nloc;
        if (old + 1u == (gen + 1u) * nloc) {
            __builtin_amdgcn_fence(__ATOMIC_RELEASE, "agent");
            asm volatile("s_waitcnt vmcnt(0)" ::: "memory");
            const unsigned og = xb_add(&bar[XB_TOP], 1u);
            const unsigned tg = og / nx;
            if (og + 1u == (tg + 1u) * nx) xb_add(&bar[XB_TOPGEN], 1u);
            else XB_SPIN(xb_ld(&bar[XB_TOPGEN]) == tg, bar);
            __builtin_amdgcn_fence(__ATOMIC_ACQUIRE, "agent");
            xb_add(&bar[XB_XGEN(b.x)], 1u);
            asm volatile("s_waitcnt vmcnt(0)" ::: "memory");
        } else {
            XB_SPIN(xb_ld(&bar[XB_XGEN(b.x)]) == gen, bar);
            __builtin_amdgcn_fence(__ATOMIC_ACQUIRE, "agent");
            asm volatile("s_waitcnt vmcnt(0)" ::: "memory");
        }
    }
    __syncthreads();
}
constexpr int LDS_BARST = LDS_SCR + 1024;
__device__ __forceinline__ void xsync(LAS unsigned char* lds, int wave_s) {
    KP kp = kparams(); XcdBarrier b; b.bar = (unsigned*)kp->ws; b.x = xb_xcc_id(); b.st = (volatile LAS unsigned*)(lds + LDS_BARST);
    xcd_barrier(b, tid_opq(wave_s));
}
#ifdef DUP_SYNC
#define GSYNC() do { xsync(lds, wave_s); xsync(lds, wave_s); } while (0)
#else
#define GSYNC() xsync(lds, wave_s)
#endif
#ifndef REP_SMALL
#define REP_SMALL 1
#endif
#ifndef REP_PROJ
#define REP_PROJ 1
#endif
#ifndef REP_MERGED
#define REP_MERGED 1
#endif
#ifndef REP_OUT
#define REP_OUT 1
#endif
#ifndef REP_XF
#define REP_XF 1
#endif
#ifndef REP_FFN2
#define REP_FFN2 1
#endif
#ifdef DUP_ATTN
#define ATT_REPS 2
#else
#define ATT_REPS 1
#endif
#ifdef DUP_FFN1
#define FFN1_REPS 2
#else
#define FFN1_REPS 1
#endif
__global__ void __launch_bounds__(NTHR, 2) fwd_megakernel(Params p_unused) {
    extern __shared__ __attribute__((aligned(16))) unsigned char lds_raw[];
    LAS unsigned char* lds = (LAS unsigned char*)lds_raw;
    cg::grid_group grid = cg::this_grid();
    const int wave_s = __builtin_amdgcn_readfirstlane((int)(threadIdx.x >> 6));
    { const int t0 = tid_opq(wave_s); if (t0 < 2) ((LAS unsigned*)(lds + LDS_BARST))[t0] = 0u; __syncthreads();
      KP kp = kparams(); (void)xcd_barrier_post((unsigned*)kp->ws, (volatile LAS unsigned*)(lds + LDS_BARST), t0); }
    for (int l = 0; l < 2; ++l) {
        { KP kp = kparams(); const int G = gridDim.x;
#ifndef SKIP_CONV
for (int rep_ = 0; rep_ < (REP_SMALL); ++rep_)
          convert_layer(kp, l, lds, G, wave_s);
#endif
          for (int rep_ = 0; rep_ < (REP_XF); ++rep_)
          if (l == 0) x_to_bf16(kp->in[0], WSP(bf16_t, WS_XB), WSP(float, WS_SS), G, wave_s); }
        if (l == 0) grid.sync(); else GSYNC();
        for (int f = 0; f < 2; ++f) {
            if (f == 1) {
#ifndef SKIP_PROJ
for (int rep_ = 0; rep_ < (REP_PROJ); ++rep_)
                { KP kp = kparams(); const int G = gridDim.x, bid = blockIdx.x; bf16_t* Wb = WSP(bf16_t, WS_W);
                  Gemm g{WSP(bf16_t, WS_XB), Wb + WO_WP, MTOK, 4864, 1024, 1024, 1024}; StaticOrder S; S.init(MTOK, 4864, G, bid);
                  EpiProj E{WSP(bf16_t, WS_P), WSP(bf16_t, WS_Q), WSP(bf16_t, WS_K), WSP(bf16_t, WS_LX), WSP(bf16_t, WS_LG), WSP(bf16_t, WS_GATES), WSP(float, WS_SS), kp->in[20] + l * 3072};
                  gemm_phase<EpiProj, StaticOrder, true, true>(lds, g, S, E, wave_s); }
#endif
#ifndef SKIP_VT
for (int rep_ = 0; rep_ < (REP_PROJ); ++rep_)
                { KP kp = kparams(); const int G = gridDim.x, bid = blockIdx.x; bf16_t* Wb = WSP(bf16_t, WS_W);
                  Gemm g{Wb + WO_WV, WSP(bf16_t, WS_XB), 512, MTOK, 1024, 1024, 1024}; StaticOrder S; S.init(512, MTOK, G, bid);
                  EpiVt E{WSP(bf16_t, WS_VT), WSP(float, WS_SS)};
                  gemm_phase<EpiVt, StaticOrder, true, true>(lds, g, S, E, wave_s); }
#endif
                GSYNC();
#ifndef SKIP_PREP
for (int rep_ = 0; rep_ < (REP_SMALL); ++rep_)
                { KP kp = kparams(); prep_phase(WSP(bf16_t, WS_P), WSP(bf16_t, WS_LX), WSP(bf16_t, WS_BR), kp->in[10] + l * 1024, kp->in[11] + l * 256, WSP(bf16_t, WS_K), WSP(unsigned, WS_KMAX) + l * 128, gridDim.x, wave_s); }
#endif
                GSYNC();
#ifndef SKIP_GATES
for (int rep_ = 0; rep_ < (REP_SMALL); ++rep_)
                { KP kp = kparams(); const int G = gridDim.x, bid = blockIdx.x; bf16_t* Wb = WSP(bf16_t, WS_W); bf16_t* BR = WSP(bf16_t, WS_BR);
                  int Kg = 256; asm volatile("" : "+s"(Kg));
                  Gemm g{BR + 768, Wb + WO_WG, MTOK, 1024, Kg, 1024, 256}; StaticOrder S; S.init(MTOK, 1024, G, bid);
                  EpiGates E{((unsigned*)kp->out)  , BR + 768, kp->in[13] + l * 512, kp->in[15] + l * 512, WSP(float, WS_TAB)};
                  gemm_phase<EpiGates, StaticOrder, true, true>(lds, g, S, E, wave_s); }
#endif
                GSYNC();
#ifndef SKIP_SCAN
for (int rep_ = 0; rep_ < (REP_SMALL); ++rep_)
                { KP kp = kparams(); const int G = gridDim.x, bid = blockIdx.x;
                  for (int u = bid; u < 512; u += G) { const int v = u & 255, k = u >> 8; scan_unit(lds, ((unsigned*)kp->out), WSP(bf16_t, WS_LG), WSP(bf16_t, WS_BR), (v & 7) + 8 * k, v >> 3, wave_s); } }
#endif
#ifndef SKIP_ATTN
                { KP kp = kparams(); const int G = gridDim.x, bid = blockIdx.x;
                  int ll = l; asm volatile("" : "+s"(ll)); const int lane = tid_opq(wave_s) & 63;
                  const float* lp = kp->in[8] + ll * 256;
                  const float s1 = wave_sum(lp[lane] * lp[64 + lane], lane), s2 = wave_sum(lp[128 + lane] * lp[192 + lane], lane);
                  int lib_ = (ll == 0) ? 0x3e4ccccd   : 0x3eb60549  ; asm volatile("" : "+s"(lib_)); const float lam_init = __int_as_float(lib_);     const float lam = __uint_as_float(__builtin_amdgcn_readfirstlane(__float_as_uint(ex2(1.44269504f * s1) - ex2(1.44269504f * s2) + lam_init)));
                  for (int rep = 0; rep < ATT_REPS; ++rep)
                  for (int u = bid; u < 2048; u += G) { const int x = u & 7, k = u >> 8, slot = (((u >> 3) & 31) + 16 * (k >> 2)) & 31, pair = 8 * k + ((x + k) & 7), b = pair >> 2, h = pair & 3;
                      const float slope2 = __uint_as_float(__builtin_amdgcn_readfirstlane(__float_as_uint(ex2(-2.0f * (float)(h + 1)) * 1.44269504f)));
                      attn_unit(lds, WSP(bf16_t, WS_Q), WSP(bf16_t, WS_K), WSP(bf16_t, WS_VT), WSP(bf16_t, WS_BR), b, h, slot, lam, slope2, kp->in[9] + ll * 128, lam_init, WSP(unsigned, WS_KMAX) + ll * 128, wave_s); } }
#endif
                GSYNC();
#ifndef SKIP_MERGED
for (int rep_ = 0; rep_ < (REP_MERGED); ++rep_)
                { KP kp = kparams(); const int G = gridDim.x, bid = blockIdx.x; bf16_t* Wb = WSP(bf16_t, WS_W);
                  Gemm g{WSP(bf16_t, WS_BR), Wb + WO_WBR, MTOK, 1024, 1024, 1024, 1024}; StaticOrder S; S.init(MTOK, 1024, G, bid);
                  EpiMerged E{WSP(bf16_t, WS_MERGED), WSP(bf16_t, WS_GATES)};
                  gemm_phase<EpiMerged, StaticOrder, true, true>(lds, g, S, E, wave_s); }
#endif
                GSYNC();
#ifndef SKIP_OUT
                for (int rep_ = 0; rep_ < (REP_OUT); ++rep_)
                { KP kp = kparams(); const int G = gridDim.x, bid = blockIdx.x; bf16_t* Wb = WSP(bf16_t, WS_W);
                  Gemm g{WSP(bf16_t, WS_MERGED), Wb + WO_WO, MTOK, 1024, 1024, 1024, 1024}; StaticOrder S; S.init(MTOK, 1024, G, bid);
                  EpiResid E{WSP(bf16_t, WS_XB), WSP(float, WS_SS), (rep_ + 1 < (REP_OUT)) ? 0.0f : 1.0f};
                  gemm_phase<EpiResid, StaticOrder, true, true>(lds, g, S, E, wave_s); }
#endif
                GSYNC();
            }
#ifndef SKIP_FFN1
            for (int rep = 0; rep < FFN1_REPS; ++rep)
            { KP kp = kparams(); const int G = gridDim.x, bid = blockIdx.x; bf16_t* Wb = WSP(bf16_t, WS_W);
              Gemm g{WSP(bf16_t, WS_XB), Wb + (f ? WO_W1B : WO_W1A), MTOK, 5632, 1024, 1024, 1024}; StaticOrder S; S.init(MTOK, 5632, G, bid);
              EpiSwiglu E{WSP(bf16_t, WS_ACT), WSP(float, WS_SS)};
              gemm_phase<EpiSwiglu, StaticOrder, true, true>(lds, g, S, E, wave_s); }
#endif
            GSYNC();
#ifndef SKIP_FFN2
            for (int rep_ = 0; rep_ < (REP_FFN2); ++rep_)
            { KP kp = kparams(); const int G = gridDim.x, bid = blockIdx.x; bf16_t* Wb = WSP(bf16_t, WS_W);
              Gemm g{WSP(bf16_t, WS_ACT), Wb + (f ? WO_W2B : WO_W2A), MTOK, 1024, 2816, 2816, 2816}; StaticOrder S; S.init(MTOK, 1024, G, bid);
              EpiResid E{WSP(bf16_t, WS_XB), WSP(float, WS_SS), 0.5f};
              gemm_phase<EpiResid, StaticOrder, true, true>(lds, g, S, E, wave_s); }
#endif
            GSYNC();
        }
    }
    for (int rep_ = 0; rep_ < (REP_XF); ++rep_)
    { KP kp = kparams(); final_norm(WSP(bf16_t, WS_XB), kp->out, WSP(float, WS_SS), kp->in[25], gridDim.x, wave_s); }
}

extern "C" void kernel_launch(void* const* d_in, const int* in_sizes, int n_in, void* d_out, int out_size, void* d_ws, size_t ws_size, hipStream_t stream) {
    static int grid = 0;
    if (grid == 0) {
        if (n_in != 26 || out_size != MTOK * DM || ws_size < WS_END) { fprintf(stderr, "kernel_launch: unexpected shapes (n_in %d, out %d, ws %zu)\n", n_in, out_size, ws_size); grid = -1; return; }
        int dev = 0, cus = 0, per_cu = 0;
        hipGetDevice(&dev); hipDeviceGetAttribute(&cus, hipDeviceAttributeMultiprocessorCount, dev);
        hipFuncSetAttribute((const void*)fwd_megakernel, hipFuncAttributeMaxDynamicSharedMemorySize, LDS_BYTES);
        hipOccupancyMaxActiveBlocksPerMultiprocessor(&per_cu, (const void*)fwd_megakernel, NTHR, LDS_BYTES);
        if (per_cu < 1) per_cu = 1;
        grid = cus * per_cu;
    }
    if (grid < 0) return;
    if (hipMemsetAsync(d_ws, 0, 65536, stream) != hipSuccess) { fprintf(stderr, "kernel_launch: memset of the barrier words failed\n"); return; }
    Params p{};
    for (int i = 0; i < 26; ++i) p.in[i] = (const float*)d_in[i];
    p.out = (float*)d_out; p.ws = (unsigned char*)d_ws;
    void* args[] = {&p};
    hipError_t e = hipLaunchCooperativeKernel((const void*)fwd_megakernel, dim3(grid), dim3(NTHR), args, LDS_BYTES, stream);
    if (e != hipSuccess) fprintf(stderr, "cooperative launch failed: %s (grid %d)\n", hipGetErrorString(e), grid);
}
```

```cpp
#include <hip/hip_runtime.h>
#include <hip/hip_cooperative_groups.h>
#include <cstdio>
#include <cstdint>
#include <cmath>
namespace cg = cooperative_groups;
namespace pg8 {
#define PG8_LAS __attribute__((address_space(3)))
typedef unsigned short bf16_t;
typedef short bf16x8 __attribute__((ext_vector_type(8)));
typedef float f32x4 __attribute__((ext_vector_type(4)));
typedef unsigned u32x4 __attribute__((ext_vector_type(4)));
constexpr int BM = 256, BK = 64, HALF = 128, HTB = HALF * BK * 2  , STAGE_BYTES = 8 * HTB, NXCD = 8, WGM = 8;

__host__ __device__ __forceinline__ int lds_byte(int r, int c) { const int st = (r >> 4) * 2 + (c >> 5), rr = r & 15, cc = c & 31, ob = rr * 64 + cc * 2; return st * 1024 + (ob ^ (((ob >> 9) & 1) << 5)); }
__host__ __device__ __forceinline__ void stage_rc(int b, int& R, int& C) { const int st = b / 1024, sb = b % 1024, swz = sb ^ (((sb >> 9) & 1) << 5); R = (st >> 1) * 16 + swz / 64; C = (st & 1) * 32 + (swz % 64) / 2; }
__host__ __device__ __forceinline__ int perm32(int rho) { const int n = rho >> 4, i = rho & 15; return 8 * (i >> 2) + 4 * n + (i & 3); }

struct Unit { int pm, pn; };
struct Gemm { const bf16_t* A; const bf16_t* Bt; int M, N, K, lda, ldb; };

struct StaticOrder {
    int nM, nN, nwg, G, c;
    __host__ __device__ void init(int M, int N, int G_, int c_) { nM = M / BM; nN = N / BM; nwg = nM * nN; G = G_; c = c_; }
    __host__ __device__ bool next(int i, Unit& u) const {
        const long L = (long)i * G + c; if (L >= nwg) return false;
        int wgid = (int)L; { const int q = nwg / NXCD, r = nwg % NXCD, xcd = wgid % NXCD, off = wgid / NXCD; wgid = (xcd < r ? xcd * (q + 1) : r * (q + 1) + (xcd - r) * q) + off; }
        const int nig = WGM * nN, gid = wgid / nig, fm = gid * WGM, gsz = (nM - fm) < WGM ? (nM - fm) : WGM;
        u.pm = fm + ((wgid % nig) % gsz); u.pn = (wgid % nig) / gsz; return true;
    }
    __device__ __forceinline__ void a_ready(const Unit&) const {}
    __device__ __forceinline__ void done(const Unit&) const {}
};

__device__ __forceinline__ unsigned cvt_pk_bf16(float lo, float hi) { unsigned r; asm volatile("s_nop 0\n\tv_cvt_pk_bf16_f32 %0, %1, %2" : "=v"(r) : "v"(lo), "v"(hi)); return r; }
typedef float f32x2 __attribute__((ext_vector_type(2)));
__device__ __forceinline__ float shx(float v, int m, int lane) { return __int_as_float(__builtin_amdgcn_ds_bpermute((lane ^ m) << 2, __float_as_int(v))); }
__device__ __forceinline__ int tid_opq(int wave_s) { unsigned ones = ~0u; int w = wave_s; asm volatile("" : "+s"(ones), "+s"(w)); return w * 64 + (int)__builtin_amdgcn_mbcnt_hi(ones, __builtin_amdgcn_mbcnt_lo(ones, 0u)); }
typedef unsigned u32x2 __attribute__((ext_vector_type(2)));
constexpr int MTOK = 65536, DM = 1024, DFF = 2816;
__device__ __forceinline__ float bf_lo(unsigned w) { return __uint_as_float(w << 16); }
__device__ __forceinline__ float bf_hi(unsigned w) { return __uint_as_float(w & 0xffff0000u); }
__device__ __forceinline__ float ex2(float x) { return __builtin_amdgcn_exp2f(x); }
__device__ __forceinline__ float rcpf_(float x) { return __builtin_amdgcn_rcpf(x); }
__device__ __forceinline__ float sigm(float x) { return rcpf_(1.f + ex2(-1.44269504f * x)); }
__device__ __forceinline__ float gelu_tanh(float x) { return x * sigm(1.5957691216f * (x + 0.044715f * x * x * x)); }
__device__ __forceinline__ float row_rstd(const float* ss, int row) {
    const f32x4* p = (const f32x4*)(ss + (size_t)row * 16);
    const f32x4 a = p[0], b = p[1], c = p[2], d = p[3];
    const float s = (((a[0] + a[1]) + (a[2] + a[3])) + ((b[0] + b[1]) + (b[2] + b[3]))) + (((c[0] + c[1]) + (c[2] + c[3])) + ((d[0] + d[1]) + (d[2] + d[3])));
    return __builtin_amdgcn_rsqf(s * (1.0f / 1024.0f) + 1e-6f);
}
__device__ __forceinline__ void rstd8(const float* ss, int row0, int fr, int fq, float (&rs)[2][4]) {
    f32x4 pr[2][4];
#pragma unroll
    for (int ai = 0; ai < 2; ++ai)
#pragma unroll
        for (int m = 0; m < 4; ++m) pr[ai][m] = *(const f32x4*)(ss + (size_t)(row0 + ai * HALF + m * 16) * 16 + 4 * fq);
    const int ln = fr + 16 * fq;
#pragma unroll
    for (int ai = 0; ai < 2; ++ai)
#pragma unroll
        for (int m = 0; m < 4; ++m) { float s = (pr[ai][m][0] + pr[ai][m][1]) + (pr[ai][m][2] + pr[ai][m][3]); s += shx(s, 16, ln); s += shx(s, 32, ln);
            rs[ai][m] = __builtin_amdgcn_rsqf(s * (1.0f / 1024.0f) + 1e-6f); }
}
__device__ __forceinline__ u32x4 pack8(const f32x4 v0, const f32x4 v1) { u32x4 w; w.x = cvt_pk_bf16(v0[0], v0[1]); w.y = cvt_pk_bf16(v0[2], v0[3]); w.z = cvt_pk_bf16(v1[0], v1[1]); w.w = cvt_pk_bf16(v1[2], v1[3]); return w; }

struct EpiSwiglu {
    static constexpr bool PERM = true, AFTER_DRAIN = false, HOOK = false;
    bf16_t* O; const float* ss;
    __device__ __forceinline__ void operator()(const f32x4 (&acc)[2][2][4][2], const Unit& u, int wr, int wc, int fr, int fq) const {
        const int row0 = u.pm * BM + wr * 64 + fr, col0 = u.pn * 128 + wc * 32 + 8 * fq;
        float rsa[2][4]; rstd8(ss, row0, fr, fq, rsa);
#pragma unroll
        for (int ai = 0; ai < 2; ++ai)
#pragma unroll
            for (int m = 0; m < 4; ++m) { const int row = row0 + ai * HALF + m * 16; const float rs = rsa[ai][m], rs2 = rs * rs, k1 = -1.44269504f * rs;
                f32x4 o[2];
#pragma unroll
                for (int n = 0; n < 2; ++n)
#pragma unroll
                    for (int e = 0; e < 4; ++e) { const float ag = acc[ai][0][m][n][e], au = acc[ai][1][m][n][e]; o[n][e] = (ag * au) * (rs2 * rcpf_(1.f + ex2(ag * k1))); }
                *(u32x4*)(O + (size_t)row * DFF + col0) = pack8(o[0], o[1]); }
    }
};
struct EpiResid {
    static constexpr bool PERM = true, AFTER_DRAIN = false, HOOK = false;
    bf16_t* xb; float* ss; float alpha;
    __device__ __forceinline__ void operator()(const f32x4 (&acc)[2][2][4][2], const Unit& u, int wr, int wc, int fr, int fq) const {
        const int row0 = u.pm * BM + wr * 64 + fr, col0 = u.pn * BM + wc * 32 + 8 * fq;
#pragma unroll
        for (int ai = 0; ai < 2; ++ai) { u32x4 bw[4][2];
#pragma unroll
            for (int m = 0; m < 4; ++m)
#pragma unroll
                for (int bj = 0; bj < 2; ++bj) bw[m][bj] = *(const u32x4*)(xb + (size_t)(row0 + ai * HALF + m * 16) * DM + col0 + bj * HALF);
#pragma unroll
            for (int m = 0; m < 4; ++m) { const int row = row0 + ai * HALF + m * 16; float sq = 0.f;
#pragma unroll
                for (int bj = 0; bj < 2; ++bj) { const size_t off = (size_t)row * DM + col0 + bj * HALF; const u32x4 w = bw[m][bj];
                    const f32x4 b0 = {bf_lo(w.x), bf_hi(w.x), bf_lo(w.y), bf_hi(w.y)}, b1 = {bf_lo(w.z), bf_hi(w.z), bf_lo(w.w), bf_hi(w.w)};
                    const f32x4 o0 = b0 + acc[ai][bj][m][0] * alpha, o1 = b1 + acc[ai][bj][m][1] * alpha;
                    *(u32x4*)(xb + off) = pack8(o0, o1);
                    sq += ((o0[0] * o0[0] + o0[1] * o0[1]) + (o0[2] * o0[2] + o0[3] * o0[3])) + ((o1[0] * o1[0] + o1[1] * o1[1]) + (o1[2] * o1[2] + o1[3] * o1[3])); }
                { const int ln = fr + 16 * fq; sq += shx(sq, 16, ln); sq += shx(sq, 32, ln); }
                if (fq == 0) ss[(size_t)row * 16 + u.pn * 4 + wc] = sq; }
            asm volatile("" ::: "memory"); }
    }
};
__device__ __forceinline__ unsigned gate_frag_off(int gt, int pm, int wave, int ai, int m, int bj, int lane) {
    return ((unsigned)(gt * 256 + pm) << 17) + (unsigned)((((wave * 2 + ai) * 4 + m) * 2 + bj) * 64 + lane) * 16u;
}
struct EpiProj {
    static constexpr bool PERM = true, AFTER_DRAIN = false, HOOK = false;
    bf16_t *P, *Q, *K, *LX, *LG, *GATES; const float* ss; const float* mbias;
    __device__ __forceinline__ void operator()(const f32x4 (&acc)[2][2][4][2], const Unit& u, int wr, int wc, int fr, int fq) const {
        const int pn = u.pn; bf16_t* dst; int ld, c0, kind = 0; float sc = 1.f;
        if (pn == 0) { dst = P; ld = 256; c0 = 0; }
        else if (pn < 3) { dst = Q; ld = 512; c0 = (pn - 1) * 256; sc = 0.125f * 1.44269504f; }
        else if (pn < 5) { dst = K; ld = 512; c0 = (pn - 3) * 256; }
        else if (pn == 5) { dst = LX; ld = 256; c0 = 0; }
        else if (pn == 6) { dst = LG; ld = 256; c0 = 0; kind = 1; }
        else { dst = GATES; ld = 3072; c0 = (pn - 7) * 256; kind = 2; }
        const int row0 = u.pm * BM + wr * 64 + fr, col0 = c0 + wc * 32 + 8 * fq;
        f32x4 bv[2][2];
#pragma unroll
        for (int bj = 0; bj < 2; ++bj)
#pragma unroll
            for (int n = 0; n < 2; ++n) bv[bj][n] = (kind == 2) ? *(const f32x4*)(mbias + col0 + bj * HALF + 4 * n) * -1.44269504f : (f32x4){0.f, 0.f, 0.f, 0.f};
        float rsa[2][4]; rstd8(ss, row0, fr, fq, rsa);
#pragma unroll
        for (int ai = 0; ai < 2; ++ai)
#pragma unroll
            for (int m = 0; m < 4; ++m) { const int row = row0 + ai * HALF + m * 16; const float rs = rsa[ai][m] * sc;
#pragma unroll
                for (int bj = 0; bj < 2; ++bj) { f32x4 v[2];
#pragma unroll
                    for (int n = 0; n < 2; ++n) {
                        if (kind == 2) {
                            const float k1 = -1.44269504f * rs;
#pragma unroll
                            for (int e = 0; e < 4; ++e) v[n][e] = rcpf_(1.f + ex2(__builtin_fmaf(acc[ai][bj][m][n][e], k1, bv[bj][n][e]))); }
                        else { v[n] = acc[ai][bj][m][n] * rs;
                            if (kind == 1) {
#pragma unroll
                                for (int e = 0; e < 4; ++e) v[n][e] = gelu_tanh(v[n][e]); } } }
                    if (kind == 2) *(u32x4*)((char*)GATES + gate_frag_off(pn - 7, u.pm, wr * 4 + wc, ai, m, bj, fr + 16 * fq)) = pack8(v[0], v[1]);
                    else *(u32x4*)(dst + (size_t)row * ld + col0 + bj * HALF) = pack8(v[0], v[1]); } }
    }
};
struct EpiVt {
    static constexpr bool PERM = false, AFTER_DRAIN = false, HOOK = false;
    bf16_t* Vt; const float* ss;
    __device__ __forceinline__ void operator()(const f32x4 (&acc)[2][2][4][2], const Unit& u, int wr, int wc, int fr, int fq) const {
        const int ch0 = u.pm * BM + wr * 64 + fr;
        const int tokj = u.pn * BM + (fr >> 3) * HALF + wc * 32 + ((fr >> 2) & 1) * 16 + 4 * fq + (fr & 3);
        const float rsj = row_rstd(ss, tokj);
#pragma unroll
        for (int bj = 0; bj < 2; ++bj)
#pragma unroll
            for (int n = 0; n < 2; ++n) { const int tok = u.pn * BM + bj * HALF + wc * 32 + n * 16 + 4 * fq;
                f32x4 rs;
#pragma unroll
                for (int e2 = 0; e2 < 4; ++e2) rs[e2] = __int_as_float(__builtin_amdgcn_ds_bpermute(((bj * 8 + n * 4 + e2) + 16 * fq) << 2, __float_as_int(rsj)));
                const int b = tok >> 12, s = tok & 4095, sp = (s & ~15) + 8 * (fq & 1) + 4 * (fq >> 1);
#pragma unroll
                for (int ai = 0; ai < 2; ++ai)
#pragma unroll
                    for (int m = 0; m < 4; ++m) { const int ch = ch0 + ai * HALF + m * 16; const f32x4 v = acc[ai][bj][m][n] * rs;
                        u32x2 w; w.x = cvt_pk_bf16(v[0], v[1]); w.y = cvt_pk_bf16(v[2], v[3]);
                        *(u32x2*)(Vt + ((size_t)(b * 512 + ch)) * 4096 + sp) = w; } }
    }
};
typedef _Float16 h2_t __attribute__((ext_vector_type(2)));
struct EpiGates {
    static constexpr bool PERM = true, AFTER_DRAIN = false, HOOK = false;
    unsigned* AU; const bf16_t* XF  ; const float* b_a; const float* b_x; const float* c8;
    __device__ __forceinline__ void operator()(const f32x4 (&acc)[2][2][4][2], const Unit& u, int wr, int wc, int fr, int fq) const {
        const int dir = u.pn >> 1, half = u.pn & 1; const int row0 = u.pm * BM + wr * 64 + fr, ch0 = half * 128 + wc * 32 + 8 * fq;
#pragma unroll
        for (int n = 0; n < 2; ++n) { const int ch = ch0 + 4 * n;
            const f32x4 ba = *(const f32x4*)(b_a + dir * 256 + ch) * -1.44269504f, bx = *(const f32x4*)(b_x + dir * 256 + ch) * -1.44269504f, cc = *(const f32x4*)(c8 + dir * 256 + ch);
            u32x2 xwa[2][4];
#pragma unroll
            for (int ai = 0; ai < 2; ++ai)
#pragma unroll
                for (int m = 0; m < 4; ++m) xwa[ai][m] = *(const u32x2*)((const char*)XF + ((unsigned)(row0 + ai * HALF + m * 16) * 1024u + (unsigned)ch) * 2u);
#pragma unroll
            for (int ai = 0; ai < 2; ++ai)
#pragma unroll
                for (int m = 0; m < 4; ++m) { const int row = row0 + ai * HALF + m * 16;
                    const u32x2 xw = xwa[ai][m];
                    const float xf[4] = {bf_lo(xw.x), bf_hi(xw.x), bf_lo(xw.y), bf_hi(xw.y)};
                    u32x4 o;
#pragma unroll
                    for (int e = 0; e < 4; ++e) { const float r = rcpf_(1.f + ex2(__builtin_fmaf(acc[ai][0][m][n][e], -1.44269504f, ba[e]))), ig = rcpf_(1.f + ex2(__builtin_fmaf(acc[ai][1][m][n][e], -1.44269504f, bx[e])));
                        const float l2a = cc[e] * r; const float a2 = ex2(2.f * l2a); const float uu = __builtin_sqrtf(fmaxf(1.f - a2, 0.f)) * ig * xf[e];
                        h2_t hv; hv[0] = (_Float16)l2a; hv[1] = (_Float16)uu; o[e] = __builtin_bit_cast(unsigned, hv); }
                    *(u32x4*)((char*)AU + (((unsigned)dir * (unsigned)MTOK + (unsigned)row) * 256u + (unsigned)ch) * 4u) = o; }
            asm volatile("" ::: "memory"); }
    }
};
struct EpiMerged {
    static constexpr bool PERM = true, AFTER_DRAIN = false, HOOK = true;
    bf16_t* O; const bf16_t* G  ;
    __device__ __forceinline__ void hook(f32x4 (&acc)[2][2][4][2], const Unit& u, int t, int wr, int wc, int fr, int fq) const {
        const int which = (t == 4) ? 0 : 1;
#pragma unroll
        for (int ai = 0; ai < 2; ++ai) { u32x4 ga[4][2], gb[4][2];
#pragma unroll
            for (int m = 0; m < 4; ++m)
#pragma unroll
                for (int bj = 0; bj < 2; ++bj) { const unsigned go = gate_frag_off(which * 4 + u.pn, u.pm, wr * 4 + wc, ai, m, bj, fr + 16 * fq);
                    ga[m][bj] = *(const u32x4*)((const char*)G + go); gb[m][bj] = *(const u32x4*)((const char*)G + go + ((4u * 256u) << 17)); }
#pragma unroll
            for (int m = 0; m < 4; ++m)
#pragma unroll
                for (int bj = 0; bj < 2; ++bj) { const u32x4 a = ga[m][bj], b = gb[m][bj];
                    acc[ai][bj][m][0][0] *= bf_lo(a.x) * rcpf_(bf_lo(b.x)); acc[ai][bj][m][0][1] *= bf_hi(a.x) * rcpf_(bf_hi(b.x));
                    acc[ai][bj][m][0][2] *= bf_lo(a.y) * rcpf_(bf_lo(b.y)); acc[ai][bj][m][0][3] *= bf_hi(a.y) * rcpf_(bf_hi(b.y));
                    acc[ai][bj][m][1][0] *= bf_lo(a.z) * rcpf_(bf_lo(b.z)); acc[ai][bj][m][1][1] *= bf_hi(a.z) * rcpf_(bf_hi(b.z));
                    acc[ai][bj][m][1][2] *= bf_lo(a.w) * rcpf_(bf_lo(b.w)); acc[ai][bj][m][1][3] *= bf_hi(a.w) * rcpf_(bf_hi(b.w)); }
            asm volatile("" ::: "memory"); }
    }
    __device__ __forceinline__ void operator()(const f32x4 (&acc)[2][2][4][2], const Unit& u, int wr, int wc, int fr, int fq) const {
        const int row0 = u.pm * BM + wr * 64 + fr, col0 = u.pn * BM + wc * 32 + 8 * fq;
#pragma unroll
        for (int ai = 0; ai < 2; ++ai) { u32x4 g2[4][2];
#pragma unroll
            for (int m = 0; m < 4; ++m)
#pragma unroll
                for (int bj = 0; bj < 2; ++bj) g2[m][bj] = *(const u32x4*)((const char*)G + gate_frag_off(8 + u.pn, u.pm, wr * 4 + wc, ai, m, bj, fr + 16 * fq));
#pragma unroll
            for (int m = 0; m < 4; ++m) { const int row = row0 + ai * HALF + m * 16;
#pragma unroll
                for (int bj = 0; bj < 2; ++bj) { const u32x4 g = g2[m][bj];
                    f32x4 v0 = acc[ai][bj][m][0], v1 = acc[ai][bj][m][1];
                    v0[0] *= bf_lo(g.x); v0[1] *= bf_hi(g.x); v0[2] *= bf_lo(g.y); v0[3] *= bf_hi(g.y);
                    v1[0] *= bf_lo(g.z); v1[1] *= bf_hi(g.z); v1[2] *= bf_lo(g.w); v1[3] *= bf_hi(g.w);
                    *(u32x4*)(O + (size_t)row * DM + col0 + bj * HALF) = pack8(v0, v1); } }
            asm volatile("" ::: "memory"); }
    }
};
template <class Epi, class Sched, bool ALIGN_EPI = false, bool SP2 = false>
__device__ __forceinline__ void gemm_phase(PG8_LAS unsigned char* lds, const Gemm g, const Sched& S, const Epi& E, int wave_s) {
    const int tid_ = tid_opq(wave_s);
    const int tid = tid_, wid = __builtin_amdgcn_readfirstlane(tid >> 6), lane = tid & 63, wr = wid >> 2, wc = wid & 3, fr = lane & 15, fq = lane >> 4;
    const int K = g.K, nt = K / BK;
    unsigned voffA[2], voffB[2];
#pragma unroll
    for (int i = 0; i < 2; ++i) { int R, C; stage_rc(tid * 16 + i * 8192, R, C); const int Rb = Epi::PERM ? ((R & ~31) + perm32(R & 31)) : R;
        voffA[i] = (unsigned)(R * g.lda + C) * 2u; voffB[i] = (unsigned)(Rb * g.ldb + C) * 2u; }
    const size_t kstep = (size_t)(BK * 2);
    const size_t hstepA = (size_t)HALF * g.lda * 2, hstepB = (size_t)HALF * g.ldb * 2;
    const size_t tstepA = 2 * hstepA, tstepB = 2 * hstepB;
    const unsigned ldsw = (unsigned)wid * 1024u;
    const int aoff = lds_byte(wr * 64 + fr, fq * 8), boff = lds_byte(wc * 32 + fr, fq * 8);
#define PG8_SA(b, h) (((b) * 2 + (h)) * HTB)
#define PG8_SB(b, h) ((4 + (b) * 2 + (h)) * HTB)
#define PG8_STAGE(bufoff, gbase, voff) do { _Pragma("unroll") for (int _i = 0; _i < 2; ++_i) \
        __builtin_amdgcn_global_load_lds((const unsigned*)((const char*)(gbase) + (voff)[_i]), (PG8_LAS unsigned*)(lds + (bufoff) + ldsw + _i * 8192), 16, 0, 0); } while (0)
#define PG8_LDA(dst, b, h) do { _Pragma("unroll") for (int m = 0; m < 4; ++m) _Pragma("unroll") for (int k = 0; k < 2; ++k) dst[m][k] = *(const PG8_LAS bf16x8*)(lds + PG8_SA(b, h) + aoff + m * 2048 + k * 1024); } while (0)
#define PG8_LDB(dst, b, h) do { _Pragma("unroll") for (int n = 0; n < 2; ++n) _Pragma("unroll") for (int k = 0; k < 2; ++k) dst[n][k] = *(const PG8_LAS bf16x8*)(lds + PG8_SB(b, h) + boff + n * 2048 + k * 1024); } while (0)
#define PG8_MMA(ai, bj, At, Bt) do { __builtin_amdgcn_s_setprio(1); _Pragma("unroll") for (int m = 0; m < 4; ++m) _Pragma("unroll") for (int n = 0; n < 2; ++n) _Pragma("unroll") for (int k = 0; k < 2; ++k) \
        acc[ai][bj][m][n] = __builtin_amdgcn_mfma_f32_16x16x32_bf16(Bt[n][k], At[m][k], acc[ai][bj][m][n], 0, 0, 0); __builtin_amdgcn_s_setprio(0); } while (0)
#define PG8_WAIT_V(n) asm volatile("s_waitcnt vmcnt(" #n ")" ::: "memory")
#define PG8_WAIT_L(n) asm volatile("s_waitcnt lgkmcnt(" #n ")" ::: "memory")
#define PG8_BAR __builtin_amdgcn_s_barrier()
#define PG8_SCHED __builtin_amdgcn_sched_barrier(0)
    Unit cur, nxt; int ui = 0;
    if (!S.next(0, cur)) return;
    f32x4 acc[2][2][4][2];
#pragma unroll
    for (int a = 0; a < 2; ++a)
#pragma unroll
        for (int b = 0; b < 2; ++b)
#pragma unroll
            for (int m = 0; m < 4; ++m)
#pragma unroll
                for (int n = 0; n < 2; ++n) acc[a][b][m][n] = (f32x4){0.f, 0.f, 0.f, 0.f};
    bf16x8 At[4][2], B0[2][2], B1[2][2];
    const char* cA = (const char*)g.A + (size_t)cur.pm * tstepA; const char* cB = (const char*)g.Bt + (size_t)cur.pn * tstepB;
    S.a_ready(cur);
    if constexpr (SP2) {
        PG8_STAGE(PG8_SB(0, 0), cB, voffB); PG8_STAGE(PG8_SB(0, 1), cB + hstepB, voffB); PG8_STAGE(PG8_SA(0, 0), cA, voffA); PG8_STAGE(PG8_SA(0, 1), cA + hstepA, voffA);
        if (wr == 1) PG8_BAR;
        PG8_WAIT_V(2); PG8_BAR;
        PG8_STAGE(PG8_SB(1, 0), cB + kstep, voffB); PG8_STAGE(PG8_SA(1, 0), cA + kstep, voffA); PG8_STAGE(PG8_SB(1, 1), cB + hstepB + kstep, voffB);
        PG8_WAIT_V(6); PG8_BAR;
    } else {
        PG8_STAGE(PG8_SB(0, 0), cB, voffB); PG8_STAGE(PG8_SA(0, 0), cA, voffA); PG8_STAGE(PG8_SB(0, 1), cB + hstepB, voffB); PG8_STAGE(PG8_SA(0, 1), cA + hstepA, voffA);
        if (wr == 1) PG8_BAR;
        PG8_WAIT_V(4); PG8_BAR;
        PG8_STAGE(PG8_SB(1, 0), cB + kstep, voffB); PG8_STAGE(PG8_SA(1, 0), cA + kstep, voffA); PG8_STAGE(PG8_SB(1, 1), cB + hstepB + kstep, voffB);
        PG8_WAIT_V(6); PG8_BAR;
    }
    for (;;) {
        const bool has_next = S.next(ui + 1, nxt);
        const char* nA = has_next ? (const char*)g.A + (size_t)nxt.pm * tstepA : cA; const char* nB = has_next ? (const char*)g.Bt + (size_t)nxt.pn * tstepB : cB;
        for (int t = 0; t < nt; t += 2) {
            const bool last = (t == nt - 2);
            if constexpr (Epi::HOOK) { if (t == 4 || t == 12) { PG8_SCHED; E.hook(acc, cur, t, wr, wc, fr, fq); PG8_SCHED; } }
            const char* a1 = cA + (size_t)(t + 1) * kstep;
            const char* a2 = last ? nA : cA + (size_t)(t + 2) * kstep; const char* b2 = last ? nB : cB + (size_t)(t + 2) * kstep;
            const char* a3 = a2 + kstep; const char* b3 = b2 + kstep;
            if (last && has_next) S.a_ready(nxt);
            if constexpr (SP2) {
            PG8_LDB(B0, 0, 0); PG8_LDB(B1, 0, 1); PG8_SCHED; PG8_LDA(At, 0, 0); PG8_STAGE(PG8_SA(1, 1), a1 + hstepA, voffA);
            PG8_WAIT_V(8); PG8_WAIT_L(0); PG8_BAR; PG8_MMA(0, 0, At, B0); PG8_MMA(0, 1, At, B1); PG8_BAR; PG8_SCHED;
            PG8_LDA(At, 0, 1); PG8_STAGE(PG8_SB(0, 0), b2, voffB); PG8_STAGE(PG8_SB(0, 1), b2 + hstepB, voffB); PG8_STAGE(PG8_SA(0, 0), a2, voffA);
            PG8_WAIT_V(8); PG8_WAIT_L(0); PG8_BAR; PG8_MMA(1, 0, At, B0); PG8_MMA(1, 1, At, B1); PG8_BAR; PG8_SCHED;
            PG8_LDB(B0, 1, 0); PG8_LDB(B1, 1, 1); PG8_SCHED; PG8_LDA(At, 1, 0); PG8_STAGE(PG8_SA(0, 1), a2 + hstepA, voffA);
            PG8_WAIT_V(8); PG8_WAIT_L(0); PG8_BAR; PG8_MMA(0, 0, At, B0); PG8_MMA(0, 1, At, B1); PG8_BAR; PG8_SCHED;
            PG8_LDA(At, 1, 1); PG8_STAGE(PG8_SB(1, 0), b3, voffB); PG8_STAGE(PG8_SB(1, 1), b3 + hstepB, voffB); PG8_STAGE(PG8_SA(1, 0), a3, voffA);
            PG8_WAIT_V(8); PG8_WAIT_L(0); PG8_BAR; PG8_MMA(1, 0, At, B0); PG8_MMA(1, 1, At, B1); PG8_BAR; PG8_SCHED;
            } else {
            PG8_LDB(B0, 0, 0); PG8_SCHED; PG8_LDA(At, 0, 0); PG8_STAGE(PG8_SA(1, 1), a1 + hstepA, voffA);
            PG8_WAIT_L(8); PG8_BAR; PG8_WAIT_L(0); PG8_MMA(0, 0, At, B0); PG8_BAR; PG8_SCHED;
            PG8_LDB(B1, 0, 1); PG8_STAGE(PG8_SB(0, 0), b2, voffB);
            PG8_BAR; PG8_WAIT_L(0); PG8_MMA(0, 1, At, B1); PG8_BAR;
            PG8_LDA(At, 0, 1); PG8_STAGE(PG8_SA(0, 0), a2, voffA);
            PG8_BAR; PG8_WAIT_L(0); PG8_MMA(1, 0, At, B0); PG8_BAR; PG8_SCHED;
            PG8_STAGE(PG8_SB(0, 1), b2 + hstepB, voffB);
            PG8_WAIT_V(6); PG8_BAR; PG8_MMA(1, 1, At, B1); PG8_BAR;
            PG8_LDB(B0, 1, 0); PG8_SCHED; PG8_LDA(At, 1, 0); PG8_STAGE(PG8_SA(0, 1), a2 + hstepA, voffA);
            PG8_WAIT_L(8); PG8_BAR; PG8_WAIT_L(0); PG8_MMA(0, 0, At, B0); PG8_BAR; PG8_SCHED;
            PG8_LDB(B1, 1, 1); PG8_STAGE(PG8_SB(1, 0), b3, voffB);
            PG8_BAR; PG8_WAIT_L(0); PG8_MMA(0, 1, At, B1); PG8_BAR;
            PG8_LDA(At, 1, 1); PG8_STAGE(PG8_SA(1, 0), a3, voffA);
            PG8_BAR; PG8_WAIT_L(0); PG8_MMA(1, 0, At, B0); PG8_BAR; PG8_SCHED;
            PG8_STAGE(PG8_SB(1, 1), b3 + hstepB, voffB);
            PG8_WAIT_V(6); PG8_BAR; PG8_MMA(1, 1, At, B1); PG8_BAR;
            }
        }
        if constexpr (ALIGN_EPI) { if (wr == 0) PG8_BAR; }
        if constexpr (!Epi::AFTER_DRAIN) { E(acc, cur, wr, wc, fr, fq); S.done(cur); }
        if (!has_next) break;
#pragma unroll
        for (int a = 0; a < 2; ++a)
#pragma unroll
            for (int b = 0; b < 2; ++b)
#pragma unroll
                for (int m = 0; m < 4; ++m)
#pragma unroll
                    for (int n = 0; n < 2; ++n) acc[a][b][m][n] = (f32x4){0.f, 0.f, 0.f, 0.f};
        cur = nxt; cA = nA; cB = nB; ++ui;
        if constexpr (ALIGN_EPI) { if (wr == 1) PG8_BAR; }
    }
    PG8_WAIT_V(0);
    if constexpr (!ALIGN_EPI) { if (wr == 0) PG8_BAR; }
    PG8_BAR;
    if constexpr (Epi::AFTER_DRAIN) { E.fused(acc, cur, wr, wc, fr, fq, lds, wid, lane); S.done(cur); }
#undef PG8_SA
#undef PG8_SB
#undef PG8_STAGE
#undef PG8_LDA
#undef PG8_LDB
#undef PG8_MMA
#undef PG8_WAIT_V
#undef PG8_WAIT_L
#undef PG8_BAR
#undef PG8_SCHED
}
}
using namespace pg8;
#define LAS __attribute__((address_space(3)))
typedef float f32x16 __attribute__((ext_vector_type(16)));
constexpr int NWAVES = 8, NTHR = 512;
constexpr int SEQ = 4096, NBATCH = 16;
constexpr int LDS_BYTES = 147456;
constexpr int LDS_SCR = 131072;
constexpr size_t MiB = 1u << 20;
constexpr size_t WS_KMAX = 32768;
constexpr size_t WS_SS = 1 * MiB, WS_W = 5 * MiB, WS_TAB = 53 * MiB, WS_XB = 54 * MiB, WS_MIX = 182 * MiB;
constexpr size_t WS_P = WS_MIX, WS_LX = WS_MIX + 32 * MiB, WS_Q = WS_MIX + 64 * MiB, WS_K = WS_MIX + 128 * MiB, WS_LG = WS_MIX + 192 * MiB,
                 WS_VT = WS_MIX + 224 * MiB, WS_BR = WS_MIX + 288 * MiB, WS_GATES = WS_MIX + 416 * MiB, WS_END = WS_MIX + 800 * MiB;
constexpr size_t WS_MERGED = WS_Q, WS_ACT = WS_MIX;
constexpr size_t WO_W1A = 0, WO_W2A = WO_W1A + 5632 * 1024, WO_WP = WO_W2A + 1024 * 2816, WO_WV = WO_WP + 4864 * 1024, WO_WG = WO_WV + 512 * 1024,
                 WO_WBR = WO_WG + 1024 * 256, WO_WO = WO_WBR + 1024 * 1024, WO_W1B = WO_WO + 1024 * 1024, WO_W2B = WO_W1B + 5632 * 1024, WO_END = WO_W2B + 1024 * 2816;
static_assert(WO_END * 2 <= 48 * MiB, "weights region");

struct Params { const float* in[26]; float* out; unsigned char* ws; };

__device__ __forceinline__ unsigned f2bf(float f) { unsigned u = __builtin_bit_cast(unsigned, f); return (u + 0x7fffu + ((u >> 16) & 1u)) >> 16; }
__device__ __forceinline__ unsigned pk2(float lo, float hi) { return f2bf(lo) | (f2bf(hi) << 16); }
__device__ __forceinline__ float wave_sum(float v, int lane) {
#pragma unroll
    for (int o = 1; o < 64; o <<= 1) v += shx(v, o, lane);
    return v;
}
__device__ __forceinline__ void transpose_block(const float* W, int ldsrc, int sc0, int k0, bf16_t* WT, int ldd, int dr0, int koff, const float* kscale, LAS float* scr, int lane) {
#pragma unroll 16
    for (int i = 0; i < 32; ++i) { const int kk = 2 * i + (lane >> 5); float v = W[(size_t)(k0 + kk) * ldsrc + sc0 + (lane & 31)]; if (kscale) v *= kscale[k0 + kk]; scr[kk * 33 + (lane & 31)] = v; }
    asm volatile("s_waitcnt lgkmcnt(0)" ::: "memory");
    const int c = lane & 7;
#pragma unroll
    for (int j = 0; j < 4; ++j) { const int n = (lane >> 3) + 8 * j; const LAS float* s = scr + (8 * c) * 33 + n;
        u32x4 o; o.x = pk2(s[0 * 33], s[1 * 33]); o.y = pk2(s[2 * 33], s[3 * 33]); o.z = pk2(s[4 * 33], s[5 * 33]); o.w = pk2(s[6 * 33], s[7 * 33]);
        *(u32x4*)(WT + (size_t)(dr0 + n) * ldd + koff + k0 + 8 * c) = o; }
    asm volatile("s_waitcnt lgkmcnt(0)" ::: "memory");
}
typedef const __attribute__((address_space(4))) Params* KPc;
__device__ __forceinline__ void convert_layer(KPc pp, int l, LAS unsigned char* lds, int G, int wave_s) {
    const int tid = tid_opq(wave_s), lane = tid & 63, wave = tid >> 6;
    LAS float* scr = (LAS float*)(lds + wave * 16384);
    bf16_t* Wb = (bf16_t*)(pp->ws + WS_W);
    const int gw = blockIdx.x * NWAVES + wave, NGW = G * NWAVES;
    constexpr int I_W1 = 16 * 176, I_W2 = 44 * 32, I_WP = 16 * 152, I_WV = 16 * 16, I_BA = 8 * 32, I_BL = 4 * 32, I_WO = 16 * 32;
    constexpr int NIT = 2 * I_W1 + 2 * I_W2 + I_WP + I_WV + I_BA + I_BL + I_WO;
    for (int it = gw; it < NIT; it += NGW) {
        int r = it;
        if (r < 2 * I_W1) { const int f = r / I_W1; r -= f * I_W1; const int kb = r / 176, nb = r % 176; const int dr0 = nb * 32, tile = dr0 >> 8, within = dr0 & 255, bj = within >> 7, j = within & 127;
            const float* src = pp->in[f ? 23 : 2] + (size_t)l * 1024 * 5632; const float* gn = pp->in[f ? 22 : 1] + l * 1024;
            transpose_block(src, 5632, bj * 2816 + tile * 128 + j, kb * 64, Wb + (f ? WO_W1B : WO_W1A), 1024, dr0, 0, gn, scr, lane); continue; }
        r -= 2 * I_W1;
        if (r < 2 * I_W2) { const int f = r / I_W2; r -= f * I_W2; const int kb = r / 32, nb = r % 32;
            const float* src = pp->in[f ? 24 : 3] + (size_t)l * 2816 * 1024;
            transpose_block(src, 1024, nb * 32, kb * 64, Wb + (f ? WO_W2B : WO_W2A), 2816, nb * 32, 0, nullptr, scr, lane); continue; }
        r -= 2 * I_W2;
        if (r < I_WP) { const int kb = r / 152, nb = r % 152; const int dr0 = nb * 32; const int sc0 = dr0 < 1280 ? dr0 : dr0 + 512;
            transpose_block(pp->in[5] + (size_t)l * 1024 * 5376, 5376, sc0, kb * 64, Wb + WO_WP, 1024, dr0, 0, pp->in[4] + l * 1024, scr, lane); continue; }
        r -= I_WP;
        if (r < I_WV) { const int kb = r / 16, nb = r % 16;
            transpose_block(pp->in[5] + (size_t)l * 1024 * 5376, 5376, 1280 + nb * 32, kb * 64, Wb + WO_WV, 1024, nb * 32, 0, pp->in[4] + l * 1024, scr, lane); continue; }
        r -= I_WV;
        if (r < I_BA) { const int kb = r / 32, nb = r % 32;
            transpose_block(pp->in[18] + (size_t)l * 512 * 1024, 1024, nb * 32, kb * 64, Wb + WO_WBR, 1024, nb * 32, 256, nullptr, scr, lane); continue; }
        r -= I_BA;
        if (r < I_BL) { const int kb = r / 32, nb = r % 32;
            transpose_block(pp->in[19] + (size_t)l * 256 * 1024, 1024, nb * 32, kb * 64, Wb + WO_WBR, 1024, nb * 32, 768, nullptr, scr, lane); continue; }
        r -= I_BL;
        { const int kb = r / 32, nb = r % 32;
            transpose_block(pp->in[21] + (size_t)l * 1024 * 1024, 1024, nb * 32, kb * 64, Wb + WO_WO, 1024, nb * 32, 0, nullptr, scr, lane); }
    }
    const int gt = blockIdx.x * NTHR + tid, NGT = G * NTHR;
    { const float* pw = pp->in[6] + (size_t)l * 4 * 64 * 64; const float* ps = pp->in[7] + l * 256; const float* wbp = pp->in[17] + (size_t)l * 256 * 1024;
      for (int i = gt; i < 256 * 1024; i += NGT) { const int n = i & 1023, k = i >> 10, g = k >> 6; const float* pr = pw + (size_t)k * 64; float s = 0.f;
#pragma unroll 16
          for (int d = 0; d < 64; ++d) s += pr[d] * ps[64 * g + d] * wbp[(size_t)(64 * g + d) * 1024 + n];
          Wb[WO_WBR + (size_t)n * 1024 + k] = (bf16_t)f2bf(s); } }
    { for (int i = gt; i < 1024 * 256; i += NGT) { const int k = i & 255, n = i >> 8, tile = n >> 8, bj = (n >> 7) & 1, j = n & 127, dir = tile >> 1, half = tile & 1, ch = half * 128 + j, gq = ch >> 6, d = ch & 63;
          const float* w = pp->in[bj ? 14 : 12] + ((size_t)(l * 2 + dir) * 4 + gq) * 64 * 64; const float v = ((k >> 6) == gq) ? w[(k & 63) * 64 + d] : 0.f;
          Wb[WO_WG + (size_t)n * 256 + k] = (bf16_t)f2bf(v); } }
    { float* tab = (float*)(pp->ws + WS_TAB); const float* lam = pp->in[16] + l * 512;
      for (int i = gt; i < 512; i += NGT) tab[i] = -8.0f * __builtin_amdgcn_logf(1.0f + ex2(-1.44269504f * lam[i])); }
}
__device__ __forceinline__ void x_to_bf16(const float* x, bf16_t* xb, float* ss, int G, int wave_s) {
    const int tid = tid_opq(wave_s), lane = tid & 63, wave = tid >> 6; const int gw = blockIdx.x * NWAVES + wave, NGW = G * NWAVES;
    for (int m0 = gw * 4; m0 < MTOK; m0 += NGW * 4) { f32x4 v[4][4];
#pragma unroll
        for (int r = 0; r < 4; ++r)
#pragma unroll
            for (int j = 0; j < 4; ++j) v[r][j] = ((const f32x4*)(x + (size_t)(m0 + r) * DM) + lane)[64 * j];
#pragma unroll
        for (int r = 0; r < 4; ++r) { u32x2* o = (u32x2*)(xb + (size_t)(m0 + r) * DM) + lane; float s = 0.f;
#pragma unroll
            for (int j = 0; j < 4; ++j) { const f32x4 q = v[r][j]; s += (q[0] * q[0] + q[1] * q[1]) + (q[2] * q[2] + q[3] * q[3]); u32x2 w; w.x = cvt_pk_bf16(q[0], q[1]); w.y = cvt_pk_bf16(q[2], q[3]); o[64 * j] = w; }
            s = wave_sum(s, lane); if (lane < 16) ss[(size_t)(m0 + r) * 16 + lane] = (lane == 0) ? s : 0.f; } }
}
__device__ __forceinline__ void final_norm(const bf16_t* xb, float* out, const float* ss, const float* g, int G, int wave_s) {
    const int tid = tid_opq(wave_s), lane = tid & 63, wave = tid >> 6; const int gw = blockIdx.x * NWAVES + wave, NGW = G * NWAVES;
    f32x4 gv[4];
#pragma unroll
    for (int j = 0; j < 4; ++j) gv[j] = ((const f32x4*)g)[lane + 64 * j];
    for (int m0 = gw * 4; m0 < MTOK; m0 += NGW * 4) { u32x2 w[4][4]; float rs[4];
#pragma unroll
        for (int r = 0; r < 4; ++r) { rs[r] = row_rstd(ss, m0 + r);
#pragma unroll
            for (int j = 0; j < 4; ++j) w[r][j] = ((const u32x2*)(xb + (size_t)(m0 + r) * DM) + lane)[64 * j]; }
#pragma unroll
        for (int r = 0; r < 4; ++r) { f32x4* o = (f32x4*)(out + (size_t)(m0 + r) * DM) + lane;
#pragma unroll
            for (int j = 0; j < 4; ++j) { const u32x2 q = w[r][j]; const f32x4 v = {bf_lo(q.x), bf_hi(q.x), bf_lo(q.y), bf_hi(q.y)}; o[64 * j] = v * rs[r] * gv[j]; } } }
}
__device__ __forceinline__ void unpack8(const u32x4 w, float* f) { f[0] = bf_lo(w.x); f[1] = bf_hi(w.x); f[2] = bf_lo(w.y); f[3] = bf_hi(w.y); f[4] = bf_lo(w.z); f[5] = bf_hi(w.z); f[6] = bf_lo(w.w); f[7] = bf_hi(w.w); }
__device__ __forceinline__ u32x4 pack8f(const float* f) { u32x4 w; w.x = cvt_pk_bf16(f[0], f[1]); w.y = cvt_pk_bf16(f[2], f[3]); w.z = cvt_pk_bf16(f[4], f[5]); w.w = cvt_pk_bf16(f[6], f[7]); return w; }
__device__ __forceinline__ void prep_phase(const bf16_t* __restrict__ P, const bf16_t* __restrict__ LX, bf16_t* __restrict__ BR, const float* __restrict__ cw, const float* __restrict__ cb, const bf16_t* __restrict__ Kb, unsigned* __restrict__ kmax2, int G, int wave_s) {
    const int tid = tid_opq(wave_s), sub = tid >> 5, c8 = (tid & 31) * 8;
#pragma unroll 2
    for (int rb = blockIdx.x; rb < MTOK / 16; rb += G) { const int row = rb * 16 + sub, t = row & (SEQ - 1), b0 = row - t;
        { const int g = c8 >> 6, hw = 1 << g; const int lo = max(t - hw, 0), hi = min(t + hw, SEQ); float sum[8] = {0, 0, 0, 0, 0, 0, 0, 0}, f[8];
#pragma unroll
          for (int o = 0; o < 16; ++o) { const int tt = t - hw + o; if (o < 2 * hw && tt >= 0 && tt < SEQ) { unpack8(*(const u32x4*)(P + (size_t)(b0 + tt) * 256 + c8), f);
#pragma unroll
              for (int e = 0; e < 8; ++e) sum[e] += f[e]; } }
          unpack8(*(const u32x4*)(P + (size_t)row * 256 + c8), f); const float inv = 1.0f / (float)(hi - lo);
#pragma unroll
          for (int e = 0; e < 8; ++e) sum[e] = sum[e] * inv - f[e];
          *(u32x4*)(BR + (size_t)row * 1024 + c8) = pack8f(sum); }
        { float a[8], f[8];
#pragma unroll
          for (int e = 0; e < 8; ++e) a[e] = cb[c8 + e];
#pragma unroll
          for (int j = 0; j < 4; ++j) { const int tt = t - 2 + j; if (tt >= 0 && tt < SEQ) { unpack8(*(const u32x4*)(LX + (size_t)(b0 + tt) * 256 + c8), f);
#pragma unroll
                  for (int e = 0; e < 8; ++e) a[e] += cw[j * 256 + c8 + e] * f[e]; } }
          *(u32x4*)(BR + (size_t)row * 1024 + 768 + c8) = pack8f(a); }
        { float f[8], g8[8]; unpack8(*(const u32x4*)(Kb + (size_t)row * 512 + 2 * c8), f); unpack8(*(const u32x4*)(Kb + (size_t)row * 512 + 2 * c8 + 8), g8); float s = 0.f;
#pragma unroll
          for (int e = 0; e < 8; ++e) s += f[e] * f[e] + g8[e] * g8[e];
          s += shx(s, 1, tid & 63); s += shx(s, 2, tid & 63);
          if ((tid & 3) == 0) { unsigned* dst = kmax2 + (row >> 12) * 8 + ((tid & 31) >> 2); const unsigned sv = __float_as_uint(s);
              if (sv > __hip_atomic_load(dst, __ATOMIC_RELAXED, __HIP_MEMORY_SCOPE_AGENT)) atomicMax(dst, sv); } }
    }
}
__device__ __forceinline__ void lau4(const u32x4 w, f32x4& a, f32x4& u) {
    const unsigned w0 = w.x, w1 = w.y, w2 = w.z, w3 = w.w;
    const h2_t h0 = __builtin_bit_cast(h2_t, w0), h1 = __builtin_bit_cast(h2_t, w1), h2 = __builtin_bit_cast(h2_t, w2), h3 = __builtin_bit_cast(h2_t, w3);
    a = (f32x4){ex2((float)h0[0]), ex2((float)h1[0]), ex2((float)h2[0]), ex2((float)h3[0])}; u = (f32x4){(float)h0[1], (float)h1[1], (float)h2[1], (float)h3[1]};
}
__device__ __forceinline__ void scan_unit(LAS unsigned char* lds, const unsigned* __restrict__ AU, const bf16_t* __restrict__ GL, bf16_t* __restrict__ BR, int b, int cg8, int wave_s) {
    const int tid = tid_opq(wave_s), cq = tid & 1, j = tid >> 1, ch = cg8 * 8 + cq * 4, t0 = j * 16;
    LAS float* sPf = (LAS float*)lds; LAS float* sHf = sPf + 2048; LAS float* sPb = sPf + 4096; LAS float* sHb = sPf + 6144; LAS float* sCf = sPf + 8192; LAS float* sCb = sPf + 10240;
    const unsigned* auf = AU + ((size_t)b * SEQ + t0) * 256 + ch; const unsigned* aub = auf + (size_t)MTOK * 256;
    u32x4 wf[16], wb[16];
#pragma unroll
    for (int s = 0; s < 16; ++s) { wf[s] = *(const u32x4*)(auf + (size_t)s * 256); wb[s] = *(const u32x4*)(aub + (size_t)s * 256); }
    { f32x4 Pp = {1.f, 1.f, 1.f, 1.f}, H = {0.f, 0.f, 0.f, 0.f};
#pragma unroll
      for (int s = 0; s < 16; ++s) { f32x4 a, u; lau4(wf[s], a, u); Pp = Pp * a; H = a * H + u; }
      *(LAS f32x4*)(sPf + j * 8 + cq * 4) = Pp; *(LAS f32x4*)(sHf + j * 8 + cq * 4) = H; }
    { f32x4 Pp = {1.f, 1.f, 1.f, 1.f}, H = {0.f, 0.f, 0.f, 0.f};
#pragma unroll
      for (int s = 15; s >= 0; --s) { f32x4 a, u; lau4(wb[s], a, u); Pp = Pp * a; H = a * H + u; }
      *(LAS f32x4*)(sPb + j * 8 + cq * 4) = Pp; *(LAS f32x4*)(sHb + j * 8 + cq * 4) = H; }
#pragma unroll
    for (int s = 0; s < 16; ++s) { asm volatile("" : "+v"(wf[s]), "+v"(wb[s])); }
    __syncthreads();
    if (tid < 16) { const int c = tid & 7; float h = 0.f;
        if (tid < 8) {
#pragma unroll 8
            for (int jj = 0; jj < 256; ++jj) { sCf[jj * 8 + c] = h; h = sPf[jj * 8 + c] * h + sHf[jj * 8 + c]; } }
        else {
#pragma unroll 8
            for (int jj = 255; jj >= 0; --jj) { sCb[jj * 8 + c] = h; h = sPb[jj * 8 + c] * h + sHb[jj * 8 + c]; } } }
    __syncthreads();
    { f32x4 h = *(const LAS f32x4*)(sCb + j * 8 + cq * 4);
#pragma unroll
      for (int s = 15; s >= 0; --s) { f32x4 a, u; lau4(wb[s], a, u); h = a * h + u; wb[s] = __builtin_bit_cast(u32x4, h); } }
    { f32x4 h = *(const LAS f32x4*)(sCf + j * 8 + cq * 4);
      for (int sb = 0; sb < 16; sb += 8) { u32x2 gw[8];
#pragma unroll
        for (int i = 0; i < 8; ++i) gw[i] = *(const u32x2*)(GL + ((size_t)b * SEQ + t0 + sb + i) * 256 + ch);
#pragma unroll
        for (int i = 0; i < 8; ++i) { const int s = sb + i; const size_t row = (size_t)b * SEQ + t0 + s; f32x4 a, u; lau4(wf[s], a, u); h = a * h + u; const f32x4 hb = __builtin_bit_cast(f32x4, wb[s]);
            const f32x4 o = {(h[0] + hb[0]) * bf_lo(gw[i].x), (h[1] + hb[1]) * bf_hi(gw[i].x), (h[2] + hb[2]) * bf_lo(gw[i].y), (h[3] + hb[3]) * bf_hi(gw[i].y)};
            u32x2 ow; ow.x = cvt_pk_bf16(o[0], o[1]); ow.y = cvt_pk_bf16(o[2], o[3]); *(u32x2*)(BR + row * 1024 + 768 + ch) = ow; } } }
    __syncthreads();
}
__device__ __forceinline__ int crow(int r, int hi) { return (r & 3) + 8 * (r >> 2) + 4 * hi; }
__device__ __forceinline__ bf16x8 pack_p(const f32x16& s, int o) {
    u32x4 w; w.x = cvt_pk_bf16(s[o + 0], s[o + 1]); w.y = cvt_pk_bf16(s[o + 2], s[o + 3]); w.z = cvt_pk_bf16(s[o + 4], s[o + 5]); w.w = cvt_pk_bf16(s[o + 6], s[o + 7]);
    return __builtin_bit_cast(bf16x8, w);
}
__device__ __forceinline__ void attn_unit(LAS unsigned char* lds, const bf16_t* Q, const bf16_t* Kb, const bf16_t* Vt, bf16_t* BR, int b, int h, int qblk, float lam, float slope2, const float* subln, float lam_init, const unsigned* kmax2, int wave_s) {
    const int tid = tid_opq(wave_s), lane = tid & 63, wid = wave_s  , r32 = lane & 31, hi = lane >> 5, mp = wid >> 2, wq = wid & 3;
    const int q0 = qblk * 128; const size_t rowbase = (size_t)b * SEQ;
    bf16x8 qf[4];
    { const bf16_t* qp = Q + (rowbase + q0 + wq * 32 + r32) * 512 + h * 128 + mp * 64 + hi * 8;
#pragma unroll
      for (int d0 = 0; d0 < 4; ++d0) qf[d0] = *(const bf16x8*)(qp + d0 * 16); }
    const int srow = tid >> 3, sc = (tid & 7) ^ ((srow >> 1) & 7);
    const bf16_t* kg = Kb + (rowbase + srow) * 512 + h * 128 + sc * 8;
    const bf16_t* vg = Vt + ((size_t)(b * 512 + h * 128 + srow)) * 4096 + sc * 8;
    const int wofs = wid * 1024;
    const int sw = (r32 >> 1) & 7;
    const int kfo = mp * 8192 + r32 * 128, vfo = 65536 + r32 * 128;
#define ATT_DMA(gp, off) __builtin_amdgcn_global_load_lds((const unsigned*)(gp), (LAS unsigned*)(lds + (off)), 16, 0, 0)
    LAS float* scr = (LAS float*)(lds + LDS_SCR + wid * 128);
    const int td = q0 >> 6;
    { const size_t k0_ = (size_t)td * 64, k1_ = k0_ + 64;
      ATT_DMA(kg + k0_ * 512, wofs); ATT_DMA(kg + k0_ * 512 + 64, 8192 + wofs); ATT_DMA(kg + k1_ * 512, 16384 + wofs); ATT_DMA(kg + k1_ * 512 + 64, 16384 + 8192 + wofs);
      ATT_DMA(vg + k0_, 65536 + wofs); ATT_DMA(vg + k0_ + (size_t)64 * 4096, 65536 + 8192 + wofs); }
    int tlo, thi;
    { float q2 = 0.f;
#pragma unroll
      for (int d0 = 0; d0 < 4; ++d0) { const u32x4 w = __builtin_bit_cast(u32x4, qf[d0]); float f[8]; unpack8(w, f);
#pragma unroll
          for (int e = 0; e < 8; ++e) q2 += f[e] * f[e]; }
      q2 += shx(q2, 32, lane);
#pragma unroll
      for (int o = 1; o < 32; o <<= 1) q2 = fmaxf(q2, shx(q2, o, lane));
      LAS float* qx = (LAS float*)(lds + LDS_SCR + 1040);
      if (lane == 0) qx[wid] = q2;
      __syncthreads();
      float qm = qx[0];
#pragma unroll
      for (int w = 1; w < 8; ++w) qm = fmaxf(qm, qx[w]);
      const float k2 = fmaxf(__uint_as_float(kmax2[b * 8 + 2 * h]), __uint_as_float(kmax2[b * 8 + 2 * h + 1]));
      const float bound = 160.0f + 2.02f * __builtin_sqrtf(qm * k2);
      const float Df = fminf(bound / slope2, 16384.0f);
      const int hi_ = (int)floorf((Df + (float)(q0 + 127)) * (1.0f / 64.0f)), lo_ = (int)ceilf(((float)(q0 - 63) - Df) * (1.0f / 64.0f));
      thi = __builtin_amdgcn_readfirstlane(hi_ > 63 ? 63 : hi_); tlo = __builtin_amdgcn_readfirstlane(lo_ < 0 ? 0 : lo_);
      if (thi < td + 1) thi = td + 1; if (tlo > td) tlo = td; }
    const int ntile = thi - tlo + 1, nr = thi - td + 1;
#define ATT_TILE(i) (((i) < nr) ? (td + (i)) : (td - 1 + nr - (i)))
#define SBAR() __builtin_amdgcn_sched_barrier(0)
#define MFMA32(a, b, c) __builtin_amdgcn_mfma_f32_32x32x16_bf16(a, b, c, 0, 0, 0)
    { const u32x4 z = (u32x4){0u, 0u, 0u, 0u}; *(LAS u32x4*)(lds + 65536 + 3 * 16384 + tid * 32) = z; *(LAS u32x4*)(lds + 65536 + 3 * 16384 + tid * 32 + 16) = z;
      const size_t k2_ = (size_t)ATT_TILE(ntile > 2 ? 2 : ntile - 1) * 64;
      ATT_DMA(kg + k2_ * 512, 32768 + wofs); ATT_DMA(kg + k2_ * 512 + 64, 32768 + 8192 + wofs); }
    asm volatile("s_waitcnt vmcnt(0) lgkmcnt(0)\n\ts_barrier" ::: "memory");
    f32x16 SA0, SA1, SB0, SB1;
#pragma unroll
    for (int r = 0; r < 16; ++r) { SA0[r] = 0.f; SA1[r] = 0.f; }
#pragma unroll
    for (int d0 = 0; d0 < 4; ++d0) { const int co = ((2 * d0 + hi) ^ sw) << 4;
        SA0 = MFMA32(*(const LAS bf16x8*)(lds + kfo + co), qf[d0], SA0); SA1 = MFMA32(*(const LAS bf16x8*)(lds + kfo + 4096 + co), qf[d0], SA1); }
    float mrun = -1e30f, lsum = 0.f; f32x16 O[4];
#pragma unroll
    for (int d = 0; d < 4; ++d)
#pragma unroll
        for (int r = 0; r < 16; ++r) O[d][r] = 0.f;
    const float qposf = (float)(q0 + wq * 32 + r32 - 4 * hi);
#define KFRAG(d0, blk) (*(const LAS bf16x8*)(kb_ + (blk) * 4096 + (((2 * (d0) + hi) ^ sw) << 4)))
#define VFRAG(g) (*(const LAS bf16x8*)(vb_ + ((g) & 3) * 4096 + (((2 * ((g) >> 2) + hi) ^ sw) << 4)))
#define ATT_BIAS(SC0, SC1, d0) do { _Pragma("unroll") for (int r = 4 * (d0); r < 4 * (d0) + 4; ++r) { const float cr_ = (float)((r & 3) + 8 * (r >> 2)); \
        if (FAST_) { SC0[r] = __builtin_fmaf(ssg_, cr_, SC0[r]); SC1[r] = __builtin_fmaf(ssg_, cr_ + 32.f, SC1[r]); mx0_ = fmaxf(mx0_, fmaxf(SC0[r], SC1[r])); } \
        else { SC0[r] = SC0[r] - slope2 * __builtin_fabsf(dq_ - cr_); SC1[r] = SC1[r] - slope2 * __builtin_fabsf(dq_ - 32.f - cr_); mx0_ = fmaxf(mx0_, fmaxf(SC0[r], SC1[r])); } } } while (0)
#define ATT_STEP(t, SC0, SC1, SN0, SN1, FAST) do { \
        constexpr bool FAST_ = (FAST) != 0; \
        const int t_ = (t); const int tile_ = ATT_TILE(t_); \
        { const int tn_ = (t_ + 3 < ntile) ? t_ + 3 : ntile - 1, tv_ = (t_ + 1 < ntile) ? t_ + 1 : ntile - 1; const int tk_ = ATT_TILE(tn_), tvt_ = ATT_TILE(tv_); const size_t kv0_ = (size_t)tk_ * 64, vv0_ = (size_t)tvt_ * 64; \
          const int kd_ = ((t_ + 3) & 3) * 16384 + wofs, vd_ = 65536 + ((t_ + 1) & 3) * 16384 + wofs; \
          ATT_DMA(kg + kv0_ * 512, kd_); ATT_DMA(kg + kv0_ * 512 + 64, kd_ + 8192); ATT_DMA(vg + vv0_, vd_); ATT_DMA(vg + vv0_ + (size_t)64 * 4096, vd_ + 8192); } \
        const LAS unsigned char* kb_ = lds + ((t_ + 1) & 3) * 16384 + kfo; const LAS unsigned char* vb_ = lds + ((t_ + 3) & 3) * 16384 + vfo; \
        const float dq_ = qposf - (float)(tile_ * 64); float mx0_ = -1e30f; \
        const float ssg_ = (t_ < nr) ? -slope2 : slope2; const float c1_ = -ssg_ * dq_; \
        bf16x8 k00_ = KFRAG(0, 0), k01_ = KFRAG(0, 1), k10_ = KFRAG(1, 0), k11_ = KFRAG(1, 1); \
        ATT_BIAS(SC0, SC1, 0); SBAR(); \
        { f32x16 z_; _Pragma("unroll") for (int r = 0; r < 16; ++r) z_[r] = 0.f; SN0 = MFMA32(k00_, qf[0], z_); SN1 = MFMA32(k01_, qf[0], z_); } \
        k00_ = KFRAG(2, 0); k01_ = KFRAG(2, 1); ATT_BIAS(SC0, SC1, 1); SBAR(); \
        SN0 = MFMA32(k10_, qf[1], SN0); SN1 = MFMA32(k11_, qf[1], SN1); \
        k10_ = KFRAG(3, 0); k11_ = KFRAG(3, 1); ATT_BIAS(SC0, SC1, 2); SBAR(); \
        SN0 = MFMA32(k00_, qf[2], SN0); SN1 = MFMA32(k01_, qf[2], SN1); \
        bf16x8 v0_ = VFRAG(0), v1_ = VFRAG(1); ATT_BIAS(SC0, SC1, 3); SBAR(); \
        SN0 = MFMA32(k10_, qf[3], SN0); SN1 = MFMA32(k11_, qf[3], SN1); \
        float mt_ = FAST_ ? (mx0_ + c1_) : mx0_; \
        mt_ = fmaxf(mt_, shx(mt_, 32, lane)); \
        const bool resc_ = __any(mt_ > mrun); \
        { const float mn_ = fmaxf(mrun, mt_), al_ = ex2(mrun - mn_); lsum *= al_; mrun = mn_; if (hi == 0) scr[r32] = al_; } \
        const float mo0_ = FAST_ ? (mrun - c1_) : mrun; \
        SBAR(); \
        _Pragma("unroll") for (int g = 0; g < 16; ++g) { const int c_ = g >> 2, d_ = g & 3; \
            bf16x8 v2_ = v0_; if (g < 14) v2_ = VFRAG(g + 2); \
            O[d_] = MFMA32(PK[c_], v0_, O[d_]); \
            if (g < 8) { SC0[2 * g] = ex2(SC0[2 * g] - mo0_); SC0[2 * g + 1] = ex2(SC0[2 * g + 1] - mo0_); lsum += SC0[2 * g] + SC0[2 * g + 1]; } \
            else { SC1[2 * g - 16] = ex2(SC1[2 * g - 16] - mo0_); SC1[2 * g - 15] = ex2(SC1[2 * g - 15] - mo0_); lsum += SC1[2 * g - 16] + SC1[2 * g - 15]; } \
            if (g == 3) PK[0] = pack_p(SC0, 0); if (g == 7) PK[1] = pack_p(SC0, 8); if (g == 11) PK[2] = pack_p(SC1, 0); if (g == 15) PK[3] = pack_p(SC1, 8); \
            v0_ = v1_; v1_ = v2_; SBAR(); } \
        if (resc_) { f32x4 al4_[4]; \
            _Pragma("unroll") for (int jq = 0; jq < 4; ++jq) al4_[jq] = *(const LAS f32x4*)(scr + 8 * jq + 4 * hi); \
            _Pragma("unroll") for (int d = 0; d < 4; ++d) _Pragma("unroll") for (int r = 0; r < 16; ++r) O[d][r] *= al4_[r >> 2][r & 3]; } \
        asm volatile("s_waitcnt vmcnt(4) lgkmcnt(0)\n\ts_barrier" ::: "memory");     \
    } while (0)
    bf16x8 PK[4];
#pragma unroll
    for (int c = 0; c < 4; ++c) PK[c] = (bf16x8){0, 0, 0, 0, 0, 0, 0, 0};
    ATT_STEP(0, SA0, SA1, SB0, SB1, 0);
    ATT_STEP(1, SB0, SB1, SA0, SA1, 0);
    for (int t = 2; t < ntile; t += 2) {
        ATT_STEP(t, SA0, SA1, SB0, SB1, 1);
        if (t + 1 >= ntile) break;
        ATT_STEP(t + 1, SB0, SB1, SA0, SA1, 1);
    }
    { const LAS unsigned char* vb_ = lds + ((ntile - 1) & 3) * 16384 + vfo;
#pragma unroll
      for (int c = 0; c < 4; ++c)
#pragma unroll
          for (int d = 0; d < 4; ++d) { const bf16x8 vf = *(const LAS bf16x8*)(vb_ + d * 4096 + (((2 * c + hi) ^ sw) << 4)); O[d] = MFMA32(PK[c], vf, O[d]); } }
    lsum += shx(lsum, 32, lane);
    if (hi == 0) scr[r32] = rcpf_(lsum);
    __builtin_amdgcn_wave_barrier();
    { f32x4 al[4];
#pragma unroll
      for (int jq = 0; jq < 4; ++jq) al[jq] = *(const LAS f32x4*)(scr + 8 * jq + 4 * hi);
#pragma unroll
      for (int d = 0; d < 4; ++d)
#pragma unroll
          for (int r = 0; r < 16; ++r) O[d][r] *= al[r >> 2][r & 3]; }
    asm volatile("s_waitcnt vmcnt(0)" ::: "memory");
    __syncthreads();
    LAS float* C = (LAS float*)lds;
    if (mp == 1) {
#pragma unroll
        for (int d = 0; d < 4; ++d)
#pragma unroll
            for (int r = 0; r < 16; ++r) C[(wq * 32 + crow(r, hi)) * 132 + d * 32 + r32] = O[d][r]; }
    __syncthreads();
    if (mp == 0) {
#pragma unroll
        for (int d = 0; d < 4; ++d)
#pragma unroll
            for (int r = 0; r < 16; ++r) { const int ix = (wq * 32 + crow(r, hi)) * 132 + d * 32 + r32; C[ix] = O[d][r] - lam * C[ix]; } }
    __syncthreads();
    { float li_ = lam_init; asm volatile("" : "+s"(li_)); const float outscale = 1.0f - li_;
      const int tid2 = tid_opq(wave_s); const int row = tid2 >> 2, part = tid2 & 3; const LAS float* cp = C + row * 132 + part * 32; float v[32]; float sq = 0.f;
#pragma unroll
      for (int jq = 0; jq < 8; ++jq) { const f32x4 x = *(const LAS f32x4*)(cp + 4 * jq); v[4 * jq] = x[0]; v[4 * jq + 1] = x[1]; v[4 * jq + 2] = x[2]; v[4 * jq + 3] = x[3]; sq += (x[0] * x[0] + x[1] * x[1]) + (x[2] * x[2] + x[3] * x[3]); }
      sq += shx(sq, 1, tid2 & 63); sq += shx(sq, 2, tid2 & 63);
      const float rs = __builtin_amdgcn_rsqf(sq * (1.0f / 128.0f) + 1e-5f) * outscale;
      bf16_t* op = BR + (rowbase + q0 + row) * 1024 + 256 + h * 128 + part * 32;
#pragma unroll
      for (int jq = 0; jq < 4; ++jq) { float f[8];
#pragma unroll
          for (int e = 0; e < 8; ++e) f[e] = v[8 * jq + e] * rs * subln[part * 32 + 8 * jq + e];
          *(u32x4*)(op + 8 * jq) = pack8f(f); } }
    __syncthreads();
#undef ATT_TILE
#undef ATT_DMA
#undef ATT_STEP
#undef ATT_BIAS
#undef KFRAG
#undef VFRAG
#undef SBAR
#undef MFMA32
}

typedef const __attribute__((address_space(4))) Params* KP;
__device__ __forceinline__ KP kparams() { auto k = __builtin_amdgcn_kernarg_segment_ptr(); asm volatile("" : "+s"(k)); return (KP)k; }
#define WSP(T, off) ((T*)(kp->ws + (off)))
#define RLX_AGENT __ATOMIC_RELAXED, __HIP_MEMORY_SCOPE_AGENT
#define XB_TMO      128
#define XB_XCNT(j)  (256  + 64 * (j))
#define XB_XSUB(j)  (1280 + 64 * (j))
#define XB_XGEN(j)  (2304 + 64 * (j))
#define XB_TOP      3328
#define XB_TOPGEN   3392
#define XCD_BAR_WORDS 3456
#define XB_SPIN_CAP (1u << 18)

__device__ __forceinline__ unsigned xb_ld(unsigned* p)              { return __hip_atomic_load(p, __ATOMIC_RELAXED, __HIP_MEMORY_SCOPE_AGENT); }
__device__ __forceinline__ unsigned xb_add(unsigned* p, unsigned v) { return __hip_atomic_fetch_add(p, v, __ATOMIC_RELAXED, __HIP_MEMORY_SCOPE_AGENT); }
__device__ __forceinline__ unsigned xb_xcc_id() { return (unsigned)__builtin_amdgcn_s_getreg((3 << 11) | 20) & 0xFu; }
#define XB_SPIN(cond, bar) do { unsigned _sp = 0; while (cond) { __builtin_amdgcn_s_sleep(1); \
    if ((++_sp & 255u) == 0u) { if (xb_ld(&(bar)[XB_TMO])) break; if (_sp > XB_SPIN_CAP) { atomicAdd(&(bar)[XB_TMO], 1u); break; } } } } while (0)

struct XcdBarrier {
    unsigned* bar; unsigned x;
    volatile LAS unsigned* st;
};

__device__ __forceinline__ XcdBarrier xcd_barrier_post(unsigned* bar, volatile LAS unsigned* st, int tid) {
    XcdBarrier b; b.bar = bar; b.x = xb_xcc_id(); b.st = st;
    if (tid == 0) (void)xb_add(&bar[XB_XCNT(b.x)], 1u);
    return b;
}
__device__ __forceinline__ void xcd_barrier_complete(unsigned* bar, unsigned x, unsigned& nloc, unsigned& nx) {
    const unsigned G = gridDim.x * gridDim.y * gridDim.z;
    unsigned sum, cnt, mine, sp = 0u;
    for (;;) {
        sum = 0u; cnt = 0u; mine = 0u;
#pragma unroll
        for (unsigned j = 0; j < 16; ++j) { const unsigned c = xb_ld(&bar[XB_XCNT(j)]); sum += c; cnt += (c > 0u) ? 1u : 0u; mine = (j == x) ? c : mine; }
        if (sum == G) break;
        __builtin_amdgcn_s_sleep(1);
        if ((++sp & 255u) == 0u) { if (xb_ld(&bar[XB_TMO])) break; if (sp > XB_SPIN_CAP) { atomicAdd(&bar[XB_TMO], 1u); break; } }
    }
    nloc = mine > 0u ? mine : 1u; nx = cnt > 0u ? cnt : 1u;
}

__device__ __forceinline__ void xcd_barrier(const XcdBarrier& b, int tid) {
    asm volatile("s_waitcnt vmcnt(0)" ::: "memory");
    __syncthreads();
    if (tid == 0) {
        unsigned* bar = b.bar;
        __builtin_amdgcn_s_waitcnt(0);
        unsigned nloc = b.st[0], nx = b.st[1];
        if (nloc == 0u) { xcd_barrier_complete(bar, b.x, nloc, nx); b.st[0] = nloc; b.st[1] = nx; }
        const unsigned old = xb_add(&bar[XB_XSUB(b.x)], 1u);
        const unsigned gen = old / nloc;
        if (old + 1u == (gen + 1u) * nloc) {
            __builtin_amdgcn_fence(__ATOMIC_RELEASE, "agent");
            asm volatile("s_waitcnt vmcnt(0)" ::: "memory");
            const unsigned og = xb_add(&bar[XB_TOP], 1u);
            const unsigned tg = og / nx;
            if (og + 1u == (tg + 1u) * nx) xb_add(&bar[XB_TOPGEN], 1u);
            else XB_SPIN(xb_ld(&bar[XB_TOPGEN]) == tg, bar);
            __builtin_amdgcn_fence(__ATOMIC_ACQUIRE, "agent");
            xb_add(&bar[XB_XGEN(b.x)], 1u);
            asm volatile("s_waitcnt vmcnt(0)" ::: "memory");
        } else {
            XB_SPIN(xb_ld(&bar[XB_XGEN(b.x)]) == gen, bar);
            __builtin_amdgcn_fence(__ATOMIC_ACQUIRE, "agent");
            asm volatile("s_waitcnt vmcnt(0)" ::: "memory");
        }
    }
    __syncthreads();
}
constexpr int LDS_BARST = LDS_SCR + 1024;
__device__ __forceinline__ void xsync(LAS unsigned char* lds, int wave_s) {
    KP kp = kparams(); XcdBarrier b; b.bar = (unsigned*)kp->ws; b.x = xb_xcc_id(); b.st = (volatile LAS unsigned*)(lds + LDS_BARST);
    xcd_barrier(b, tid_opq(wave_s));
}
#ifdef DUP_SYNC
#define GSYNC() do { xsync(lds, wave_s); xsync(lds, wave_s); } while (0)
#else
#define GSYNC() xsync(lds, wave_s)
#endif
#ifndef REP_SMALL
#define REP_SMALL 1
#endif
#ifndef REP_PROJ
#define REP_PROJ 1
#endif
#ifndef REP_MERGED
#define REP_MERGED 1
#endif
#ifndef REP_OUT
#define REP_OUT 1
#endif
#ifndef REP_XF
#define REP_XF 1
#endif
#ifndef REP_FFN2
#define REP_FFN2 1
#endif
#ifdef DUP_ATTN
#define ATT_REPS 2
#else
#define ATT_REPS 1
#endif
#ifdef DUP_FFN1
#define FFN1_REPS 2
#else
#define FFN1_REPS 1
#endif
__global__ void __launch_bounds__(NTHR, 2) fwd_megakernel(Params p_unused) {
    extern __shared__ __attribute__((aligned(16))) unsigned char lds_raw[];
    LAS unsigned char* lds = (LAS unsigned char*)lds_raw;
    cg::grid_group grid = cg::this_grid();
    const int wave_s = __builtin_amdgcn_readfirstlane((int)(threadIdx.x >> 6));
    { const int t0 = tid_opq(wave_s); if (t0 < 2) ((LAS unsigned*)(lds + LDS_BARST))[t0] = 0u; __syncthreads();
      KP kp = kparams(); (void)xcd_barrier_post((unsigned*)kp->ws, (volatile LAS unsigned*)(lds + LDS_BARST), t0); }
    for (int l = 0; l < 2; ++l) {
        { KP kp = kparams(); const int G = gridDim.x;
#ifndef SKIP_CONV
for (int rep_ = 0; rep_ < (REP_SMALL); ++rep_)
          convert_layer(kp, l, lds, G, wave_s);
#endif
          for (int rep_ = 0; rep_ < (REP_XF); ++rep_)
          if (l == 0) x_to_bf16(kp->in[0], WSP(bf16_t, WS_XB), WSP(float, WS_SS), G, wave_s); }
        if (l == 0) grid.sync(); else GSYNC();
        for (int f = 0; f < 2; ++f) {
            if (f == 1) {
#ifndef SKIP_PROJ
for (int rep_ = 0; rep_ < (REP_PROJ); ++rep_)
                { KP kp = kparams(); const int G = gridDim.x, bid = blockIdx.x; bf16_t* Wb = WSP(bf16_t, WS_W);
                  Gemm g{WSP(bf16_t, WS_XB), Wb + WO_WP, MTOK, 4864, 1024, 1024, 1024}; StaticOrder S; S.init(MTOK, 4864, G, bid);
                  EpiProj E{WSP(bf16_t, WS_P), WSP(bf16_t, WS_Q), WSP(bf16_t, WS_K), WSP(bf16_t, WS_LX), WSP(bf16_t, WS_LG), WSP(bf16_t, WS_GATES), WSP(float, WS_SS), kp->in[20] + l * 3072};
                  gemm_phase<EpiProj, StaticOrder, true, true>(lds, g, S, E, wave_s); }
#endif
#ifndef SKIP_VT
for (int rep_ = 0; rep_ < (REP_PROJ); ++rep_)
                { KP kp = kparams(); const int G = gridDim.x, bid = blockIdx.x; bf16_t* Wb = WSP(bf16_t, WS_W);
                  Gemm g{Wb + WO_WV, WSP(bf16_t, WS_XB), 512, MTOK, 1024, 1024, 1024}; StaticOrder S; S.init(512, MTOK, G, bid);
                  EpiVt E{WSP(bf16_t, WS_VT), WSP(float, WS_SS)};
                  gemm_phase<EpiVt, StaticOrder, true, true>(lds, g, S, E, wave_s); }
#endif
                GSYNC();
#ifndef SKIP_PREP
for (int rep_ = 0; rep_ < (REP_SMALL); ++rep_)
                { KP kp = kparams(); prep_phase(WSP(bf16_t, WS_P), WSP(bf16_t, WS_LX), WSP(bf16_t, WS_BR), kp->in[10] + l * 1024, kp->in[11] + l * 256, WSP(bf16_t, WS_K), WSP(unsigned, WS_KMAX) + l * 128, gridDim.x, wave_s); }
#endif
                GSYNC();
#ifndef SKIP_GATES
for (int rep_ = 0; rep_ < (REP_SMALL); ++rep_)
                { KP kp = kparams(); const int G = gridDim.x, bid = blockIdx.x; bf16_t* Wb = WSP(bf16_t, WS_W); bf16_t* BR = WSP(bf16_t, WS_BR);
                  int Kg = 256; asm volatile("" : "+s"(Kg));
                  Gemm g{BR + 768, Wb + WO_WG, MTOK, 1024, Kg, 1024, 256}; StaticOrder S; S.init(MTOK, 1024, G, bid);
                  EpiGates E{((unsigned*)kp->out)  , BR + 768, kp->in[13] + l * 512, kp->in[15] + l * 512, WSP(float, WS_TAB)};
                  gemm_phase<EpiGates, StaticOrder, true, true>(lds, g, S, E, wave_s); }
#endif
                GSYNC();
#ifndef SKIP_SCAN
for (int rep_ = 0; rep_ < (REP_SMALL); ++rep_)
                { KP kp = kparams(); const int G = gridDim.x, bid = blockIdx.x;
                  for (int u = bid; u < 512; u += G) { const int v = u & 255, k = u >> 8; scan_unit(lds, ((unsigned*)kp->out), WSP(bf16_t, WS_LG), WSP(bf16_t, WS_BR), (v & 7) + 8 * k, v >> 3, wave_s); } }
#endif
#ifndef SKIP_ATTN
                { KP kp = kparams(); const int G = gridDim.x, bid = blockIdx.x;
                  int ll = l; asm volatile("" : "+s"(ll)); const int lane = tid_opq(wave_s) & 63;
                  const float* lp = kp->in[8] + ll * 256;
                  const float s1 = wave_sum(lp[lane] * lp[64 + lane], lane), s2 = wave_sum(lp[128 + lane] * lp[192 + lane], lane);
                  int lib_ = (ll == 0) ? 0x3e4ccccd   : 0x3eb60549  ; asm volatile("" : "+s"(lib_)); const float lam_init = __int_as_float(lib_);     const float lam = __uint_as_float(__builtin_amdgcn_readfirstlane(__float_as_uint(ex2(1.44269504f * s1) - ex2(1.44269504f * s2) + lam_init)));
                  for (int rep = 0; rep < ATT_REPS; ++rep)
                  for (int u = bid; u < 2048; u += G) { const int x = u & 7, k = u >> 8, slot = (((u >> 3) & 31) + 16 * (k >> 2)) & 31, pair = 8 * k + ((x + k) & 7), b = pair >> 2, h = pair & 3;
                      const float slope2 = __uint_as_float(__builtin_amdgcn_readfirstlane(__float_as_uint(ex2(-2.0f * (float)(h + 1)) * 1.44269504f)));
                      attn_unit(lds, WSP(bf16_t, WS_Q), WSP(bf16_t, WS_K), WSP(bf16_t, WS_VT), WSP(bf16_t, WS_BR), b, h, slot, lam, slope2, kp->in[9] + ll * 128, lam_init, WSP(unsigned, WS_KMAX) + ll * 128, wave_s); } }
#endif
                GSYNC();
#ifndef SKIP_MERGED
for (int rep_ = 0; rep_ < (REP_MERGED); ++rep_)
                { KP kp = kparams(); const int G = gridDim.x, bid = blockIdx.x; bf16_t* Wb = WSP(bf16_t, WS_W);
                  Gemm g{WSP(bf16_t, WS_BR), Wb + WO_WBR, MTOK, 1024, 1024, 1024, 1024}; StaticOrder S; S.init(MTOK, 1024, G, bid);
                  EpiMerged E{WSP(bf16_t, WS_MERGED), WSP(bf16_t, WS_GATES)};
                  gemm_phase<EpiMerged, StaticOrder, true, true>(lds, g, S, E, wave_s); }
#endif
                GSYNC();
#ifndef SKIP_OUT
                for (int rep_ = 0; rep_ < (REP_OUT); ++rep_)
                { KP kp = kparams(); const int G = gridDim.x, bid = blockIdx.x; bf16_t* Wb = WSP(bf16_t, WS_W);
                  Gemm g{WSP(bf16_t, WS_MERGED), Wb + WO_WO, MTOK, 1024, 1024, 1024, 1024}; StaticOrder S; S.init(MTOK, 1024, G, bid);
                  EpiResid E{WSP(bf16_t, WS_XB), WSP(float, WS_SS), (rep_ + 1 < (REP_OUT)) ? 0.0f : 1.0f};
                  gemm_phase<EpiResid, StaticOrder, true, true>(lds, g, S, E, wave_s); }
#endif
                GSYNC();
            }
#ifndef SKIP_FFN1
            for (int rep = 0; rep < FFN1_REPS; ++rep)
            { KP kp = kparams(); const int G = gridDim.x, bid = blockIdx.x; bf16_t* Wb = WSP(bf16_t, WS_W);
              Gemm g{WSP(bf16_t, WS_XB), Wb + (f ? WO_W1B : WO_W1A), MTOK, 5632, 1024, 1024, 1024}; StaticOrder S; S.init(MTOK, 5632, G, bid);
              EpiSwiglu E{WSP(bf16_t, WS_ACT), WSP(float, WS_SS)};
              gemm_phase<EpiSwiglu, StaticOrder, true, true>(lds, g, S, E, wave_s); }
#endif
            GSYNC();
#ifndef SKIP_FFN2
            for (int rep_ = 0; rep_ < (REP_FFN2); ++rep_)
            { KP kp = kparams(); const int G = gridDim.x, bid = blockIdx.x; bf16_t* Wb = WSP(bf16_t, WS_W);
              Gemm g{WSP(bf16_t, WS_ACT), Wb + (f ? WO_W2B : WO_W2A), MTOK, 1024, 2816, 2816, 2816}; StaticOrder S; S.init(MTOK, 1024, G, bid);
              EpiResid E{WSP(bf16_t, WS_XB), WSP(float, WS_SS), 0.5f};
              gemm_phase<EpiResid, StaticOrder, true, true>(lds, g, S, E, wave_s); }
#endif
            GSYNC();
        }
    }
    for (int rep_ = 0; rep_ < (REP_XF); ++rep_)
    { KP kp = kparams(); final_norm(WSP(bf16_t, WS_XB), kp->out, WSP(float, WS_SS), kp->in[25], gridDim.x, wave_s); }
}

extern "C" void kernel_launch(void* const* d_in, const int* in_sizes, int n_in, void* d_out, int out_size, void* d_ws, size_t ws_size, hipStream_t stream) {
    static int grid = 0;
    if (grid == 0) {
        if (n_in != 26 || out_size != MTOK * DM || ws_size < WS_END) { fprintf(stderr, "kernel_launch: unexpected shapes (n_in %d, out %d, ws %zu)\n", n_in, out_size, ws_size); grid = -1; return; }
        int dev = 0, cus = 0, per_cu = 0;
        hipGetDevice(&dev); hipDeviceGetAttribute(&cus, hipDeviceAttributeMultiprocessorCount, dev);
        hipFuncSetAttribute((const void*)fwd_megakernel, hipFuncAttributeMaxDynamicSharedMemorySize, LDS_BYTES);
        hipOccupancyMaxActiveBlocksPerMultiprocessor(&per_cu, (const void*)fwd_megakernel, NTHR, LDS_BYTES);
        if (per_cu < 1) per_cu = 1;
        grid = cus * per_cu;
    }
    if (grid < 0) return;
    if (hipMemsetAsync(d_ws, 0, 65536, stream) != hipSuccess) { fprintf(stderr, "kernel_launch: memset of the barrier words failed\n"); return; }
    Params p{};
    for (int i = 0; i < 26; ++i) p.in[i] = (const float*)d_in[i];
    p.out = (float*)d_out; p.ws = (unsigned char*)d_ws;
    void* args[] = {&p};
    hipError_t e = hipLaunchCooperativeKernel((const void*)fwd_megakernel, dim3(grid), dim3(NTHR), args, LDS_BYTES, stream);
    if (e != hipSuccess) fprintf(stderr, "cooperative launch failed: %s (grid %d)\n", hipGetErrorString(e), grid);
}
```
